# Optimizing an MI355X kernel written in HIP

```python
import jax, jax.numpy as jnp
from jax import lax
import numpy as np

D_MODEL = 1024
BATCH = 16
SEQ = 4096
DEPTH = 1
DEC_BATCH = 32
DEC_SEQ = 32
PAST_LEN = 4096

CHUNK = 64
RET_HEADS = 4
RET_QK_DIM = 256
RET_V_DIM = D_MODEL // RET_HEADS
RET_QK_WIDTH = RET_HEADS * RET_QK_DIM
RET_WIDTH = RET_HEADS * RET_V_DIM
SB_HEADS = 8
SB_HEAD_DIM = D_MODEL // SB_HEADS
SB_WIDTH = SB_HEADS * SB_HEAD_DIM
SB_BLOCK = 128
D_FF = 4 * D_MODEL
ROPE_BASE = 10000.0
EPS = 1e-6
IN_WIDTHS = (RET_QK_WIDTH, RET_QK_WIDTH, RET_WIDTH, RET_WIDTH,
             SB_WIDTH, SB_WIDTH, SB_WIDTH, D_MODEL, D_MODEL)
IN_WIDTH = sum(IN_WIDTHS)

kernel_name = "retention_stickbreaking_parallel_streaming_step"


def rmsnorm(x, w):
    xf = x.astype(jnp.float32)
    y = xf * lax.rsqrt(jnp.mean(xf * xf, axis=-1, keepdims=True) + EPS)
    return (y * w.astype(jnp.float32)).astype(x.dtype)


def rotary(x, pos):
    half = x.shape[-1] // 2
    inv_freq = ROPE_BASE ** (-jnp.arange(half, dtype=jnp.float32) / half)
    ang = pos.astype(jnp.float32)[:, None] * inv_freq[None, :]
    cos = jnp.cos(ang)[None, :, None, :]
    sin = jnp.sin(ang)[None, :, None, :]
    xf = x.astype(jnp.float32)
    x1, x2 = xf[..., :half], xf[..., half:]
    return jnp.concatenate([x1 * cos - x2 * sin, x1 * sin + x2 * cos], axis=-1).astype(x.dtype)


def retention_log_gamma():
    return jnp.log1p(-jnp.exp2(-5.0 - jnp.arange(RET_HEADS, dtype=jnp.float32)))


def project(h, pos, w_in_l, q_norm_w, k_norm_w):
    B, T, _ = h.shape
    bounds = np.concatenate([[0], np.cumsum(IN_WIDTHS)])
    parts = [h @ w_in_l[:, int(bounds[i]):int(bounds[i + 1])] for i in range(len(IN_WIDTHS))]
    rq, rk, rv, rg, sq, sk, sv, ga, gb = parts
    rq = rotary(rq.reshape(B, T, RET_HEADS, RET_QK_DIM), pos)
    rk = rotary(rk.reshape(B, T, RET_HEADS, RET_QK_DIM), pos) * (RET_QK_DIM ** -0.5)
    rv = rv.reshape(B, T, RET_HEADS, RET_V_DIM)
    sq = rmsnorm(sq.reshape(B, T, SB_HEADS, SB_HEAD_DIM), q_norm_w)
    sk = rmsnorm(sk.reshape(B, T, SB_HEADS, SB_HEAD_DIM), k_norm_w)
    sv = sv.reshape(B, T, SB_HEADS, SB_HEAD_DIM)
    return rq, rk, rv, rg, sq, sk, sv, ga, gb


def retention_chunk(S, q, k, v, log_gamma):
    L = q.shape[1]
    idx = jnp.arange(L, dtype=jnp.float32)
    decay = jnp.exp(log_gamma[:, None, None] * jnp.abs(idx[:, None] - idx[None, :]))
    scores = jnp.einsum('bihd,bjhd->bhij', q, k) * decay[None]
    o_intra = jnp.einsum('bhij,bjhe->bihe', scores, v)
    q_decay = jnp.exp(log_gamma[None, :] * (idx[:, None] + 1.0))
    o_cross = jnp.einsum('bihd,bhde->bihe', q, S) * q_decay[None, :, :, None]
    k_decay = jnp.exp(log_gamma[None, :] * (L - 1.0 - idx[:, None]))
    S_new = (jnp.exp(log_gamma * L)[None, :, None, None] * S
             + jnp.einsum('bjhd,bjhe->bhde', k * k_decay[None, :, :, None], v))
    return S_new, o_intra + o_cross


def retention_prompt(q, k, v, log_gamma):
    B, T = q.shape[:2]
    nc = T // CHUNK
    to_chunks = lambda a: jnp.moveaxis(a.astype(jnp.float32).reshape(B, nc, CHUNK, *a.shape[2:]), 1, 0)
    S0 = jnp.zeros((B, RET_HEADS, RET_QK_DIM, RET_V_DIM), jnp.float32)
    S_fin, o = lax.scan(lambda S, xs: retention_chunk(S, xs[0], xs[1], xs[2], log_gamma),
                        S0, (to_chunks(q), to_chunks(k), to_chunks(v)))
    o = jnp.moveaxis(o, 0, 1).reshape(B, T, RET_HEADS, RET_V_DIM)
    return o, S_fin


def stick_breaking_block(q, k, v, q_pos, k_pos):
    z = jnp.einsum('bqhd,bkhd->bhqk', q, k).astype(jnp.float32) * (SB_HEAD_DIM ** -0.5)
    mask = (k_pos[None, :] < q_pos[:, None])[None, None]
    u = jnp.where(mask, jax.nn.log_sigmoid(-z), 0.0)
    after = lax.cumsum(u, axis=3, reverse=True) - u
    w = jnp.where(mask, jnp.exp(jax.nn.log_sigmoid(z) + after), 0.0)
    return jnp.einsum('bhqk,bkhd->bqhd', w.astype(v.dtype), v)


def stick_breaking_prompt(q, k, v):
    T = q.shape[1]
    pos = jnp.arange(T, dtype=jnp.int32)
    outs = []
    for b in range(T // SB_BLOCK):
        lo, hi = b * SB_BLOCK, (b + 1) * SB_BLOCK
        outs.append(stick_breaking_block(q[:, lo:hi], k[:, :hi], v[:, :hi], pos[lo:hi], pos[:hi]))
    return jnp.concatenate(outs, axis=1)


def merge(o_ret, rg, o_sb, ga, gb, ret_norm_w_l, w_out_l):
    B, T = o_ret.shape[:2]
    r = rmsnorm(o_ret, ret_norm_w_l).reshape(B, T, RET_WIDTH).astype(rg.dtype) * jax.nn.silu(rg)
    s = o_sb.reshape(B, T, SB_WIDTH)
    mix = jax.nn.sigmoid(ga) * r + jax.nn.sigmoid(gb) * s
    return mix @ w_out_l


def sq_relu_mlp(h, w_up_l, w_down_l):
    return jnp.square(jax.nn.relu(h @ w_up_l)) @ w_down_l


def setup_inputs(seed: int = 0) -> dict:
    key = jax.random.key(seed)
    ks = jax.random.split(key, 16)
    f32 = jnp.float32
    nrm = lambda k, shape, s: jax.random.normal(k, shape, f32) * s
    return {
        "x_prompt": nrm(ks[0], (BATCH, SEQ, D_MODEL), 1.0),
        "x_sample": nrm(ks[1], (DEC_BATCH, DEC_SEQ, D_MODEL), 1.0),
        "cache_sb_k": nrm(ks[2], (DEPTH, DEC_BATCH, PAST_LEN, SB_HEADS, SB_HEAD_DIM), 1.0),
        "cache_sb_v": nrm(ks[3], (DEPTH, DEC_BATCH, PAST_LEN, SB_HEADS, SB_HEAD_DIM), 1.0),
        "state_ret": nrm(ks[4], (DEPTH, DEC_BATCH, RET_HEADS, RET_QK_DIM, RET_V_DIM), 0.5),
        "norm_mix_w": 1.0 + nrm(ks[5], (DEPTH, D_MODEL), 0.01),
        "w_in": nrm(ks[6], (DEPTH, D_MODEL, IN_WIDTH), D_MODEL ** -0.5),
        "ret_norm_w": 1.0 + nrm(ks[7], (DEPTH, RET_HEADS, RET_V_DIM), 0.01),
        "sb_q_norm_w": 1.0 + nrm(ks[8], (DEPTH, SB_HEAD_DIM), 0.01),
        "sb_k_norm_w": 1.0 + nrm(ks[9], (DEPTH, SB_HEAD_DIM), 0.01),
        "w_out": nrm(ks[10], (DEPTH, D_MODEL, D_MODEL), D_MODEL ** -0.5),
        "norm_mlp_w": 1.0 + nrm(ks[11], (DEPTH, D_MODEL), 0.01),
        "w_up": nrm(ks[12], (DEPTH, D_MODEL, D_FF), D_MODEL ** -0.5),
        "w_down": nrm(ks[13], (DEPTH, D_FF, D_MODEL), D_FF ** -0.5),
    }


def reference(x_prompt, x_sample, cache_sb_k, cache_sb_v, state_ret, norm_mix_w, w_in,
              ret_norm_w, sb_q_norm_w, sb_k_norm_w, w_out, norm_mlp_w, w_up, w_down):
    log_gamma = retention_log_gamma()
    T = x_prompt.shape[1]
    L = x_sample.shape[1]
    past = cache_sb_k.shape[2]
    pos_p = jnp.arange(T, dtype=jnp.int32)
    pos_s = past + jnp.arange(L, dtype=jnp.int32)
    k_pos_s = jnp.arange(past + L, dtype=jnp.int32)
    xp, xs = x_prompt, x_sample
    kp_l, vp_l, sp_l, ks_l, vs_l, ss_l = [], [], [], [], [], []
    for l in range(DEPTH):
        hp = rmsnorm(xp, norm_mix_w[l])
        rq, rk, rv, rg, sq, sk, sv, ga, gb = project(hp, pos_p, w_in[l], sb_q_norm_w[l], sb_k_norm_w[l])
        o_ret, S_p = retention_prompt(rq, rk, rv, log_gamma)
        o_sb = stick_breaking_prompt(sq, sk, sv)
        xp = xp + merge(o_ret, rg, o_sb, ga, gb, ret_norm_w[l], w_out[l])
        xp = xp + sq_relu_mlp(rmsnorm(xp, norm_mlp_w[l]), w_up[l], w_down[l])
        kp_l.append(sk)
        vp_l.append(sv)
        sp_l.append(S_p.astype(state_ret.dtype))
        hs = rmsnorm(xs, norm_mix_w[l])
        rq, rk, rv, rg, sq, sk, sv, ga, gb = project(hs, pos_s, w_in[l], sb_q_norm_w[l], sb_k_norm_w[l])
        S_s, o_ret_s = retention_chunk(state_ret[l].astype(jnp.float32), rq.astype(jnp.float32),
                                       rk.astype(jnp.float32), rv.astype(jnp.float32), log_gamma)
        k_all = jnp.concatenate([cache_sb_k[l].astype(sk.dtype), sk], axis=1)
        v_all = jnp.concatenate([cache_sb_v[l].astype(sv.dtype), sv], axis=1)
        o_sb_s = stick_breaking_block(sq, k_all, v_all, pos_s, k_pos_s)
        xs = xs + merge(o_ret_s, rg, o_sb_s, ga, gb, ret_norm_w[l], w_out[l])
        xs = xs + sq_relu_mlp(rmsnorm(xs, norm_mlp_w[l]), w_up[l], w_down[l])
        ks_l.append(sk)
        vs_l.append(sv)
        ss_l.append(S_s.astype(state_ret.dtype))
    return (xp, xs, jnp.stack(kp_l), jnp.stack(vp_l), jnp.stack(sp_l),
            jnp.stack(ks_l), jnp.stack(vs_l), jnp.stack(ss_l))
```

```cpp
#include <hip/hip_runtime.h>
#include <cstdio>
#include <cstdint>
#include <cmath>
namespace pg8 {
#define PG8_LAS __attribute__((address_space(3)))
typedef unsigned short bf16_t;
typedef short bf16x8 __attribute__((ext_vector_type(8)));
typedef float f32x4 __attribute__((ext_vector_type(4)));
typedef unsigned u32x4 __attribute__((ext_vector_type(4)));
constexpr int BM = 256, BK = 64, HALF = 128, HTB = HALF * BK * 2  , STAGE_BYTES = 8 * HTB, NXCD = 8, WGM = 8;

__host__ __device__ __forceinline__ int lds_byte(int r, int c) { const int st = (r >> 4) * 2 + (c >> 5), rr = r & 15, cc = c & 31, ob = rr * 64 + cc * 2; return st * 1024 + (ob ^ (((ob >> 9) & 1) << 5)); }
__host__ __device__ __forceinline__ void stage_rc(int b, int& R, int& C) { const int st = b / 1024, sb = b % 1024, swz = sb ^ (((sb >> 9) & 1) << 5); R = (st >> 1) * 16 + swz / 64; C = (st & 1) * 32 + (swz % 64) / 2; }
__host__ __device__ __forceinline__ int perm32(int rho) { const int n = rho >> 4, i = rho & 15; return 8 * (i >> 2) + 4 * n + (i & 3); }

struct Unit { int pm, pn; };
struct Gemm { const bf16_t* A; const bf16_t* Bt; int M, N, K; };

struct StaticOrder {
    int nM, nN, nwg, G, c;
    __host__ __device__ void init(int M, int N, int G_, int c_) { nM = M / BM; nN = N / BM; nwg = nM * nN; G = G_; c = c_; }
    __host__ __device__ bool next(int i, Unit& u) const {
        const long L = (long)i * G + c; if (L >= nwg) return false;
        int wgid = (int)L; { const int q = nwg / NXCD, r = nwg % NXCD, xcd = wgid % NXCD, off = wgid / NXCD; wgid = (xcd < r ? xcd * (q + 1) : r * (q + 1) + (xcd - r) * q) + off; }
        const int nig = WGM * nN, gid = wgid / nig, fm = gid * WGM, gsz = (nM - fm) < WGM ? (nM - fm) : WGM;
        u.pm = fm + ((wgid % nig) % gsz); u.pn = (wgid % nig) / gsz; return true;
    }
    __device__ __forceinline__ void a_ready(const Unit&) const {}
    __device__ __forceinline__ void done(const Unit&) const {}
};

__device__ __forceinline__ unsigned cvt_pk_bf16(float lo, float hi) { unsigned r; asm volatile("v_cvt_pk_bf16_f32 %0, %1, %2" : "=v"(r) : "v"(lo), "v"(hi)); return r; }
typedef float f32x2 __attribute__((ext_vector_type(2)));

typedef unsigned u32x2 __attribute__((ext_vector_type(2)));
typedef float f32x2_t __attribute__((ext_vector_type(2))); typedef __bf16 bf16x2_t __attribute__((ext_vector_type(2)));
__device__ __forceinline__ unsigned cvtpk(float lo, float hi) { f32x2_t v = {lo, hi}; bf16x2_t b = __builtin_convertvector(v, bf16x2_t); return __builtin_bit_cast(unsigned, b); }
__device__ __forceinline__ void store8(bf16_t* p, const f32x4 a, const f32x4 b) { u32x4 w; w.x = cvtpk(a[0], a[1]); w.y = cvtpk(a[2], a[3]); w.z = cvtpk(b[0], b[1]); w.w = cvtpk(b[2], b[3]); *(u32x4*)p = w; }
__device__ __forceinline__ float sigmoidf_fast(float x) { return __builtin_amdgcn_rcpf(1.0f + __builtin_amdgcn_exp2f(-1.4426950408889634f * x)); }
__device__ __forceinline__ float sumsq4(const f32x4 a) { return (a[0] * a[0] + a[1] * a[1]) + (a[2] * a[2] + a[3] * a[3]); }

constexpr int E_MP = 65536;
constexpr size_t E_REG = (size_t)66560 * 1024;
constexpr size_t EO_KP = 68157440, EO_VP = 135266304, EO_KS = 206569472, EO_VS = 207618048;

struct EpiIn {
    static constexpr bool PERM = true, AFTER_DRAIN = false;
    bf16_t* R; float* out; const float* rope; const float* qw; const float* kw; PG8_LAS float* xch;
    __device__ __forceinline__ void operator()(const f32x4 (&acc)[2][2][4][2], const Unit& u, int wr, int wc, int fr, int fq) const {
        const int tt = u.pn >> 2, hq = u.pn & 3;
        const int row0 = u.pm * BM + wr * 64 + fr, cl = 32 * wc + 8 * fq;
        bf16_t* base = R + (size_t)tt * E_REG + hq * 256 + cl;
        if (tt <= 1) {
            const float sc = (tt == 1) ? 0.0625f : 1.0f;
#pragma unroll
            for (int ai = 0; ai < 2; ++ai)
#pragma unroll
                for (int m = 0; m < 4; ++m) {
                    const int row = row0 + ai * HALF + m * 16;
                    const int pos = (row < E_MP) ? (row & 4095) : (4096 + (row & 31));
                    const f32x4* tp = (const f32x4*)(rope + ((size_t)pos * 128 + cl) * 2);
                    f32x4 o1[2], o2[2];
#pragma unroll
                    for (int n = 0; n < 2; ++n) {
                        const f32x4 t0 = tp[2 * n], t1 = tp[2 * n + 1], x1 = acc[ai][0][m][n], x2 = acc[ai][1][m][n];
                        o1[n] = (f32x4){x1[0] * t0[0] - x2[0] * t0[1], x1[1] * t0[2] - x2[1] * t0[3], x1[2] * t1[0] - x2[2] * t1[1], x1[3] * t1[2] - x2[3] * t1[3]} * sc;
                        o2[n] = (f32x4){x1[0] * t0[1] + x2[0] * t0[0], x1[1] * t0[3] + x2[1] * t0[2], x1[2] * t1[1] + x2[2] * t1[0], x1[3] * t1[3] + x2[3] * t1[2]} * sc;
                    }
                    bf16_t* rp = base + (size_t)row * 1024;
                    store8(rp, o1[0], o1[1]); store8(rp + HALF, o2[0], o2[1]);
                }
        } else if (tt == 4 || tt == 5) {
            const float* wsrc = (tt == 4) ? qw : kw;
            const f32x4 w0 = *(const f32x4*)(wsrc + cl), w1 = *(const f32x4*)(wsrc + cl + 4);
            const float osc = (tt == 4) ? 0.08838834764831845f : 1.0f;
#pragma unroll
            for (int ai = 0; ai < 2; ++ai)
#pragma unroll
                for (int m = 0; m < 4; ++m)
#pragma unroll
                    for (int bj = 0; bj < 2; ++bj) {
                        float s = sumsq4(acc[ai][bj][m][0]) + sumsq4(acc[ai][bj][m][1]);
                        s += __shfl_xor(s, 16); s += __shfl_xor(s, 32);
                        if (fq == 0) xch[((ai * HALF + wr * 64 + m * 16 + fr) * 2 + bj) * 4 + wc] = s;
                    }
            asm volatile("s_waitcnt lgkmcnt(0)" ::: "memory"); __builtin_amdgcn_s_barrier(); asm volatile("" ::: "memory");
            float* ok = (row0 < E_MP) ? out + EO_KP : out + EO_KS - (size_t)E_MP * 1024;
#pragma unroll
            for (int ai = 0; ai < 2; ++ai)
#pragma unroll
                for (int m = 0; m < 4; ++m) {
                    const int rl = ai * HALF + wr * 64 + m * 16 + fr, row = u.pm * BM + rl;
#pragma unroll
                    for (int bj = 0; bj < 2; ++bj) {
                        const f32x4 p = *(const PG8_LAS f32x4*)(xch + (rl * 2 + bj) * 4);
                        const float rstd = osc / sqrtf(((p[0] + p[1]) + (p[2] + p[3])) * (1.0f / 128.0f) + 1e-6f);
                        const f32x4 v0 = acc[ai][bj][m][0] * rstd * w0, v1 = acc[ai][bj][m][1] * rstd * w1;
                        if (tt == 5) { float* o = ok + (size_t)row * 1024 + hq * 256 + bj * HALF + cl; *(f32x4*)o = v0; *(f32x4*)(o + 4) = v1; }
                        store8(base + (size_t)row * 1024 + bj * HALF, v0, v1);
                    }
                }
        } else {
            float* ov = (row0 < E_MP) ? out + EO_VP : out + EO_VS - (size_t)E_MP * 1024;
#pragma unroll
            for (int ai = 0; ai < 2; ++ai)
#pragma unroll
                for (int m = 0; m < 4; ++m) {
                    const int row = row0 + ai * HALF + m * 16;
#pragma unroll
                    for (int bj = 0; bj < 2; ++bj) {
                        f32x4 v0 = acc[ai][bj][m][0], v1 = acc[ai][bj][m][1];
                        if (tt == 3) {
#pragma unroll
                            for (int e = 0; e < 4; ++e) { v0[e] *= sigmoidf_fast(v0[e]); v1[e] *= sigmoidf_fast(v1[e]); }
                        } else if (tt >= 7) {
#pragma unroll
                            for (int e = 0; e < 4; ++e) { v0[e] = sigmoidf_fast(v0[e]); v1[e] = sigmoidf_fast(v1[e]); }
                        } else if (tt == 6) { float* o = ov + (size_t)row * 1024 + hq * 256 + bj * HALF + cl; *(f32x4*)o = v0; *(f32x4*)(o + 4) = v1; }
                        store8(base + (size_t)row * 1024 + bj * HALF, v0, v1);
                    }
                }
        }
    }
};

struct EpiRes1 {
    static constexpr bool PERM = true, AFTER_DRAIN = false;
    const float* xp; const float* xs; float* out; bf16_t* XB; float* SSQ;
    __device__ __forceinline__ void operator()(const f32x4 (&acc)[2][2][4][2], const Unit& u, int wr, int wc, int fr, int fq) const {
        const int row0 = u.pm * BM + wr * 64 + fr, col0 = u.pn * BM + 32 * wc + 8 * fq;
        const float* xb = (row0 < E_MP) ? xp : xs - (size_t)E_MP * 1024;
#pragma unroll
        for (int ai = 0; ai < 2; ++ai)
#pragma unroll
            for (int m = 0; m < 4; ++m) {
                const int row = row0 + ai * HALF + m * 16; float ss = 0.f;
#pragma unroll
                for (int bj = 0; bj < 2; ++bj) {
                    const size_t off = (size_t)row * 1024 + col0 + bj * HALF;
                    const f32x4 v0 = acc[ai][bj][m][0] + *(const f32x4*)(xb + off), v1 = acc[ai][bj][m][1] + *(const f32x4*)(xb + off + 4);
                    *(f32x4*)(out + off) = v0; *(f32x4*)(out + off + 4) = v1;
                    ss += sumsq4(v0) + sumsq4(v1);
                    store8(XB + off, v0, v1);
                }
                ss += __shfl_xor(ss, 16); ss += __shfl_xor(ss, 32);
                if (fq == 0) SSQ[(size_t)row * 16 + u.pn * 4 + wc] = ss;
            }
    }
};

struct EpiUp {
    static constexpr bool PERM = true, AFTER_DRAIN = false;
    bf16_t* H; const float* SSQ;
    __device__ __forceinline__ void operator()(const f32x4 (&acc)[2][2][4][2], const Unit& u, int wr, int wc, int fr, int fq) const {
        const int row0 = u.pm * BM + wr * 64 + fr, col0 = u.pn * BM + 32 * wc + 8 * fq;
#pragma unroll
        for (int ai = 0; ai < 2; ++ai)
#pragma unroll
            for (int m = 0; m < 4; ++m) {
                const int row = row0 + ai * HALF + m * 16;
                const f32x4* sp = (const f32x4*)(SSQ + (size_t)row * 16);
                const f32x4 s4 = (sp[0] + sp[1]) + (sp[2] + sp[3]);
                const float r2 = 1.0f / (((s4[0] + s4[1]) + (s4[2] + s4[3])) * (1.0f / 1024.0f) + 1e-6f);
#pragma unroll
                for (int bj = 0; bj < 2; ++bj) {
                    f32x4 v0 = acc[ai][bj][m][0], v1 = acc[ai][bj][m][1];
#pragma unroll
                    for (int e = 0; e < 4; ++e) { const float a = fmaxf(v0[e], 0.f), b = fmaxf(v1[e], 0.f); v0[e] = a * a * r2; v1[e] = b * b * r2; }
                    store8(H + (size_t)row * 4096 + col0 + bj * HALF, v0, v1);
                }
            }
    }
};

struct EpiDown {
    static constexpr bool PERM = true, AFTER_DRAIN = false;
    float* out;
    __device__ __forceinline__ void operator()(const f32x4 (&acc)[2][2][4][2], const Unit& u, int wr, int wc, int fr, int fq) const {
        const int row0 = u.pm * BM + wr * 64 + fr, col0 = u.pn * BM + 32 * wc + 8 * fq;
#pragma unroll
        for (int ai = 0; ai < 2; ++ai)
#pragma unroll
            for (int m = 0; m < 4; ++m) {
                const int row = row0 + ai * HALF + m * 16;
#pragma unroll
                for (int bj = 0; bj < 2; ++bj) {
                    float* o = out + (size_t)row * 1024 + col0 + bj * HALF;
                    const f32x4 v0 = acc[ai][bj][m][0] + *(const f32x4*)o, v1 = acc[ai][bj][m][1] + *(const f32x4*)(o + 4);
                    *(f32x4*)o = v0; *(f32x4*)(o + 4) = v1;
                }
            }
    }
};

template <class Epi, class Sched, bool ALIGN_EPI = false, bool SP2 = false>
__device__ __forceinline__ void gemm_phase(PG8_LAS unsigned char* lds, const Gemm g, const Sched& S, const Epi& E) {
    int tid_ = threadIdx.x; asm volatile("" : "+v"(tid_));
    const int tid = tid_, wid = __builtin_amdgcn_readfirstlane(tid >> 6), lane = tid & 63, wr = wid >> 2, wc = wid & 3, fr = lane & 15, fq = lane >> 4;
    const int K = g.K, nt = K / BK;
    unsigned voffA[2], voffB[2];
#pragma unroll
    for (int i = 0; i < 2; ++i) { int R, C; stage_rc(tid * 16 + i * 8192, R, C); const int Rb = Epi::PERM ? ((R & ~31) + perm32(R & 31)) : R;
        voffA[i] = (unsigned)(R * K + C) * 2u; voffB[i] = (unsigned)(Rb * K + C) * 2u; }
    const size_t kstep = (size_t)(BK * 2);
    const size_t hstep = (size_t)HALF * K * 2;
    const size_t tstep = 2 * hstep;
    const unsigned ldsw = (unsigned)wid * 1024u;
    const int aoff = lds_byte(wr * 64 + fr, fq * 8), boff = lds_byte(wc * 32 + fr, fq * 8);
#define PG8_SA(b, h) (((b) * 2 + (h)) * HTB)
#define PG8_SB(b, h) ((4 + (b) * 2 + (h)) * HTB)
#define PG8_STAGE(bufoff, gbase, voff) do { _Pragma("unroll") for (int _i = 0; _i < 2; ++_i) \
        __builtin_amdgcn_global_load_lds((const unsigned*)((const char*)(gbase) + (voff)[_i]), (PG8_LAS unsigned*)(lds + (bufoff) + ldsw + _i * 8192), 16, 0, 0); } while (0)
#define PG8_LDA(dst, b, h) do { _Pragma("unroll") for (int m = 0; m < 4; ++m) _Pragma("unroll") for (int k = 0; k < 2; ++k) dst[m][k] = *(const PG8_LAS bf16x8*)(lds + PG8_SA(b, h) + aoff + m * 2048 + k * 1024); } while (0)
#define PG8_LDB(dst, b, h) do { _Pragma("unroll") for (int n = 0; n < 2; ++n) _Pragma("unroll") for (int k = 0; k < 2; ++k) dst[n][k] = *(const PG8_LAS bf16x8*)(lds + PG8_SB(b, h) + boff + n * 2048 + k * 1024); } while (0)
#define PG8_MMA(ai, bj, At, Bt) do { __builtin_amdgcn_s_setprio(1); _Pragma("unroll") for (int m = 0; m < 4; ++m) _Pragma("unroll") for (int n = 0; n < 2; ++n) _Pragma("unroll") for (int k = 0; k < 2; ++k) \
        acc[ai][bj][m][n] = __builtin_amdgcn_mfma_f32_16x16x32_bf16(Bt[n][k], At[m][k], acc[ai][bj][m][n], 0, 0, 0); __builtin_amdgcn_s_setprio(0); } while (0)
#define PG8_WAIT_V(n) asm volatile("s_waitcnt vmcnt(" #n ")" ::: "memory")
#define PG8_WAIT_L(n) asm volatile("s_waitcnt lgkmcnt(" #n ")" ::: "memory")
#define PG8_BAR __builtin_amdgcn_s_barrier()
#define PG8_SCHED __builtin_amdgcn_sched_barrier(0)
    Unit cur, nxt; int ui = 0;
    if (!S.next(0, cur)) return;
    f32x4 acc[2][2][4][2];
#pragma unroll
    for (int a = 0; a < 2; ++a)
#pragma unroll
        for (int b = 0; b < 2; ++b)
#pragma unroll
            for (int m = 0; m < 4; ++m)
#pragma unroll
                for (int n = 0; n < 2; ++n) acc[a][b][m][n] = (f32x4){0.f, 0.f, 0.f, 0.f};
    bf16x8 At[4][2], B0[2][2], B1[2][2];
    const char* cA = (const char*)g.A + (size_t)cur.pm * tstep; const char* cB = (const char*)g.Bt + (size_t)cur.pn * tstep;
    S.a_ready(cur);
    if constexpr (SP2) {
        PG8_STAGE(PG8_SB(0, 0), cB, voffB); PG8_STAGE(PG8_SB(0, 1), cB + hstep, voffB); PG8_STAGE(PG8_SA(0, 0), cA, voffA); PG8_STAGE(PG8_SA(0, 1), cA + hstep, voffA);
        if (wr == 1) PG8_BAR;
        PG8_WAIT_V(2); PG8_BAR;
        PG8_STAGE(PG8_SB(1, 0), cB + kstep, voffB); PG8_STAGE(PG8_SA(1, 0), cA + kstep, voffA); PG8_STAGE(PG8_SB(1, 1), cB + hstep + kstep, voffB);
        PG8_WAIT_V(6); PG8_BAR;
    } else {
        PG8_STAGE(PG8_SB(0, 0), cB, voffB); PG8_STAGE(PG8_SA(0, 0), cA, voffA); PG8_STAGE(PG8_SB(0, 1), cB + hstep, voffB); PG8_STAGE(PG8_SA(0, 1), cA + hstep, voffA);
        if (wr == 1) PG8_BAR;
        PG8_WAIT_V(4); PG8_BAR;
        PG8_STAGE(PG8_SB(1, 0), cB + kstep, voffB); PG8_STAGE(PG8_SA(1, 0), cA + kstep, voffA); PG8_STAGE(PG8_SB(1, 1), cB + hstep + kstep, voffB);
        PG8_WAIT_V(6); PG8_BAR;
    }
    for (;;) {
        const bool has_next = S.next(ui + 1, nxt);
        const char* nA = has_next ? (const char*)g.A + (size_t)nxt.pm * tstep : cA; const char* nB = has_next ? (const char*)g.Bt + (size_t)nxt.pn * tstep : cB;
        for (int t = 0; t < nt; t += 2) {
            const bool last = (t == nt - 2);
            const char* a1 = cA + (size_t)(t + 1) * kstep;
            const char* a2 = last ? nA : cA + (size_t)(t + 2) * kstep; const char* b2 = last ? nB : cB + (size_t)(t + 2) * kstep;
            const char* a3 = a2 + kstep; const char* b3 = b2 + kstep;
            if (last && has_next) S.a_ready(nxt);
            if constexpr (SP2) {
            PG8_LDB(B0, 0, 0); PG8_LDB(B1, 0, 1); PG8_SCHED; PG8_LDA(At, 0, 0); PG8_STAGE(PG8_SA(1, 1), a1 + hstep, voffA);
            PG8_WAIT_V(8); PG8_WAIT_L(0); PG8_BAR; PG8_MMA(0, 0, At, B0); PG8_MMA(0, 1, At, B1); PG8_BAR; PG8_SCHED;
            PG8_LDA(At, 0, 1); PG8_STAGE(PG8_SB(0, 0), b2, voffB); PG8_STAGE(PG8_SB(0, 1), b2 + hstep, voffB); PG8_STAGE(PG8_SA(0, 0), a2, voffA);
            PG8_WAIT_V(8); PG8_WAIT_L(0); PG8_BAR; PG8_MMA(1, 0, At, B0); PG8_MMA(1, 1, At, B1); PG8_BAR; PG8_SCHED;
            PG8_LDB(B0, 1, 0); PG8_LDB(B1, 1, 1); PG8_SCHED; PG8_LDA(At, 1, 0); PG8_STAGE(PG8_SA(0, 1), a2 + hstep, voffA);
            PG8_WAIT_V(8); PG8_WAIT_L(0); PG8_BAR; PG8_MMA(0, 0, At, B0); PG8_MMA(0, 1, At, B1); PG8_BAR; PG8_SCHED;
            PG8_LDA(At, 1, 1); PG8_STAGE(PG8_SB(1, 0), b3, voffB); PG8_STAGE(PG8_SB(1, 1), b3 + hstep, voffB); PG8_STAGE(PG8_SA(1, 0), a3, voffA);
            PG8_WAIT_V(8); PG8_WAIT_L(0); PG8_BAR; PG8_MMA(1, 0, At, B0); PG8_MMA(1, 1, At, B1); PG8_BAR; PG8_SCHED;
            } else {
            PG8_LDB(B0, 0, 0); PG8_SCHED; PG8_LDA(At, 0, 0); PG8_STAGE(PG8_SA(1, 1), a1 + hstep, voffA);
            PG8_WAIT_L(8); PG8_BAR; PG8_WAIT_L(0); PG8_MMA(0, 0, At, B0); PG8_BAR; PG8_SCHED;
            PG8_LDB(B1, 0, 1); PG8_STAGE(PG8_SB(0, 0), b2, voffB);
            PG8_BAR; PG8_WAIT_L(0); PG8_MMA(0, 1, At, B1); PG8_BAR;
            PG8_LDA(At, 0, 1); PG8_STAGE(PG8_SA(0, 0), a2, voffA);
            PG8_BAR; PG8_WAIT_L(0); PG8_MMA(1, 0, At, B0); PG8_BAR; PG8_SCHED;
            PG8_STAGE(PG8_SB(0, 1), b2 + hstep, voffB);
            PG8_WAIT_V(6); PG8_BAR; PG8_MMA(1, 1, At, B1); PG8_BAR;
            PG8_LDB(B0, 1, 0); PG8_SCHED; PG8_LDA(At, 1, 0); PG8_STAGE(PG8_SA(0, 1), a2 + hstep, voffA);
            PG8_WAIT_L(8); PG8_BAR; PG8_WAIT_L(0); PG8_MMA(0, 0, At, B0); PG8_BAR; PG8_SCHED;
            PG8_LDB(B1, 1, 1); PG8_STAGE(PG8_SB(1, 0), b3, voffB);
            PG8_BAR; PG8_WAIT_L(0); PG8_MMA(0, 1, At, B1); PG8_BAR;
            PG8_LDA(At, 1, 1); PG8_STAGE(PG8_SA(1, 0), a3, voffA);
            PG8_BAR; PG8_WAIT_L(0); PG8_MMA(1, 0, At, B0); PG8_BAR; PG8_SCHED;
            PG8_STAGE(PG8_SB(1, 1), b3 + hstep, voffB);
            PG8_WAIT_V(6); PG8_BAR; PG8_MMA(1, 1, At, B1); PG8_BAR;
            }
        }
        if constexpr (ALIGN_EPI) { if (wr == 0) PG8_BAR; }
        if constexpr (!Epi::AFTER_DRAIN) { E(acc, cur, wr, wc, fr, fq); S.done(cur); }
        if (!has_next) break;
#pragma unroll
        for (int a = 0; a < 2; ++a)
#pragma unroll
            for (int b = 0; b < 2; ++b)
#pragma unroll
                for (int m = 0; m < 4; ++m)
#pragma unroll
                    for (int n = 0; n < 2; ++n) acc[a][b][m][n] = (f32x4){0.f, 0.f, 0.f, 0.f};
        cur = nxt; cA = nA; cB = nB; ++ui;
        if constexpr (ALIGN_EPI) { if (wr == 1) PG8_BAR; }
    }
    PG8_WAIT_V(0);
    if constexpr (!ALIGN_EPI) { if (wr == 0) PG8_BAR; }
    PG8_BAR;
    if constexpr (Epi::AFTER_DRAIN) { E.fused(acc, cur, wr, wc, fr, fq, lds, wid, lane); S.done(cur); }
#undef PG8_SA
#undef PG8_SB
#undef PG8_STAGE
#undef PG8_LDA
#undef PG8_LDB
#undef PG8_MMA
#undef PG8_WAIT_V
#undef PG8_WAIT_L
#undef PG8_BAR
#undef PG8_SCHED
}
}
#define GAS __attribute__((address_space(1)))
#define LAS __attribute__((address_space(3)))
typedef unsigned short bf16;
typedef unsigned v4u __attribute__((ext_vector_type(4)));
typedef float f32x4 __attribute__((ext_vector_type(4)));
typedef short bf16x8 __attribute__((ext_vector_type(8)));
typedef GAS unsigned gu32;
typedef GAS unsigned long long gu64;
#define RLX_AGENT __ATOMIC_RELAXED, __HIP_MEMORY_SCOPE_AGENT
#define LDS_WAIT() asm volatile("s_waitcnt lgkmcnt(0)" ::: "memory")
#define VM_WAIT() asm volatile("s_waitcnt vmcnt(0)" ::: "memory")
__device__ __forceinline__ unsigned long long rt() { return __builtin_amdgcn_s_memrealtime(); }
__device__ __forceinline__ unsigned f2bf(float f) { unsigned u = __builtin_bit_cast(unsigned, f); return (u + 0x7fffu + ((u >> 16) & 1u)) >> 16; }
__device__ __forceinline__ unsigned pk2(float lo, float hi) { return f2bf(lo) | (f2bf(hi) << 16); }

#define XB_TMO      128
#define XB_XCNT(j)  (256  + 64 * (j))
#define XB_XSUB(j)  (1280 + 64 * (j))
#define XB_XGEN(j)  (2304 + 64 * (j))
#define XB_TOP      3328
#define XB_TOPGEN   3392
#define XCD_BAR_WORDS 3456
#define XB_SPIN_CAP (1u << 18)

__device__ __forceinline__ unsigned xb_ld(unsigned* p)              { return __hip_atomic_load(p, __ATOMIC_RELAXED, __HIP_MEMORY_SCOPE_AGENT); }
__device__ __forceinline__ unsigned xb_add(unsigned* p, unsigned v) { return __hip_atomic_fetch_add(p, v, __ATOMIC_RELAXED, __HIP_MEMORY_SCOPE_AGENT); }
__device__ __forceinline__ unsigned xb_xcc_id() { return (unsigned)__builtin_amdgcn_s_getreg((3 << 11) | 20) & 0xFu; }
#define XB_SPIN(cond, bar) do { unsigned _sp = 0; while (cond) { __builtin_amdgcn_s_sleep(1); \
    if ((++_sp & 255u) == 0u) { if (xb_ld(&(bar)[XB_TMO])) break; if (_sp > XB_SPIN_CAP) { atomicAdd(&(bar)[XB_TMO], 1u); break; } } } } while (0)

struct XcdBarrier {
    unsigned* bar; unsigned x;
    volatile LAS unsigned* st;
};

__device__ __forceinline__ XcdBarrier xcd_barrier_post(unsigned* bar, volatile LAS unsigned* st) {
    XcdBarrier b; b.bar = bar; b.x = xb_xcc_id(); b.st = st;
    if (threadIdx.x == 0) (void)xb_add(&bar[XB_XCNT(b.x)], 1u);
    return b;
}
__device__ __forceinline__ void xcd_barrier_complete(unsigned* bar, unsigned x, unsigned& nloc, unsigned& nx) {
    const unsigned G = gridDim.x * gridDim.y * gridDim.z;
    unsigned sum, cnt, mine, sp = 0u;
    for (;;) {
        sum = 0u; cnt = 0u; mine = 0u;
#pragma unroll
        for (unsigned j = 0; j < 16; ++j) { const unsigned c = xb_ld(&bar[XB_XCNT(j)]); sum += c; cnt += (c > 0u) ? 1u : 0u; mine = (j == x) ? c : mine; }
        if (sum == G) break;
        __builtin_amdgcn_s_sleep(1);
        if ((++sp & 255u) == 0u) { if (xb_ld(&bar[XB_TMO])) break; if (sp > XB_SPIN_CAP) { atomicAdd(&bar[XB_TMO], 1u); break; } }
    }
    nloc = mine > 0u ? mine : 1u; nx = cnt > 0u ? cnt : 1u;
}

__device__ __forceinline__ void xcd_barrier(const XcdBarrier& b) {
    asm volatile("s_waitcnt vmcnt(0)" ::: "memory");
    __syncthreads();
    if (threadIdx.x == 0) {
        unsigned* bar = b.bar;
        __builtin_amdgcn_s_waitcnt(0);
        unsigned nloc = b.st[0], nx = b.st[1];
        if (nloc == 0u) { xcd_barrier_complete(bar, b.x, nloc, nx); b.st[0] = nloc; b.st[1] = nx; }
        const unsigned old = xb_add(&bar[XB_XSUB(b.x)], 1u);
        const unsigned gen = old / nloc;
        if (old + 1u == (gen + 1u) * nloc) {
            __builtin_amdgcn_fence(__ATOMIC_RELEASE, "agent");
            asm volatile("s_waitcnt vmcnt(0)" ::: "memory");
            const unsigned og = xb_add(&bar[XB_TOP], 1u);
            const unsigned tg = og / nx;
            if (og + 1u == (tg + 1u) * nx) xb_add(&bar[XB_TOPGEN], 1u);
            else XB_SPIN(xb_ld(&bar[XB_TOPGEN]) == tg, bar);
            __builtin_amdgcn_fence(__ATOMIC_ACQUIRE, "agent");
            xb_add(&bar[XB_XGEN(b.x)], 1u);
            asm volatile("s_waitcnt vmcnt(0)" ::: "memory");
        } else {
            XB_SPIN(xb_ld(&bar[XB_XGEN(b.x)]) == gen, bar);
            __builtin_amdgcn_fence(__ATOMIC_ACQUIRE, "agent");
            asm volatile("s_waitcnt vmcnt(0)" ::: "memory");
        }
    }
    __syncthreads();
}
typedef float f32x2_pair __attribute__((ext_vector_type(2)));

constexpr int NWAVES = 8;
constexpr int DM = 1024, FF = 4096, NIN = 9216;
constexpr int MP = 65536, MS = 1024, M = MP + MS;
constexpr int PAST = 4096;
constexpr size_t MiB = 1u << 20;
constexpr size_t REG_E = (size_t)M * DM;
constexpr size_t WS_CTL = 0, CTL_ZERO_BYTES = 1 * MiB;
constexpr size_t WS_WIN = 2 * MiB, WS_WOUT = 20 * MiB, WS_WUP = 22 * MiB, WS_WDN = 30 * MiB;
constexpr size_t WS_ROPE = 38 * MiB;
constexpr size_t WS_SSQ = 43 * MiB;
constexpr size_t WS_RSS = 48 * MiB;
constexpr size_t WS_XN = 54 * MiB;
constexpr size_t WS_R = 184 * MiB;
constexpr size_t WS_END = WS_R + 9 * REG_E * 2;
static_assert(WS_ROPE + (size_t)4128 * 128 * 8 <= WS_SSQ && WS_SSQ + (size_t)M * 64 <= WS_RSS && WS_RSS + (size_t)M * 64 <= WS_XN && WS_XN + REG_E * 2 <= WS_R, "ws map");
constexpr size_t O_Y = 0, O_KP = 68157440, O_VP = 135266304, O_SP = 202375168, O_KS = 206569472, O_VS = 207618048, O_SS = 208666624, O_END = 217055232;
constexpr int CW_BAR = 4096;
constexpr int RING_BYTES = 131072, XCH_OFF = RING_BYTES + 512, MISC_OFF = XCH_OFF + 8192, LDS_BYTES = 147456;
static_assert(MISC_OFF + 64 <= LDS_BYTES, "LDS map");

typedef short s16x4 __attribute__((ext_vector_type(4)));
typedef unsigned v2u __attribute__((ext_vector_type(2)));
#define DI __device__ __forceinline__
#define MFMA16(a, b, c) __builtin_amdgcn_mfma_f32_16x16x32_bf16((a), (b), (c), 0, 0, 0)
#define LBAR() do { asm volatile("s_waitcnt lgkmcnt(0)" ::: "memory"); __builtin_amdgcn_s_barrier(); asm volatile("" ::: "memory"); } while (0)
typedef short v4i16_t __attribute__((ext_vector_type(4)));
DI s16x4 trd(const LAS unsigned char* p) { return __builtin_bit_cast(s16x4, __builtin_amdgcn_ds_read_tr16_b64_v4i16((LAS v4i16_t*)p)); }
DI bf16x8 cat8(s16x4 lo, s16x4 hi) { return (bf16x8){lo[0], lo[1], lo[2], lo[3], hi[0], hi[1], hi[2], hi[3]}; }
DI float bflo(unsigned u) { return __uint_as_float(u << 16); }
DI float bfhi(unsigned u) { return __uint_as_float(u & 0xffff0000u); }
using pg8::cvtpk;
DI float wave_sum(float v) {
#pragma unroll
    for (int o = 1; o < 64; o <<= 1) v += __shfl_xor(v, o);
    return v;
}
constexpr float LOG2E = 1.4426950408889634f, LN2 = 0.6931471805599453f;

struct Args {
    const float *xp, *xs, *ck, *cv, *st, *nmix, *win, *rnw, *qnw, *knw, *wout, *nmlp, *wup, *wdn;
    float* out; unsigned char* ws;
};

DI void p0_transpose_item(const float* W, int K, int N, bf16* WT, const float* ksc, LAS float* scr, int item, int lane) {
    const int nblk = N / 32, kb = item / nblk, nb = item % nblk, k0 = 64 * kb, n0 = 32 * nb;
#pragma unroll 8
    for (int i = 0; i < 32; ++i) { const int kk = 2 * i + (lane >> 5); float v = W[(size_t)(k0 + kk) * N + n0 + (lane & 31)]; if (ksc) v *= ksc[k0 + kk]; scr[kk * 33 + (lane & 31)] = v; }
    LDS_WAIT(); asm volatile("" ::: "memory");
    const int c = lane & 7;
#pragma unroll
    for (int j = 0; j < 4; ++j) { const int n = (lane >> 3) + 8 * j; const LAS float* s = scr + (8 * c) * 33 + n;
        v4u o; o.x = cvtpk(s[0 * 33], s[1 * 33]); o.y = cvtpk(s[2 * 33], s[3 * 33]); o.z = cvtpk(s[4 * 33], s[5 * 33]); o.w = cvtpk(s[6 * 33], s[7 * 33]);
        *(GAS v4u*)(WT + (size_t)(n0 + n) * K + k0 + 8 * c) = o; }
    LDS_WAIT(); asm volatile("" ::: "memory");
}
DI void p0_prologue(const Args& a, LAS unsigned char* lds, int vcu, int G, int wave, int lane) {
    unsigned char* ws = a.ws;
    LAS float* scr = (LAS float*)(lds + wave * 16384);
    const int gw = vcu * NWAVES + wave, NGW = G * NWAVES;
    constexpr int I_IN = (DM / 64) * (NIN / 32), I_O = (DM / 64) * (DM / 32), I_U = (DM / 64) * (FF / 32), I_D = (FF / 64) * (DM / 32);
    constexpr int NITEMS = I_IN + I_O + I_U + I_D;
    for (int it = gw; it < NITEMS; it += NGW) {
        int r = it;
        if (r < I_IN) { p0_transpose_item(a.win, DM, NIN, (bf16*)(ws + WS_WIN), nullptr, scr, r, lane); continue; } r -= I_IN;
        if (r < I_O) { p0_transpose_item(a.wout, DM, DM, (bf16*)(ws + WS_WOUT), nullptr, scr, r, lane); continue; } r -= I_O;
        if (r < I_U) { p0_transpose_item(a.wup, DM, FF, (bf16*)(ws + WS_WUP), a.nmlp, scr, r, lane); continue; } r -= I_U;
        p0_transpose_item(a.wdn, FF, DM, (bf16*)(ws + WS_WDN), nullptr, scr, r, lane);
    }
    {
        f32x4 wv[4];
#pragma unroll
        for (int j = 0; j < 4; ++j) wv[j] = ((const GAS f32x4*)a.nmix)[lane + 64 * j];
        bf16* XN = (bf16*)(ws + WS_XN);
        for (int m = gw; m < M; m += NGW) {
            const float* xrow = (m < MP) ? a.xp + (size_t)m * DM : a.xs + (size_t)(m - MP) * DM;
            const GAS f32x4* xr = (const GAS f32x4*)xrow + lane;
            f32x4 v[4]; float s = 0.f;
#pragma unroll
            for (int j = 0; j < 4; ++j) { v[j] = xr[64 * j]; s += (v[j].x * v[j].x + v[j].y * v[j].y) + (v[j].z * v[j].z + v[j].w * v[j].w); }
            const float rstd = 1.0f / sqrtf(wave_sum(s) * (1.0f / DM) + 1e-6f);
            GAS v2u* o8 = (GAS v2u*)(XN + (size_t)m * DM) + lane;
#pragma unroll
            for (int j = 0; j < 4; ++j) { const f32x4 y = v[j] * rstd * wv[j]; v2u o; o.x = cvtpk(y.x, y.y); o.y = cvtpk(y.z, y.w); o8[64 * j] = o; }
        }
    }
    {
        float* rope = (float*)(ws + WS_ROPE);
        for (int idx = gw * 64 + lane; idx < 4128 * 128; idx += NGW * 64) {
            const int pos = idx >> 7, j = idx & 127;
            const float inv = powf(10000.0f, -(float)j * (1.0f / 128.0f));
            const float ang = (float)pos * inv;
            float sn, cs; sincosf(ang, &sn, &cs);
            *(GAS f32x2_pair*)(rope + (size_t)idx * 2) = (f32x2_pair){cs, sn};
        }
    }
}

constexpr int RT_QS = 0, RT_KS = 33792, RT_VS = 67584, RT_VDS = 76800, RT_PS = 86016, RT_STS = 95232, RT_RXS = 129024;
static_assert(RT_RXS + 1024 <= RING_BYTES, "retention LDS map");
template <bool SAMPLE>
DI void ret_unit(const Args& a, LAS unsigned char* L, int b, int h, int s, int tid, int lane, int w) {
    const int c15 = lane & 15, g = lane >> 4, q4 = c15 >> 2, p4 = c15 & 3;
    constexpr int Lc = SAMPLE ? 32 : 64, NSTEP = SAMPLE ? 1 : 64;
    const float lg2 = log2f(1.0f - exp2f(-5.0f - (float)h));
    const size_t rowbase = SAMPLE ? (size_t)MP + 32 * b : (size_t)4096 * b;
    const bf16* RQ = (const bf16*)(a.ws + WS_R), *RK = RQ + REG_E, *RV = RQ + 2 * REG_E;
    bf16* ORET = (bf16*)(a.ws + WS_XN);
    float* RSS = (float*)(a.ws + WS_RSS);
    f32x4 S[2][4];
    const size_t sbase = ((size_t)(b * 4 + h) * 256) * 256 + 64 * s;
    {
        const float* sp0 = a.st + sbase + (size_t)(32 * w + 4 * g) * 256 + c15;
#pragma unroll
        for (int k2 = 0; k2 < 2; ++k2)
#pragma unroll
            for (int dt = 0; dt < 4; ++dt)
#pragma unroll
                for (int r = 0; r < 4; ++r) S[k2][dt][r] = SAMPLE ? sp0[(16 * k2 + r) * 256 + 16 * dt] : 0.f;
    }
    v4u pq[4], pk[4], pv;
    const int vrow = tid >> 3, vpc = tid & 7;
#define RT_LOAD(c) do { \
        _Pragma("unroll") for (int p_ = 0; p_ < 4; ++p_) { const int idx_ = tid + 512 * p_, row_ = idx_ >> 5, pc_ = idx_ & 31; \
            if (!SAMPLE || row_ < 32) { const size_t go_ = (rowbase + (size_t)64 * (c) + row_) * 1024 + 256 * h + 8 * pc_; pq[p_] = *(const GAS v4u*)(RQ + go_); pk[p_] = *(const GAS v4u*)(RK + go_); } \
            else { pq[p_] = (v4u){0u, 0u, 0u, 0u}; pk[p_] = (v4u){0u, 0u, 0u, 0u}; } } \
        if (!SAMPLE || vrow < 32) pv = *(const GAS v4u*)(RV + (rowbase + (size_t)64 * (c) + vrow) * 1024 + 256 * h + 64 * s + 8 * vpc); else pv = (v4u){0u, 0u, 0u, 0u}; } while (0)
#define RT_WRITE() do { \
        _Pragma("unroll") for (int p_ = 0; p_ < 4; ++p_) { const int idx_ = tid + 512 * p_, row_ = idx_ >> 5, pc_ = idx_ & 31; \
            *(LAS v4u*)(L + RT_QS + row_ * 528 + pc_ * 16) = pq[p_]; *(LAS v4u*)(L + RT_KS + row_ * 528 + pc_ * 16) = pk[p_]; } \
        *(LAS v4u*)(L + RT_VS + vrow * 144 + vpc * 16) = pv; \
        { const float kd_ = exp2f(lg2 * (float)(Lc - 1 - vrow)); v4u d_; \
          d_.x = cvtpk(bflo(pv.x) * kd_, bfhi(pv.x) * kd_); d_.y = cvtpk(bflo(pv.y) * kd_, bfhi(pv.y) * kd_); d_.z = cvtpk(bflo(pv.z) * kd_, bfhi(pv.z) * kd_); d_.w = cvtpk(bflo(pv.w) * kd_, bfhi(pv.w) * kd_); \
          *(LAS v4u*)(L + RT_VDS + vrow * 144 + vpc * 16) = d_; } } while (0)
    RT_LOAD(0); RT_WRITE();
    const int jt = w >> 1, itp = w & 1, dto = w >> 1;
    const float gL = exp2f(lg2 * (float)Lc);
    for (int c = 0; c < NSTEP; ++c) {
        LBAR();
        if (c + 1 < NSTEP) RT_LOAD(c + 1);
        bf16x8 bq[2][8];
        {
            f32x4 sc[2] = {(f32x4){0.f, 0.f, 0.f, 0.f}, (f32x4){0.f, 0.f, 0.f, 0.f}};
            const LAS unsigned char* kp = L + RT_KS + (16 * jt + c15) * 528 + g * 16;
            const LAS unsigned char* qp = L + RT_QS + (32 * itp + c15) * 528 + g * 16;
#pragma unroll
            for (int ks = 0; ks < 8; ++ks) {
                const bf16x8 ak = *(const LAS bf16x8*)(kp + ks * 64);
                bq[0][ks] = *(const LAS bf16x8*)(qp + ks * 64); bq[1][ks] = *(const LAS bf16x8*)(qp + 16 * 528 + ks * 64);
                sc[0] = MFMA16(ak, bq[0][ks], sc[0]); sc[1] = MFMA16(ak, bq[1][ks], sc[1]);
            }
#pragma unroll
            for (int t = 0; t < 2; ++t) {
                const int i = 32 * itp + 16 * t + c15, j0 = 16 * jt + 4 * g;
                float p[4];
#pragma unroll
                for (int r = 0; r < 4; ++r) { const int d = i - (j0 + r); p[r] = sc[t][r] * exp2f(lg2 * (float)(d < 0 ? -d : d)); }
                v2u o; o.x = cvtpk(p[0], p[1]); o.y = cvtpk(p[2], p[3]);
                *(LAS v2u*)(L + RT_PS + i * 144 + j0 * 2) = o;
            }
        }
#pragma unroll
        for (int k2 = 0; k2 < 2; ++k2)
#pragma unroll
            for (int dt = 0; dt < 4; ++dt) { v2u o; o.x = cvtpk(S[k2][dt][0], S[k2][dt][1]); o.y = cvtpk(S[k2][dt][2], S[k2][dt][3]);
                *(LAS v2u*)(L + RT_STS + (16 * dt + c15) * 528 + (16 * (2 * w + k2) + 4 * g) * 2) = o; }
        LBAR();
        {
            f32x4 oc[2] = {(f32x4){0.f, 0.f, 0.f, 0.f}, (f32x4){0.f, 0.f, 0.f, 0.f}};
            const LAS unsigned char* sp = L + RT_STS + (16 * dto + c15) * 528 + g * 16;
#pragma unroll
            for (int ks = 0; ks < 8; ++ks) { const bf16x8 as = *(const LAS bf16x8*)(sp + ks * 64); oc[0] = MFMA16(as, bq[0][ks], oc[0]); oc[1] = MFMA16(as, bq[1][ks], oc[1]); }
#pragma unroll
            for (int t = 0; t < 2; ++t) { const int i = 32 * itp + 16 * t + c15; oc[t] = oc[t] * exp2f(lg2 * (float)(i + 1)); }
#pragma unroll
            for (int k2 = 0; k2 < 2; ++k2) {
                const LAS unsigned char* vp = L + RT_VS + (32 * k2 + 8 * g + q4) * 144 + (16 * dto + 4 * p4) * 2;
                const bf16x8 av = cat8(trd(vp), trd(vp + 4 * 144));
#pragma unroll
                for (int t = 0; t < 2; ++t) { const int i = 32 * itp + 16 * t + c15;
                    const bf16x8 bp = *(const LAS bf16x8*)(L + RT_PS + i * 144 + (32 * k2 + 8 * g) * 2); oc[t] = MFMA16(av, bp, oc[t]); }
            }
#pragma unroll
            for (int t = 0; t < 2; ++t) {
                const int i = 32 * itp + 16 * t + c15;
                float ss = (oc[t][0] * oc[t][0] + oc[t][1] * oc[t][1]) + (oc[t][2] * oc[t][2] + oc[t][3] * oc[t][3]);
                ss += __shfl_xor(ss, 16); ss += __shfl_xor(ss, 32);
                if (g == 0) ((LAS float*)(L + RT_RXS))[dto * 64 + i] = ss;
                if (!SAMPLE || i < 32) { v2u o; o.x = cvtpk(oc[t][0], oc[t][1]); o.y = cvtpk(oc[t][2], oc[t][3]);
                    *(GAS v2u*)(ORET + (rowbase + (size_t)64 * c + i) * 1024 + 256 * h + 64 * s + 16 * dto + 4 * g) = o; }
            }
        }
#pragma unroll
        for (int k2 = 0; k2 < 2; ++k2)
#pragma unroll
            for (int dt = 0; dt < 4; ++dt) S[k2][dt] = S[k2][dt] * gL;
#pragma unroll
        for (int ks = 0; ks < 2; ++ks) {
            const int tok = 32 * ks + 8 * g + q4;
            bf16x8 ak[2];
#pragma unroll
            for (int k2 = 0; k2 < 2; ++k2) { const LAS unsigned char* kp = L + RT_KS + tok * 528 + (16 * (2 * w + k2) + 4 * p4) * 2; ak[k2] = cat8(trd(kp), trd(kp + 4 * 528)); }
#pragma unroll
            for (int dt = 0; dt < 4; ++dt) { const LAS unsigned char* vp = L + RT_VDS + tok * 144 + (16 * dt + 4 * p4) * 2; const bf16x8 bv = cat8(trd(vp), trd(vp + 4 * 144));
                S[0][dt] = MFMA16(ak[0], bv, S[0][dt]); S[1][dt] = MFMA16(ak[1], bv, S[1][dt]); }
        }
        LBAR();
        if (tid < 64 && (!SAMPLE || tid < 32)) { const LAS float* rx = (const LAS float*)(L + RT_RXS);
            RSS[(rowbase + (size_t)64 * c + tid) * 16 + h * 4 + s] = (rx[tid] + rx[64 + tid]) + (rx[128 + tid] + rx[192 + tid]); }
        if (c + 1 < NSTEP) RT_WRITE();
    }
    {
        int ln = lane; asm volatile("" : "+v"(ln));
        float* so = a.out + (SAMPLE ? O_SS : O_SP) + sbase + (size_t)(32 * w + 4 * (ln >> 4)) * 256 + (ln & 15);
#pragma unroll
        for (int k2 = 0; k2 < 2; ++k2)
#pragma unroll
            for (int dt = 0; dt < 4; ++dt)
#pragma unroll
                for (int r = 0; r < 4; ++r) so[(16 * k2 + r) * 256 + 16 * dt] = S[k2][dt][r];
    }
    LBAR();
#undef RT_LOAD
#undef RT_WRITE
}

constexpr int SB_KS = 0, SB_VS = 34816, SB_FLAGS = 69632, SB_TILE = 17408;
constexpr float SB_EXIT = -110.0f;
template <bool SAMPLE>
DI void sb_unit(const Args& a, LAS unsigned char* L, int b, int h, int qb, int tid, int lane, int w) {
    const int c15 = lane & 15, g = lane >> 4, q4 = c15 >> 2, p4 = c15 & 3;
    const bf16* R0 = (const bf16*)(a.ws + WS_R);
    const bf16 *RG = R0 + 3 * REG_E, *SQ = R0 + 4 * REG_E, *SK = R0 + 5 * REG_E, *SV = R0 + 6 * REG_E, *GA = R0 + 7 * REG_E, *GB = R0 + 8 * REG_E;
    const bf16* ORET = (const bf16*)(a.ws + WS_XN);
    bf16* MIX = (bf16*)(a.ws + WS_R);
    const float* RSS = (const float*)(a.ws + WS_RSS);
    const bool wvalid = SAMPLE ? (w < 2) : true;
    const int qwbase = SAMPLE ? PAST + 16 * w : 128 * qb + 16 * w;
    const int qpos = qwbase + c15;
    const size_t qrow = SAMPLE ? (size_t)MP + 32 * b + 16 * w + c15 : (size_t)4096 * b + qpos;
    bf16x8 bq[4];
#pragma unroll
    for (int ks = 0; ks < 4; ++ks) bq[ks] = wvalid ? *(const GAS bf16x8*)(SQ + qrow * 1024 + 128 * h + 32 * ks + 8 * g) : (bf16x8){0, 0, 0, 0, 0, 0, 0, 0};
    bf16x8 ones, tri0, tri1;
#pragma unroll
    for (int e = 0; e < 8; ++e) { ones[e] = (short)0x3f80; tri0[e] = (e < 4) ? ((4 * g + e > c15) ? (short)0x3f80 : (short)0) : (short)0x3f80; tri1[e] = (e < 4) ? (short)0 : ((4 * g + e - 4 > c15) ? (short)0x3f80 : (short)0); }
    const int T0 = SAMPLE ? 64 : 2 * qb + 1;
    float carry = 0.f;
    f32x4 oacc[8];
#pragma unroll
    for (int dt = 0; dt < 8; ++dt) oacc[dt] = (f32x4){0.f, 0.f, 0.f, 0.f};
    const int kl0 = tid >> 4, dp = tid & 15;
    v4u tk[2], tv[2]; f32x4 fk[2][2], fv[2][2];
    {
#pragma unroll
        for (int p = 0; p < 2; ++p) { const int kl = kl0 + 32 * p;
            if (!SAMPLE) { const size_t go = ((size_t)4096 * b + 64 * T0 + kl) * 1024 + 128 * h + 8 * dp; tk[p] = *(const GAS v4u*)(SK + go); tv[p] = *(const GAS v4u*)(SV + go); }
            else if (kl < 32) { const size_t go = ((size_t)MP + 32 * b + kl) * 1024 + 128 * h + 8 * dp; tk[p] = *(const GAS v4u*)(SK + go); tv[p] = *(const GAS v4u*)(SV + go); }
            else { tk[p] = (v4u){0u, 0u, 0u, 0u}; tv[p] = (v4u){0u, 0u, 0u, 0u}; }
            *(LAS v4u*)(L + SB_KS + kl * 272 + dp * 16) = tk[p]; *(LAS v4u*)(L + SB_VS + kl * 272 + dp * 16) = tv[p]; }
    }
    for (int it = 0;; ++it) {
        const int T = T0 - it, buf = it & 1;
        LBAR();
        if (it > 0) { const LAS unsigned* fl = (const LAS unsigned*)(L + SB_FLAGS) + 8 * ((it - 1) & 1);
            const unsigned any = (fl[0] | fl[1]) | (fl[2] | fl[3]) | (fl[4] | fl[5]) | (fl[6] | fl[7]);
            if (__builtin_amdgcn_readfirstlane(any) == 0u) break; }
        if (T > 0) {
#pragma unroll
            for (int p = 0; p < 2; ++p) { const int kl = kl0 + 32 * p;
                if (!SAMPLE) { const size_t go = ((size_t)4096 * b + 64 * (T - 1) + kl) * 1024 + 128 * h + 8 * dp; tk[p] = *(const GAS v4u*)(SK + go); tv[p] = *(const GAS v4u*)(SV + go); }
                else { const size_t go = (((size_t)b * 4096 + 64 * (T - 1) + kl) * 8 + h) * 128 + 8 * dp;
                    fk[p][0] = *(const GAS f32x4*)(a.ck + go); fk[p][1] = *(const GAS f32x4*)(a.ck + go + 4); fv[p][0] = *(const GAS f32x4*)(a.cv + go); fv[p][1] = *(const GAS f32x4*)(a.cv + go + 4); } }
        }
        if (wvalid && 64 * T < qwbase + 16) {
            const LAS unsigned char* kb = L + SB_KS + buf * SB_TILE + c15 * 272 + g * 16;
            f32x4 z[4];
#pragma unroll
            for (int j = 0; j < 4; ++j) z[j] = (f32x4){0.f, 0.f, 0.f, 0.f};
#pragma unroll
            for (int ks = 0; ks < 4; ++ks)
#pragma unroll
                for (int j = 0; j < 4; ++j) { const bf16x8 ak = *(const LAS bf16x8*)(kb + j * 16 * 272 + ks * 64); z[j] = MFMA16(ak, bq[ks], z[j]); }
            float u[4][4]; unsigned uh[4][2], ul[4][2];
#pragma unroll
            for (int j = 0; j < 4; ++j) {
#pragma unroll
                for (int r = 0; r < 4; ++r) { const int key = 64 * T + 16 * j + 4 * g + r; const float zz = z[j][r];
                    const float sp = fmaxf(zz, 0.f) + __builtin_amdgcn_logf(1.0f + __builtin_amdgcn_exp2f(-fabsf(zz) * LOG2E)) * LN2;
                    u[j][r] = (key < qpos) ? -sp : 0.f; }
                uh[j][0] = cvtpk(u[j][0], u[j][1]); uh[j][1] = cvtpk(u[j][2], u[j][3]);
                ul[j][0] = cvtpk(u[j][0] - bflo(uh[j][0]), u[j][1] - bfhi(uh[j][0])); ul[j][1] = cvtpk(u[j][2] - bflo(uh[j][1]), u[j][3] - bfhi(uh[j][1]));
            }
            bf16x8 bh[2], bl[2];
#pragma unroll
            for (int k2 = 0; k2 < 2; ++k2) { bh[k2] = __builtin_bit_cast(bf16x8, (v4u){uh[2 * k2][0], uh[2 * k2][1], uh[2 * k2 + 1][0], uh[2 * k2 + 1][1]});
                bl[k2] = __builtin_bit_cast(bf16x8, (v4u){ul[2 * k2][0], ul[2 * k2][1], ul[2 * k2 + 1][0], ul[2 * k2 + 1][1]}); }
            const f32x4 zero4 = (f32x4){0.f, 0.f, 0.f, 0.f};
            f32x4 af[4], tot;
            af[0] = MFMA16(tri0, bh[0], zero4); af[0] = MFMA16(tri0, bl[0], af[0]); af[0] = MFMA16(ones, bh[1], af[0]); af[0] = MFMA16(ones, bl[1], af[0]);
            af[1] = MFMA16(tri1, bh[0], zero4); af[1] = MFMA16(tri1, bl[0], af[1]); af[1] = MFMA16(ones, bh[1], af[1]); af[1] = MFMA16(ones, bl[1], af[1]);
            af[2] = MFMA16(tri0, bh[1], zero4); af[2] = MFMA16(tri0, bl[1], af[2]);
            af[3] = MFMA16(tri1, bh[1], zero4); af[3] = MFMA16(tri1, bl[1], af[3]);
            tot = MFMA16(ones, bh[0], zero4); tot = MFMA16(ones, bl[0], tot); tot = MFMA16(ones, bh[1], tot); tot = MFMA16(ones, bl[1], tot);
            unsigned wp[4][2];
#pragma unroll
            for (int j = 0; j < 4; ++j) { float wv[4];
#pragma unroll
                for (int r = 0; r < 4; ++r) { const int key = 64 * T + 16 * j + 4 * g + r;
                    const float ex = __builtin_amdgcn_exp2f((z[j][r] + u[j][r] + af[j][r] + carry) * LOG2E); wv[r] = (key < qpos) ? ex : 0.f; }
                wp[j][0] = cvtpk(wv[0], wv[1]); wp[j][1] = cvtpk(wv[2], wv[3]); }
            carry += tot[0];
            const LAS unsigned char* vb = L + SB_VS + buf * SB_TILE + (4 * g + q4) * 272 + 8 * p4;
#pragma unroll
            for (int k2 = 0; k2 < 2; ++k2) { const bf16x8 bw = __builtin_bit_cast(bf16x8, (v4u){wp[2 * k2][0], wp[2 * k2][1], wp[2 * k2 + 1][0], wp[2 * k2 + 1][1]});
#pragma unroll
                for (int dt = 0; dt < 8; ++dt) { const bf16x8 av = cat8(trd(vb + (32 * k2) * 272 + dt * 32), trd(vb + (32 * k2 + 16) * 272 + dt * 32)); oacc[dt] = MFMA16(av, bw, oacc[dt]); } }
        }
        { const bool more = wvalid && (carry >= SB_EXIT); const unsigned long long bal = __ballot(more);
          if (lane == 0) ((LAS unsigned*)(L + SB_FLAGS))[8 * (it & 1) + w] = (bal != 0ull) ? 1u : 0u; }
        if (T == 0) break;
        {
            const int nb = (it + 1) & 1;
#pragma unroll
            for (int p = 0; p < 2; ++p) { const int kl = kl0 + 32 * p;
                if (SAMPLE) { tk[p] = (v4u){cvtpk(fk[p][0][0], fk[p][0][1]), cvtpk(fk[p][0][2], fk[p][0][3]), cvtpk(fk[p][1][0], fk[p][1][1]), cvtpk(fk[p][1][2], fk[p][1][3])};
                    tv[p] = (v4u){cvtpk(fv[p][0][0], fv[p][0][1]), cvtpk(fv[p][0][2], fv[p][0][3]), cvtpk(fv[p][1][0], fv[p][1][1]), cvtpk(fv[p][1][2], fv[p][1][3])}; }
                *(LAS v4u*)(L + SB_KS + nb * SB_TILE + kl * 272 + dp * 16) = tk[p]; *(LAS v4u*)(L + SB_VS + nb * SB_TILE + kl * 272 + dp * 16) = tv[p]; }
        }
    }
    if (wvalid) {
        const int hr = h >> 1;
        const f32x4* rp = (const f32x4*)(RSS + qrow * 16 + hr * 4);
        const f32x4 r4 = rp[0];
        const float rstd = 1.0f / sqrtf(((r4[0] + r4[1]) + (r4[2] + r4[3])) * (1.0f / 256.0f) + 1e-6f);
#pragma unroll
        for (int dt = 0; dt < 8; ++dt) {
            const int col = 128 * h + 16 * dt + 4 * g; const size_t go = qrow * 1024 + col;
            const v2u orr = *(const GAS v2u*)(ORET + go), rg = *(const GAS v2u*)(RG + go), ga = *(const GAS v2u*)(GA + go), gb = *(const GAS v2u*)(GB + go);
            const f32x4 rw = *(const f32x4*)(a.rnw + (col & 255) + 256 * hr);
            float m[4];
            m[0] = bflo(ga.x) * (bflo(orr.x) * rstd * rw[0] * bflo(rg.x)) + bflo(gb.x) * oacc[dt][0];
            m[1] = bfhi(ga.x) * (bfhi(orr.x) * rstd * rw[1] * bfhi(rg.x)) + bfhi(gb.x) * oacc[dt][1];
            m[2] = bflo(ga.y) * (bflo(orr.y) * rstd * rw[2] * bflo(rg.y)) + bflo(gb.y) * oacc[dt][2];
            m[3] = bfhi(ga.y) * (bfhi(orr.y) * rstd * rw[3] * bfhi(rg.y)) + bfhi(gb.y) * oacc[dt][3];
            v2u o; o.x = cvtpk(m[0], m[1]); o.y = cvtpk(m[2], m[3]);
            *(GAS v2u*)(MIX + go) = o;
        }
    }
    LBAR();
}

__global__ void __launch_bounds__(NWAVES * 64, 2) mk_fwd(Args a) {
    extern __shared__ __attribute__((aligned(16))) unsigned char lds_raw[];
    LAS unsigned char* lds = (LAS unsigned char*)lds_raw;
    const int tid = threadIdx.x;
    const int G = gridDim.x, bx = blockIdx.x, vcu = (G % 8 == 0) ? (bx % 8) * (G / 8) + bx / 8 : bx;
    volatile LAS unsigned* MISC = (volatile LAS unsigned*)(lds + MISC_OFF);
    if (tid < 16) MISC[tid] = 0u;
    __syncthreads();
    XcdBarrier bar = xcd_barrier_post((unsigned*)(a.ws + WS_CTL) + CW_BAR, MISC + 8);
    unsigned char* ws = a.ws;
    bf16* R0 = (bf16*)(ws + WS_R);

#define PHASE_IDS(T_, L_, W_) int T_ = threadIdx.x; asm volatile("" : "+v"(T_)); const int L_ = T_ & 63, W_ = __builtin_amdgcn_readfirstlane(T_ >> 6)
    { PHASE_IDS(t0, l0, w0); (void)t0; p0_prologue(a, lds, vcu, G, w0, l0); }
    xcd_barrier(bar);

    {
        pg8::Gemm g{(const pg8::bf16_t*)(ws + WS_XN), (const pg8::bf16_t*)(ws + WS_WIN), M, NIN, DM}; pg8::StaticOrder S; S.init(M, NIN, G, bx);
        pg8::EpiIn E{(pg8::bf16_t*)R0, a.out, (const float*)(ws + WS_ROPE), a.qnw, a.knw, (LAS float*)(lds + XCH_OFF)};
        pg8::gemm_phase<pg8::EpiIn, pg8::StaticOrder, true, true>(lds, g, S, E);
    }
    xcd_barrier(bar);

    { PHASE_IDS(t1, l1, w1); for (int u = vcu; u < 512; u += G) ret_unit<true>(a, lds, (u >> 2) >> 2, (u >> 2) & 3, u & 3, t1, l1, w1); }
    { PHASE_IDS(t2, l2, w2); for (int u = vcu; u < 256; u += G) ret_unit<false>(a, lds, (u >> 2) >> 2, (u >> 2) & 3, u & 3, t2, l2, w2); }
    xcd_barrier(bar);

    { PHASE_IDS(t3, l3, w3); for (int u = vcu; u < 256; u += G) sb_unit<true>(a, lds, u >> 3, u & 7, 0, t3, l3, w3); }
    { PHASE_IDS(t4, l4, w4); for (int u = vcu; u < 4096; u += G) sb_unit<false>(a, lds, (u >> 5) >> 3, (u >> 5) & 7, u & 31, t4, l4, w4); }
    xcd_barrier(bar);

    {
        pg8::Gemm g{(const pg8::bf16_t*)R0, (const pg8::bf16_t*)(ws + WS_WOUT), M, DM, DM}; pg8::StaticOrder S; S.init(M, DM, G, bx);
        pg8::EpiRes1 E{a.xp, a.xs, a.out, (pg8::bf16_t*)(R0 + REG_E), (float*)(ws + WS_SSQ)};
        pg8::gemm_phase<pg8::EpiRes1, pg8::StaticOrder, true, true>(lds, g, S, E);
    }
    xcd_barrier(bar);

    {
        pg8::Gemm g{(const pg8::bf16_t*)(R0 + REG_E), (const pg8::bf16_t*)(ws + WS_WUP), M, FF, DM}; pg8::StaticOrder S; S.init(M, FF, G, bx);
        pg8::EpiUp E{(pg8::bf16_t*)(R0 + 4 * REG_E), (const float*)(ws + WS_SSQ)};
        pg8::gemm_phase<pg8::EpiUp, pg8::StaticOrder, true, true>(lds, g, S, E);
    }
    xcd_barrier(bar);

    {
        pg8::Gemm g{(const pg8::bf16_t*)(R0 + 4 * REG_E), (const pg8::bf16_t*)(ws + WS_WDN), M, DM, FF}; pg8::StaticOrder S; S.init(M, DM, G, bx);
        pg8::EpiDown E{a.out};
        pg8::gemm_phase<pg8::EpiDown, pg8::StaticOrder, true, true>(lds, g, S, E);
    }
}

extern "C" void kernel_launch(void* const* d_in, const int* in_sizes, int n_in, void* d_out, int out_size, void* d_ws, size_t ws_size, hipStream_t stream) {
    static int grid = 0;
    if (grid == 0) {
        if (n_in != 14 || in_sizes[0] != MP * DM || out_size != (int)O_END || ws_size < WS_END) {
            fprintf(stderr, "kernel_launch: unexpected shapes: n_in %d in0 %d out %d ws %zu (need %zu)\n", n_in, n_in > 0 ? in_sizes[0] : -1, out_size, ws_size, (size_t)WS_END); grid = -1; return; }
        int dev = 0, cus = 0, per_cu = 0;
        if (hipGetDevice(&dev) != hipSuccess || hipDeviceGetAttribute(&cus, hipDeviceAttributeMultiprocessorCount, dev) != hipSuccess) { grid = -1; return; }
        if (hipFuncSetAttribute((const void*)mk_fwd, hipFuncAttributeMaxDynamicSharedMemorySize, LDS_BYTES) != hipSuccess) { fprintf(stderr, "kernel_launch: hipFuncSetAttribute failed\n"); grid = -1; return; }
        if (hipOccupancyMaxActiveBlocksPerMultiprocessor(&per_cu, (const void*)mk_fwd, NWAVES * 64, LDS_BYTES) != hipSuccess || per_cu < 1) { fprintf(stderr, "kernel_launch: occupancy query reports %d blocks per CU\n", per_cu); }
        (void)hipGetLastError();
        grid = cus;
    }
    if (grid < 0) return;
    if (hipMemsetAsync((char*)d_ws + WS_CTL, 0, CTL_ZERO_BYTES, stream) != hipSuccess) return;
    Args a{};
    a.xp = (const float*)d_in[0]; a.xs = (const float*)d_in[1]; a.ck = (const float*)d_in[2]; a.cv = (const float*)d_in[3]; a.st = (const float*)d_in[4];
    a.nmix = (const float*)d_in[5]; a.win = (const float*)d_in[6]; a.rnw = (const float*)d_in[7]; a.qnw = (const float*)d_in[8]; a.knw = (const float*)d_in[9];
    a.wout = (const float*)d_in[10]; a.nmlp = (const float*)d_in[11]; a.wup = (const float*)d_in[12]; a.wdn = (const float*)d_in[13];
    a.out = (float*)d_out; a.ws = (unsigned char*)d_ws;
    hipLaunchKernelGGL(mk_fwd, dim3(grid), dim3(NWAVES * 64), LDS_BYTES, stream, a);
}
```

```cpp
#include <hip/hip_runtime.h>
#include <cstdio>
#include <cstdint>
#include <cmath>
namespace pg8 {
#define PG8_LAS __attribute__((address_space(3)))
typedef unsigned short bf16_t;
typedef short bf16x8 __attribute__((ext_vector_type(8)));
typedef float f32x4 __attribute__((ext_vector_type(4)));
typedef unsigned u32x4 __attribute__((ext_vector_type(4)));
constexpr int BM = 256, BK = 64, HALF = 128, HTB = HALF * BK * 2  , STAGE_BYTES = 8 * HTB, NXCD = 8, WGM = 8;

__host__ __device__ __forceinline__ int lds_byte(int r, int c) { const int st = (r >> 4) * 2 + (c >> 5), rr = r & 15, cc = c & 31, ob = rr * 64 + cc * 2; return st * 1024 + (ob ^ (((ob >> 9) & 1) << 5)); }
__host__ __device__ __forceinline__ void stage_rc(int b, int& R, int& C) { const int st = b / 1024, sb = b % 1024, swz = sb ^ (((sb >> 9) & 1) << 5); R = (st >> 1) * 16 + swz / 64; C = (st & 1) * 32 + (swz % 64) / 2; }
__host__ __device__ __forceinline__ int perm32(int rho) { const int n = rho >> 4, i = rho & 15; return 8 * (i >> 2) + 4 * n + (i & 3); }

struct Unit { int pm, pn; };
struct Gemm { const bf16_t* A; const bf16_t* Bt; int M, N, K; };

struct StaticOrder {
    int nM, nN, nwg, G, c;
    __host__ __device__ void init(int M, int N, int G_, int c_) { nM = M / BM; nN = N / BM; nwg = nM * nN; G = G_; c = c_; }
    __host__ __device__ bool next(int i, Unit& u) const {
        const long L = (long)i * G + c; if (L >= nwg) return false;
        int wgid = (int)L; { const int q = nwg / NXCD, r = nwg % NXCD, xcd = wgid % NXCD, off = wgid / NXCD; wgid = (xcd < r ? xcd * (q + 1) : r * (q + 1) + (xcd - r) * q) + off; }
        const int nig = WGM * nN, gid = wgid / nig, fm = gid * WGM, gsz = (nM - fm) < WGM ? (nM - fm) : WGM;
        u.pm = fm + ((wgid % nig) % gsz); u.pn = (wgid % nig) / gsz; return true;
    }
    __device__ __forceinline__ void a_ready(const Unit&) const {}
    __device__ __forceinline__ void done(const Unit&) const {}
};

__device__ __forceinline__ unsigned cvt_pk_bf16(float lo, float hi) { unsigned r; asm volatile("v_cvt_pk_bf16_f32 %0, %1, %2" : "=v"(r) : "v"(lo), "v"(hi)); return r; }
typedef float f32x2 __attribute__((ext_vector_type(2)));

typedef unsigned u32x2 __attribute__((ext_vector_type(2)));
typedef float f32x2_t __attribute__((ext_vector_type(2))); typedef __bf16 bf16x2_t __attribute__((ext_vector_type(2)));
__device__ __forceinline__ unsigned cvtpk(float lo, float hi) { f32x2_t v = {lo, hi}; bf16x2_t b = __builtin_convertvector(v, bf16x2_t); return __builtin_bit_cast(unsigned, b); }
__device__ __forceinline__ void store8(bf16_t* p, const f32x4 a, const f32x4 b) { u32x4 w; w.x = cvtpk(a[0], a[1]); w.y = cvtpk(a[2], a[3]); w.z = cvtpk(b[0], b[1]); w.w = cvtpk(b[2], b[3]); *(u32x4*)p = w; }
__device__ __forceinline__ float sigmoidf_fast(float x) { return __builtin_amdgcn_rcpf(1.0f + __builtin_amdgcn_exp2f(-1.4426950408889634f * x)); }
__device__ __forceinline__ float sumsq4(const f32x4 a) { return (a[0] * a[0] + a[1] * a[1]) + (a[2] * a[2] + a[3] * a[3]); }

constexpr int E_MP = 65536;
constexpr size_t E_REG = (size_t)66560 * 1024;
constexpr size_t EO_KP = 68157440, EO_VP = 135266304, EO_KS = 206569472, EO_VS = 207618048;

struct EpiIn {
    static constexpr bool PERM = true, AFTER_DRAIN = false, DUP_OK = true;
    bf16_t* R; float* out; const float* rope; const float* qw; const float* kw; PG8_LAS float* xch;
    __device__ __forceinline__ void operator()(const f32x4 (&acc)[2][2][4][2], const Unit& u, int wr, int wc, int fr, int fq) const {
        const int tt = u.pn >> 2, hq = u.pn & 3;
        const int row0 = u.pm * BM + wr * 64 + fr, cl = 32 * wc + 8 * fq;
        bf16_t* base = R + (size_t)tt * E_REG + hq * 256 + cl;
        if (tt <= 1) {
            const float sc = (tt == 1) ? 0.0625f : 1.0f;
            f32x4 tb[2][4];
#define ROPE_LD(g_) do { const int row_ = row0 + ((g_) >> 2) * HALF + ((g_) & 3) * 16; const int pos_ = (row_ < E_MP) ? (row_ & 4095) : (4096 + (row_ & 31)); \
                const f32x4* tp_ = (const f32x4*)(rope + ((size_t)pos_ * 128 + cl) * 2); tb[(g_) & 1][0] = tp_[0]; tb[(g_) & 1][1] = tp_[1]; tb[(g_) & 1][2] = tp_[2]; tb[(g_) & 1][3] = tp_[3]; } while (0)
            ROPE_LD(0);
#pragma unroll
            for (int gi = 0; gi < 8; ++gi) {
                const int ai = gi >> 2, m = gi & 3;
                if (gi < 7) ROPE_LD(gi + 1);
                asm volatile("" ::: "memory");
                const int row = row0 + ai * HALF + m * 16;
                f32x4 o1[2], o2[2];
#pragma unroll
                for (int n = 0; n < 2; ++n) {
                    const f32x4 t0 = tb[gi & 1][2 * n], t1 = tb[gi & 1][2 * n + 1], x1 = acc[ai][0][m][n], x2 = acc[ai][1][m][n];
                    o1[n] = (f32x4){x1[0] * t0[0] - x2[0] * t0[1], x1[1] * t0[2] - x2[1] * t0[3], x1[2] * t1[0] - x2[2] * t1[1], x1[3] * t1[2] - x2[3] * t1[3]} * sc;
                    o2[n] = (f32x4){x1[0] * t0[1] + x2[0] * t0[0], x1[1] * t0[3] + x2[1] * t0[2], x1[2] * t1[1] + x2[2] * t1[0], x1[3] * t1[3] + x2[3] * t1[2]} * sc;
                }
                bf16_t* rp = base + (size_t)row * 1024;
                store8(rp, o1[0], o1[1]); store8(rp + HALF, o2[0], o2[1]);
            }
#undef ROPE_LD
        } else if (tt == 4 || tt == 5) {
            const float* wsrc = (tt == 4) ? qw : kw;
            const f32x4 w0 = *(const f32x4*)(wsrc + cl), w1 = *(const f32x4*)(wsrc + cl + 4);
            const float osc = (tt == 4) ? 0.08838834764831845f * 1.4426950408889634f : 1.0f;
#pragma unroll
            for (int ai = 0; ai < 2; ++ai)
#pragma unroll
                for (int m = 0; m < 4; ++m)
#pragma unroll
                    for (int bj = 0; bj < 2; ++bj) {
                        float s = sumsq4(acc[ai][bj][m][0]) + sumsq4(acc[ai][bj][m][1]);
                        s += __shfl_xor(s, 16); s += __shfl_xor(s, 32);
                        if (fq == 0) xch[((ai * HALF + wr * 64 + m * 16 + fr) * 2 + bj) * 4 + wc] = s;
                    }
            asm volatile("s_waitcnt lgkmcnt(0)" ::: "memory"); __builtin_amdgcn_s_barrier(); asm volatile("" ::: "memory");
            float* ok = (row0 < E_MP) ? out + EO_KP : out + EO_KS - (size_t)E_MP * 1024;
#pragma unroll
            for (int ai = 0; ai < 2; ++ai)
#pragma unroll
                for (int m = 0; m < 4; ++m) {
                    const int rl = ai * HALF + wr * 64 + m * 16 + fr, row = u.pm * BM + rl;
#pragma unroll
                    for (int bj = 0; bj < 2; ++bj) {
                        const f32x4 p = *(const PG8_LAS f32x4*)(xch + (rl * 2 + bj) * 4);
                        const float rstd = osc / sqrtf(((p[0] + p[1]) + (p[2] + p[3])) * (1.0f / 128.0f) + 1e-6f);
                        const f32x4 v0 = acc[ai][bj][m][0] * rstd * w0, v1 = acc[ai][bj][m][1] * rstd * w1;
                        if (tt == 5) { float* o = ok + (size_t)row * 1024 + hq * 256 + bj * HALF + cl; *(f32x4*)o = v0; *(f32x4*)(o + 4) = v1; }
                        store8(base + (size_t)row * 1024 + bj * HALF, v0, v1);
                    }
                }
        } else {
            float* ov = (row0 < E_MP) ? out + EO_VP : out + EO_VS - (size_t)E_MP * 1024;
#pragma unroll
            for (int ai = 0; ai < 2; ++ai)
#pragma unroll
                for (int m = 0; m < 4; ++m) {
                    const int row = row0 + ai * HALF + m * 16;
#pragma unroll
                    for (int bj = 0; bj < 2; ++bj) {
                        f32x4 v0 = acc[ai][bj][m][0], v1 = acc[ai][bj][m][1];
                        if (tt == 3) {
#pragma unroll
                            for (int e = 0; e < 4; ++e) { v0[e] *= sigmoidf_fast(v0[e]); v1[e] *= sigmoidf_fast(v1[e]); }
                        } else if (tt >= 7) {
#pragma unroll
                            for (int e = 0; e < 4; ++e) { v0[e] = sigmoidf_fast(v0[e]); v1[e] = sigmoidf_fast(v1[e]); }
                        } else if (tt == 6) { float* o = ov + (size_t)row * 1024 + hq * 256 + bj * HALF + cl; *(f32x4*)o = v0; *(f32x4*)(o + 4) = v1; }
                        store8(base + (size_t)row * 1024 + bj * HALF, v0, v1);
                    }
                }
        }
    }
};

struct EpiRes1 {
    static constexpr bool PERM = true, AFTER_DRAIN = false, DUP_OK = true;
    const float* xp; const float* xs; float* out; bf16_t* XB; float* SSQ;
    __device__ __forceinline__ void operator()(const f32x4 (&acc)[2][2][4][2], const Unit& u, int wr, int wc, int fr, int fq) const {
        const int row0 = u.pm * BM + wr * 64 + fr, col0 = u.pn * BM + 32 * wc + 8 * fq;
        const float* xb = (row0 < E_MP) ? xp : xs - (size_t)E_MP * 1024;
        f32x4 xv[2][4];
#define RES_LD(g_) do { const size_t off_ = (size_t)(row0 + ((g_) >> 2) * HALF + ((g_) & 3) * 16) * 1024 + col0; \
            xv[(g_) & 1][0] = *(const f32x4*)(xb + off_); xv[(g_) & 1][1] = *(const f32x4*)(xb + off_ + 4); xv[(g_) & 1][2] = *(const f32x4*)(xb + off_ + HALF); xv[(g_) & 1][3] = *(const f32x4*)(xb + off_ + HALF + 4); } while (0)
        RES_LD(0);
#pragma unroll
        for (int gi = 0; gi < 8; ++gi) {
            const int ai = gi >> 2, m = gi & 3;
            if (gi < 7) RES_LD(gi + 1);
            asm volatile("" ::: "memory");
            const int row = row0 + ai * HALF + m * 16; float ss = 0.f;
#pragma unroll
            for (int bj = 0; bj < 2; ++bj) {
                const size_t off = (size_t)row * 1024 + col0 + bj * HALF;
                const f32x4 v0 = acc[ai][bj][m][0] + xv[gi & 1][2 * bj], v1 = acc[ai][bj][m][1] + xv[gi & 1][2 * bj + 1];
                *(f32x4*)(out + off) = v0; *(f32x4*)(out + off + 4) = v1;
                ss += sumsq4(v0) + sumsq4(v1);
                store8(XB + off, v0, v1);
            }
            ss += __shfl_xor(ss, 16); ss += __shfl_xor(ss, 32);
            if (fq == 0) SSQ[(size_t)row * 16 + u.pn * 4 + wc] = ss;
        }
#undef RES_LD
    }
};

struct EpiUp {
    static constexpr bool PERM = true, AFTER_DRAIN = false, DUP_OK = true;
    bf16_t* H; const float* SSQ;
    __device__ __forceinline__ void operator()(const f32x4 (&acc)[2][2][4][2], const Unit& u, int wr, int wc, int fr, int fq) const {
        const int row0 = u.pm * BM + wr * 64 + fr, col0 = u.pn * BM + 32 * wc + 8 * fq;
        f32x4 sq[2][4];
#pragma unroll
        for (int ai = 0; ai < 2; ++ai)
#pragma unroll
            for (int m = 0; m < 4; ++m) sq[ai][m] = *(const f32x4*)(SSQ + (size_t)(row0 + ai * HALF + m * 16) * 16 + 4 * fq);
        asm volatile("" ::: "memory");
#pragma unroll
        for (int ai = 0; ai < 2; ++ai)
#pragma unroll
            for (int m = 0; m < 4; ++m) {
                const int row = row0 + ai * HALF + m * 16;
                float t = (sq[ai][m][0] + sq[ai][m][1]) + (sq[ai][m][2] + sq[ai][m][3]);
                t += __shfl_xor(t, 16); t += __shfl_xor(t, 32);
                const float r2 = 1.0f / (t * (1.0f / 1024.0f) + 1e-6f);
#pragma unroll
                for (int bj = 0; bj < 2; ++bj) {
                    f32x4 v0 = acc[ai][bj][m][0], v1 = acc[ai][bj][m][1];
#pragma unroll
                    for (int e = 0; e < 4; ++e) { const float a = fmaxf(v0[e], 0.f), b = fmaxf(v1[e], 0.f); v0[e] = a * a * r2; v1[e] = b * b * r2; }
                    store8(H + (size_t)row * 4096 + col0 + bj * HALF, v0, v1);
                }
            }
    }
};

struct EpiDown {
    static constexpr bool PERM = true, AFTER_DRAIN = false, DUP_OK = false;
    float* out;
    __device__ __forceinline__ void operator()(const f32x4 (&acc)[2][2][4][2], const Unit& u, int wr, int wc, int fr, int fq) const {
        const int row0 = u.pm * BM + wr * 64 + fr, col0 = u.pn * BM + 32 * wc + 8 * fq;
        f32x4 xv[2][4];
#define DN_LD(g_) do { const float* o_ = out + (size_t)(row0 + ((g_) >> 2) * HALF + ((g_) & 3) * 16) * 1024 + col0; \
            xv[(g_) & 1][0] = *(const f32x4*)(o_); xv[(g_) & 1][1] = *(const f32x4*)(o_ + 4); xv[(g_) & 1][2] = *(const f32x4*)(o_ + HALF); xv[(g_) & 1][3] = *(const f32x4*)(o_ + HALF + 4); } while (0)
        DN_LD(0);
#pragma unroll
        for (int gi = 0; gi < 8; ++gi) {
            const int ai = gi >> 2, m = gi & 3;
            if (gi < 7) DN_LD(gi + 1);
            asm volatile("" ::: "memory");
            float* o = out + (size_t)(row0 + ai * HALF + m * 16) * 1024 + col0;
#pragma unroll
            for (int bj = 0; bj < 2; ++bj) {
                const f32x4 v0 = acc[ai][bj][m][0] + xv[gi & 1][2 * bj], v1 = acc[ai][bj][m][1] + xv[gi & 1][2 * bj + 1];
                *(f32x4*)(o + bj * HALF) = v0; *(f32x4*)(o + bj * HALF + 4) = v1;
            }
        }
#undef DN_LD
    }
};


struct EpiNull {
    static constexpr bool PERM = true, AFTER_DRAIN = false, DUP_OK = false;
    float* sink;
    __device__ __forceinline__ void operator()(const f32x4 (&acc)[2][2][4][2], const Unit& u, int wr, int wc, int fr, int fq) const {
        float t = 0.f;
#pragma unroll
        for (int ai = 0; ai < 2; ++ai)
#pragma unroll
            for (int bj = 0; bj < 2; ++bj)
#pragma unroll
                for (int m = 0; m < 4; ++m)
#pragma unroll
                    for (int n = 0; n < 2; ++n) t += (acc[ai][bj][m][n][0] + acc[ai][bj][m][n][1]) + (acc[ai][bj][m][n][2] + acc[ai][bj][m][n][3]);
        if (t == 123456.789f) sink[u.pm * 7 + u.pn + wr + wc + fr + fq] = t;
    }
};
template <class Epi, class Sched, bool ALIGN_EPI = false, bool SP2 = false>
__device__ __forceinline__ void gemm_phase(PG8_LAS unsigned char* lds, const Gemm g, const Sched& S, const Epi& E) {
    int tid_ = threadIdx.x; asm volatile("" : "+v"(tid_));
    const int tid = tid_, wid = __builtin_amdgcn_readfirstlane(tid >> 6), lane = tid & 63, wr = wid >> 2, wc = wid & 3, fr = lane & 15, fq = lane >> 4;
    const int K = g.K, nt = K / BK;
    unsigned voffA[2], voffB[2];
#pragma unroll
    for (int i = 0; i < 2; ++i) { int R, C; stage_rc(tid * 16 + i * 8192, R, C); const int Rb = Epi::PERM ? ((R & ~31) + perm32(R & 31)) : R;
        voffA[i] = (unsigned)(R * K + C) * 2u; voffB[i] = (unsigned)(Rb * K + C) * 2u; }
    const size_t kstep = (size_t)(BK * 2);
    const size_t hstep = (size_t)HALF * K * 2;
    const size_t tstep = 2 * hstep;
    const unsigned ldsw = (unsigned)wid * 1024u;
    const int aoff = lds_byte(wr * 64 + fr, fq * 8), boff = lds_byte(wc * 32 + fr, fq * 8);
#define PG8_SA(b, h) (((b) * 2 + (h)) * HTB)
#define PG8_SB(b, h) ((4 + (b) * 2 + (h)) * HTB)
#define PG8_STAGE(bufoff, gbase, voff) do { _Pragma("unroll") for (int _i = 0; _i < 2; ++_i) \
        __builtin_amdgcn_global_load_lds((const unsigned*)((const char*)(gbase) + (voff)[_i]), (PG8_LAS unsigned*)(lds + (bufoff) + ldsw + _i * 8192), 16, 0, 0); } while (0)
#define PG8_LDA(dst, b, h) do { _Pragma("unroll") for (int m = 0; m < 4; ++m) _Pragma("unroll") for (int k = 0; k < 2; ++k) dst[m][k] = *(const PG8_LAS bf16x8*)(lds + PG8_SA(b, h) + aoff + m * 2048 + k * 1024); } while (0)
#define PG8_LDB(dst, b, h) do { _Pragma("unroll") for (int n = 0; n < 2; ++n) _Pragma("unroll") for (int k = 0; k < 2; ++k) dst[n][k] = *(const PG8_LAS bf16x8*)(lds + PG8_SB(b, h) + boff + n * 2048 + k * 1024); } while (0)
#define PG8_MMA(ai, bj, At, Bt) do { __builtin_amdgcn_s_setprio(1); _Pragma("unroll") for (int m = 0; m < 4; ++m) _Pragma("unroll") for (int n = 0; n < 2; ++n) _Pragma("unroll") for (int k = 0; k < 2; ++k) \
        acc[ai][bj][m][n] = __builtin_amdgcn_mfma_f32_16x16x32_bf16(Bt[n][k], At[m][k], acc[ai][bj][m][n], 0, 0, 0); __builtin_amdgcn_s_setprio(0); } while (0)
#define PG8_WAIT_V(n) asm volatile("s_waitcnt vmcnt(" #n ")" ::: "memory")
#define PG8_WAIT_L(n) asm volatile("s_waitcnt lgkmcnt(" #n ")" ::: "memory")
#define PG8_BAR __builtin_amdgcn_s_barrier()
#define PG8_SCHED __builtin_amdgcn_sched_barrier(0)
    Unit cur, nxt; int ui = 0;
    if (!S.next(0, cur)) return;
    f32x4 acc[2][2][4][2];
#pragma unroll
    for (int a = 0; a < 2; ++a)
#pragma unroll
        for (int b = 0; b < 2; ++b)
#pragma unroll
            for (int m = 0; m < 4; ++m)
#pragma unroll
                for (int n = 0; n < 2; ++n) acc[a][b][m][n] = (f32x4){0.f, 0.f, 0.f, 0.f};
    bf16x8 At[4][2], B0[2][2], B1[2][2];
    const char* cA = (const char*)g.A + (size_t)cur.pm * tstep; const char* cB = (const char*)g.Bt + (size_t)cur.pn * tstep;
    S.a_ready(cur);
    if constexpr (SP2) {
        PG8_STAGE(PG8_SB(0, 0), cB, voffB); PG8_STAGE(PG8_SB(0, 1), cB + hstep, voffB); PG8_STAGE(PG8_SA(0, 0), cA, voffA); PG8_STAGE(PG8_SA(0, 1), cA + hstep, voffA);
        if (wr == 1) PG8_BAR;
        PG8_WAIT_V(2); PG8_BAR;
        PG8_STAGE(PG8_SB(1, 0), cB + kstep, voffB); PG8_STAGE(PG8_SA(1, 0), cA + kstep, voffA); PG8_STAGE(PG8_SB(1, 1), cB + hstep + kstep, voffB);
        PG8_WAIT_V(6); PG8_BAR;
    } else {
        PG8_STAGE(PG8_SB(0, 0), cB, voffB); PG8_STAGE(PG8_SA(0, 0), cA, voffA); PG8_STAGE(PG8_SB(0, 1), cB + hstep, voffB); PG8_STAGE(PG8_SA(0, 1), cA + hstep, voffA);
        if (wr == 1) PG8_BAR;
        PG8_WAIT_V(4); PG8_BAR;
        PG8_STAGE(PG8_SB(1, 0), cB + kstep, voffB); PG8_STAGE(PG8_SA(1, 0), cA + kstep, voffA); PG8_STAGE(PG8_SB(1, 1), cB + hstep + kstep, voffB);
        PG8_WAIT_V(6); PG8_BAR;
    }
    for (;;) {
        const bool has_next = S.next(ui + 1, nxt);
        const char* nA = has_next ? (const char*)g.A + (size_t)nxt.pm * tstep : cA; const char* nB = has_next ? (const char*)g.Bt + (size_t)nxt.pn * tstep : cB;
        for (int t = 0; t < nt; t += 2) {
            const bool last = (t == nt - 2);
            const char* a1 = cA + (size_t)(t + 1) * kstep;
            const char* a2 = last ? nA : cA + (size_t)(t + 2) * kstep; const char* b2 = last ? nB : cB + (size_t)(t + 2) * kstep;
            const char* a3 = a2 + kstep; const char* b3 = b2 + kstep;
            if (last && has_next) S.a_ready(nxt);
            if constexpr (SP2) {
            PG8_LDB(B0, 0, 0); PG8_LDB(B1, 0, 1); PG8_SCHED; PG8_LDA(At, 0, 0); PG8_STAGE(PG8_SA(1, 1), a1 + hstep, voffA);
            PG8_WAIT_V(8); PG8_WAIT_L(0); PG8_BAR; PG8_MMA(0, 0, At, B0); PG8_MMA(0, 1, At, B1); PG8_BAR; PG8_SCHED;
            PG8_LDA(At, 0, 1); PG8_STAGE(PG8_SB(0, 0), b2, voffB); PG8_STAGE(PG8_SB(0, 1), b2 + hstep, voffB); PG8_STAGE(PG8_SA(0, 0), a2, voffA);
            PG8_WAIT_V(8); PG8_WAIT_L(0); PG8_BAR; PG8_MMA(1, 0, At, B0); PG8_MMA(1, 1, At, B1); PG8_BAR; PG8_SCHED;
            PG8_LDB(B0, 1, 0); PG8_LDB(B1, 1, 1); PG8_SCHED; PG8_LDA(At, 1, 0); PG8_STAGE(PG8_SA(0, 1), a2 + hstep, voffA);
            PG8_WAIT_V(8); PG8_WAIT_L(0); PG8_BAR; PG8_MMA(0, 0, At, B0); PG8_MMA(0, 1, At, B1); PG8_BAR; PG8_SCHED;
            PG8_LDA(At, 1, 1); PG8_STAGE(PG8_SB(1, 0), b3, voffB); PG8_STAGE(PG8_SB(1, 1), b3 + hstep, voffB); PG8_STAGE(PG8_SA(1, 0), a3, voffA);
            PG8_WAIT_V(8); PG8_WAIT_L(0); PG8_BAR; PG8_MMA(1, 0, At, B0); PG8_MMA(1, 1, At, B1); PG8_BAR; PG8_SCHED;
            } else {
            PG8_LDB(B0, 0, 0); PG8_SCHED; PG8_LDA(At, 0, 0); PG8_STAGE(PG8_SA(1, 1), a1 + hstep, voffA);
            PG8_WAIT_L(8); PG8_BAR; PG8_WAIT_L(0); PG8_MMA(0, 0, At, B0); PG8_BAR; PG8_SCHED;
            PG8_LDB(B1, 0, 1); PG8_STAGE(PG8_SB(0, 0), b2, voffB);
            PG8_BAR; PG8_WAIT_L(0); PG8_MMA(0, 1, At, B1); PG8_BAR;
            PG8_LDA(At, 0, 1); PG8_STAGE(PG8_SA(0, 0), a2, voffA);
            PG8_BAR; PG8_WAIT_L(0); PG8_MMA(1, 0, At, B0); PG8_BAR; PG8_SCHED;
            PG8_STAGE(PG8_SB(0, 1), b2 + hstep, voffB);
            PG8_WAIT_V(6); PG8_BAR; PG8_MMA(1, 1, At, B1); PG8_BAR;
            PG8_LDB(B0, 1, 0); PG8_SCHED; PG8_LDA(At, 1, 0); PG8_STAGE(PG8_SA(0, 1), a2 + hstep, voffA);
            PG8_WAIT_L(8); PG8_BAR; PG8_WAIT_L(0); PG8_MMA(0, 0, At, B0); PG8_BAR; PG8_SCHED;
            PG8_LDB(B1, 1, 1); PG8_STAGE(PG8_SB(1, 0), b3, voffB);
            PG8_BAR; PG8_WAIT_L(0); PG8_MMA(0, 1, At, B1); PG8_BAR;
            PG8_LDA(At, 1, 1); PG8_STAGE(PG8_SA(1, 0), a3, voffA);
            PG8_BAR; PG8_WAIT_L(0); PG8_MMA(1, 0, At, B0); PG8_BAR; PG8_SCHED;
            PG8_STAGE(PG8_SB(1, 1), b3 + hstep, voffB);
            PG8_WAIT_V(6); PG8_BAR; PG8_MMA(1, 1, At, B1); PG8_BAR;
            }
        }
        if constexpr (ALIGN_EPI) { if (wr == 0) PG8_BAR; }
        if constexpr (!Epi::AFTER_DRAIN) { E(acc, cur, wr, wc, fr, fq);
#if defined(PROBE_EPI2)
            if constexpr (Epi::DUP_OK) { asm volatile("" ::: "memory"); E(acc, cur, wr, wc, fr, fq); }
#endif
            S.done(cur); }
        if (!has_next) break;
#pragma unroll
        for (int a = 0; a < 2; ++a)
#pragma unroll
            for (int b = 0; b < 2; ++b)
#pragma unroll
                for (int m = 0; m < 4; ++m)
#pragma unroll
                    for (int n = 0; n < 2; ++n) acc[a][b][m][n] = (f32x4){0.f, 0.f, 0.f, 0.f};
        cur = nxt; cA = nA; cB = nB; ++ui;
        if constexpr (ALIGN_EPI) { if (wr == 1) PG8_BAR; }
    }
    PG8_WAIT_V(0);
    if constexpr (!ALIGN_EPI) { if (wr == 0) PG8_BAR; }
    PG8_BAR;
    if constexpr (Epi::AFTER_DRAIN) { E.fused(acc, cur, wr, wc, fr, fq, lds, wid, lane); S.done(cur); }
#undef PG8_SA
#undef PG8_SB
#undef PG8_STAGE
#undef PG8_LDA
#undef PG8_LDB
#undef PG8_MMA
#undef PG8_WAIT_V
#undef PG8_WAIT_L
#undef PG8_BAR
#undef PG8_SCHED
}
}
#define GAS __attribute__((address_space(1)))
#define LAS __attribute__((address_space(3)))
typedef unsigned short bf16;
typedef unsigned v4u __attribute__((ext_vector_type(4)));
typedef float f32x4 __attribute__((ext_vector_type(4)));
typedef short bf16x8 __attribute__((ext_vector_type(8)));
typedef GAS unsigned gu32;
typedef GAS unsigned long long gu64;
#define RLX_AGENT __ATOMIC_RELAXED, __HIP_MEMORY_SCOPE_AGENT
#define LDS_WAIT() asm volatile("s_waitcnt lgkmcnt(0)" ::: "memory")
#define VM_WAIT() asm volatile("s_waitcnt vmcnt(0)" ::: "memory")
__device__ __forceinline__ unsigned long long rt() { return __builtin_amdgcn_s_memrealtime(); }
__device__ __forceinline__ unsigned f2bf(float f) { unsigned u = __builtin_bit_cast(unsigned, f); return (u + 0x7fffu + ((u >> 16) & 1u)) >> 16; }
__device__ __forceinline__ unsigned pk2(float lo, float hi) { return f2bf(lo) | (f2bf(hi) << 16); }

#define XB_TMO      128
#define XB_XCNT(j)  (256  + 64 * (j))
#define XB_XSUB(j)  (1280 + 64 * (j))
#define XB_XGEN(j)  (2304 + 64 * (j))
#define XB_TOP      3328
#define XB_TOPGEN   3392
#define XCD_BAR_WORDS 3456
#define XB_SPIN_CAP (1u << 18)

__device__ __forceinline__ unsigned xb_ld(unsigned* p)              { return __hip_atomic_load(p, __ATOMIC_RELAXED, __HIP_MEMORY_SCOPE_AGENT); }
__device__ __forceinline__ unsigned xb_add(unsigned* p, unsigned v) { return __hip_atomic_fetch_add(p, v, __ATOMIC_RELAXED, __HIP_MEMORY_SCOPE_AGENT); }
__device__ __forceinline__ unsigned xb_xcc_id() { return (unsigned)__builtin_amdgcn_s_getreg((3 << 11) | 20) & 0xFu; }
#define XB_SPIN(cond, bar) do { unsigned _sp = 0; while (cond) { __builtin_amdgcn_s_sleep(1); \
    if ((++_sp & 255u) == 0u) { if (xb_ld(&(bar)[XB_TMO])) break; if (_sp > XB_SPIN_CAP) { atomicAdd(&(bar)[XB_TMO], 1u); break; } } } } while (0)

struct XcdBarrier {
    unsigned* bar; unsigned x;
    volatile LAS unsigned* st;
};

__device__ __forceinline__ XcdBarrier xcd_barrier_post(unsigned* bar, volatile LAS unsigned* st) {
    XcdBarrier b; b.bar = bar; b.x = xb_xcc_id(); b.st = st;
    if (threadIdx.x == 0) (void)xb_add(&bar[XB_XCNT(b.x)], 1u);
    return b;
}
__device__ __forceinline__ void xcd_barrier_complete(unsigned* bar, unsigned x, unsigned& nloc, unsigned& nx) {
    const unsigned G = gridDim.x * gridDim.y * gridDim.z;
    unsigned sum, cnt, mine, sp = 0u;
    for (;;) {
        sum = 0u; cnt = 0u; mine = 0u;
#pragma unroll
        for (unsigned j = 0; j < 16; ++j) { const unsigned c = xb_ld(&bar[XB_XCNT(j)]); sum += c; cnt += (c > 0u) ? 1u : 0u; mine = (j == x) ? c : mine; }
        if (sum == G) break;
        __builtin_amdgcn_s_sleep(1);
        if ((++sp & 255u) == 0u) { if (xb_ld(&bar[XB_TMO])) break; if (sp > XB_SPIN_CAP) { atomicAdd(&bar[XB_TMO], 1u); break; } }
    }
    nloc = mine > 0u ? mine : 1u; nx = cnt > 0u ? cnt : 1u;
}

__device__ __forceinline__ void xcd_barrier(const XcdBarrier& b) {
    asm volatile("s_waitcnt vmcnt(0)" ::: "memory");
    __syncthreads();
    if (threadIdx.x == 0) {
        unsigned* bar = b.bar;
        __builtin_amdgcn_s_waitcnt(0);
        unsigned nloc = b.st[0], nx = b.st[1];
        if (nloc == 0u) { xcd_barrier_complete(bar, b.x, nloc, nx); b.st[0] = nloc; b.st[1] = nx; }
        const unsigned old = xb_add(&bar[XB_XSUB(b.x)], 1u);
        const unsigned gen = old / nloc;
        if (old + 1u == (gen + 1u) * nloc) {
            __builtin_amdgcn_fence(__ATOMIC_RELEASE, "agent");
            asm volatile("s_waitcnt vmcnt(0)" ::: "memory");
            const unsigned og = xb_add(&bar[XB_TOP], 1u);
            const unsigned tg = og / nx;
            if (og + 1u == (tg + 1u) * nx) xb_add(&bar[XB_TOPGEN], 1u);
            else XB_SPIN(xb_ld(&bar[XB_TOPGEN]) == tg, bar);
            __builtin_amdgcn_fence(__ATOMIC_ACQUIRE, "agent");
            xb_add(&bar[XB_XGEN(b.x)], 1u);
            asm volatile("s_waitcnt vmcnt(0)" ::: "memory");
        } else {
            XB_SPIN(xb_ld(&bar[XB_XGEN(b.x)]) == gen, bar);
            __builtin_amdgcn_fence(__ATOMIC_ACQUIRE, "agent");
            asm volatile("s_waitcnt vmcnt(0)" ::: "memory");
        }
    }
    __syncthreads();
}
typedef float f32x2_pair __attribute__((ext_vector_type(2)));

constexpr int NWAVES = 8;
constexpr int DM = 1024, FF = 4096, NIN = 9216;
constexpr int MP = 65536, MS = 1024, M = MP + MS;
constexpr int PAST = 4096;
constexpr size_t MiB = 1u << 20;
constexpr size_t REG_E = (size_t)M * DM;
constexpr size_t WS_CTL = 0, CTL_ZERO_BYTES = 1 * MiB;
constexpr size_t WS_WIN = 2 * MiB, WS_WOUT = 20 * MiB, WS_WUP = 22 * MiB, WS_WDN = 30 * MiB;
constexpr size_t WS_ROPE = 38 * MiB;
constexpr size_t WS_SSQ = 43 * MiB;
constexpr size_t WS_RSS = 48 * MiB;
constexpr size_t WS_XN = 54 * MiB;
constexpr size_t WS_R = 184 * MiB;
constexpr size_t WS_END = WS_R + 9 * REG_E * 2;
static_assert(WS_ROPE + (size_t)4128 * 128 * 8 <= WS_SSQ && WS_SSQ + (size_t)M * 64 <= WS_RSS && WS_RSS + (size_t)M * 64 <= WS_XN && WS_XN + REG_E * 2 <= WS_R, "ws map");
constexpr size_t O_Y = 0, O_KP = 68157440, O_VP = 135266304, O_SP = 202375168, O_KS = 206569472, O_VS = 207618048, O_SS = 208666624, O_END = 217055232;
constexpr int CW_BAR = 4096;
constexpr int RING_BYTES = 131072, XCH_OFF = RING_BYTES + 512, MISC_OFF = XCH_OFF + 8192, LDS_BYTES = 147456;
static_assert(MISC_OFF + 64 <= LDS_BYTES, "LDS map");

typedef short s16x4 __attribute__((ext_vector_type(4)));
typedef unsigned v2u __attribute__((ext_vector_type(2)));
#define DI __device__ __forceinline__
#define MFMA16(a, b, c) __builtin_amdgcn_mfma_f32_16x16x32_bf16((a), (b), (c), 0, 0, 0)
#define LBAR() do { asm volatile("s_waitcnt lgkmcnt(0)" ::: "memory"); __builtin_amdgcn_s_barrier(); asm volatile("" ::: "memory"); } while (0)
typedef short v4i16_t __attribute__((ext_vector_type(4)));
DI s16x4 trd(const LAS unsigned char* p) { return __builtin_bit_cast(s16x4, __builtin_amdgcn_ds_read_tr16_b64_v4i16((LAS v4i16_t*)p)); }
DI bf16x8 cat8(s16x4 lo, s16x4 hi) { return (bf16x8){lo[0], lo[1], lo[2], lo[3], hi[0], hi[1], hi[2], hi[3]}; }
DI float bflo(unsigned u) { return __uint_as_float(u << 16); }
DI float bfhi(unsigned u) { return __uint_as_float(u & 0xffff0000u); }
using pg8::cvtpk;
DI float wave_sum(float v) {
#pragma unroll
    for (int o = 1; o < 64; o <<= 1) v += __shfl_xor(v, o);
    return v;
}
constexpr float LOG2E = 1.4426950408889634f, LN2 = 0.6931471805599453f;

struct Args {
    const float *xp, *xs, *ck, *cv, *st, *nmix, *win, *rnw, *qnw, *knw, *wout, *nmlp, *wup, *wdn;
    float* out; unsigned char* ws;
};

DI void p0_transpose_item(const float* W, int K, int N, bf16* WT, const float* ksc, LAS float* scr, int item, int lane) {
    const int nblk = N / 32, kb = item / nblk, nb = item % nblk, k0 = 64 * kb, n0 = 32 * nb;
#pragma unroll 8
    for (int i = 0; i < 32; ++i) { const int kk = 2 * i + (lane >> 5); float v = W[(size_t)(k0 + kk) * N + n0 + (lane & 31)]; if (ksc) v *= ksc[k0 + kk]; scr[kk * 33 + (lane & 31)] = v; }
    LDS_WAIT(); asm volatile("" ::: "memory");
    const int c = lane & 7;
#pragma unroll
    for (int j = 0; j < 4; ++j) { const int n = (lane >> 3) + 8 * j; const LAS float* s = scr + (8 * c) * 33 + n;
        v4u o; o.x = cvtpk(s[0 * 33], s[1 * 33]); o.y = cvtpk(s[2 * 33], s[3 * 33]); o.z = cvtpk(s[4 * 33], s[5 * 33]); o.w = cvtpk(s[6 * 33], s[7 * 33]);
        *(GAS v4u*)(WT + (size_t)(n0 + n) * K + k0 + 8 * c) = o; }
    LDS_WAIT(); asm volatile("" ::: "memory");
}
DI void p0_prologue(const Args& a, LAS unsigned char* lds, int vcu, int G, int wave, int lane) {
    unsigned char* ws = a.ws;
    LAS float* scr = (LAS float*)(lds + wave * 16384);
    const int gw = vcu * NWAVES + wave, NGW = G * NWAVES;
    constexpr int I_IN = (DM / 64) * (NIN / 32), I_O = (DM / 64) * (DM / 32), I_U = (DM / 64) * (FF / 32), I_D = (FF / 64) * (DM / 32);
    constexpr int NITEMS = I_IN + I_O + I_U + I_D;
    for (int it = gw; it < NITEMS; it += NGW) {
        int r = it;
        if (r < I_IN) { p0_transpose_item(a.win, DM, NIN, (bf16*)(ws + WS_WIN), nullptr, scr, r, lane); continue; } r -= I_IN;
        if (r < I_O) { p0_transpose_item(a.wout, DM, DM, (bf16*)(ws + WS_WOUT), nullptr, scr, r, lane); continue; } r -= I_O;
        if (r < I_U) { p0_transpose_item(a.wup, DM, FF, (bf16*)(ws + WS_WUP), a.nmlp, scr, r, lane); continue; } r -= I_U;
        p0_transpose_item(a.wdn, FF, DM, (bf16*)(ws + WS_WDN), nullptr, scr, r, lane);
    }
    {
        f32x4 wv[4];
#pragma unroll
        for (int j = 0; j < 4; ++j) wv[j] = ((const GAS f32x4*)a.nmix)[lane + 64 * j];
        bf16* XN = (bf16*)(ws + WS_XN);
        for (int m = gw; m < M; m += NGW) {
            const float* xrow = (m < MP) ? a.xp + (size_t)m * DM : a.xs + (size_t)(m - MP) * DM;
            const GAS f32x4* xr = (const GAS f32x4*)xrow + lane;
            f32x4 v[4]; float s = 0.f;
#pragma unroll
            for (int j = 0; j < 4; ++j) { v[j] = xr[64 * j]; s += (v[j].x * v[j].x + v[j].y * v[j].y) + (v[j].z * v[j].z + v[j].w * v[j].w); }
            const float rstd = 1.0f / sqrtf(wave_sum(s) * (1.0f / DM) + 1e-6f);
            GAS v2u* o8 = (GAS v2u*)(XN + (size_t)m * DM) + lane;
#pragma unroll
            for (int j = 0; j < 4; ++j) { const f32x4 y = v[j] * rstd * wv[j]; v2u o; o.x = cvtpk(y.x, y.y); o.y = cvtpk(y.z, y.w); o8[64 * j] = o; }
        }
    }
    {
        float* rope = (float*)(ws + WS_ROPE);
        for (int idx = gw * 64 + lane; idx < 4128 * 128; idx += NGW * 64) {
            const int pos = idx >> 7, j = idx & 127;
            const float inv = powf(10000.0f, -(float)j * (1.0f / 128.0f));
            const float ang = (float)pos * inv;
            float sn, cs; sincosf(ang, &sn, &cs);
            *(GAS f32x2_pair*)(rope + (size_t)idx * 2) = (f32x2_pair){cs, sn};
        }
    }
}

constexpr int RT_QS = 0, RT_KS = 33792, RT_VS = 67584, RT_VDS = 76800, RT_PS = 86016, RT_STS = 95232, RT_RXS = 129024;
static_assert(RT_RXS + 1024 <= RING_BYTES, "retention LDS map");
template <bool SAMPLE>
DI void ret_unit(const Args& a, LAS unsigned char* L, int b, int h, int s, int tid, int lane, int w) {
    const int c15 = lane & 15, g = lane >> 4, q4 = c15 >> 2, p4 = c15 & 3;
    constexpr int Lc = SAMPLE ? 32 : 64, NSTEP = SAMPLE ? 1 : 64;
    const float lg2 = log2f(1.0f - exp2f(-5.0f - (float)h));
    const size_t rowbase = SAMPLE ? (size_t)MP + 32 * b : (size_t)4096 * b;
    const bf16* RQ = (const bf16*)(a.ws + WS_R), *RK = RQ + REG_E, *RV = RQ + 2 * REG_E;
    bf16* ORET = (bf16*)(a.ws + WS_XN);
    float* RSS = (float*)(a.ws + WS_RSS);
    f32x4 S[2][4];
    const size_t sbase = ((size_t)(b * 4 + h) * 256) * 256 + 64 * s;
    {
        const float* sp0 = a.st + sbase + (size_t)(32 * w + 4 * g) * 256 + c15;
#pragma unroll
        for (int k2 = 0; k2 < 2; ++k2)
#pragma unroll
            for (int dt = 0; dt < 4; ++dt)
#pragma unroll
                for (int r = 0; r < 4; ++r) S[k2][dt][r] = SAMPLE ? sp0[(16 * k2 + r) * 256 + 16 * dt] : 0.f;
    }
    v4u pq[4], pk[4], pv;
    const int vrow = tid >> 3, vpc = tid & 7;
#define RT_LOAD(c) do { \
        _Pragma("unroll") for (int p_ = 0; p_ < 4; ++p_) { const int idx_ = tid + 512 * p_, row_ = idx_ >> 5, pc_ = idx_ & 31; \
            if (!SAMPLE || row_ < 32) { const size_t go_ = (rowbase + (size_t)64 * (c) + row_) * 1024 + 256 * h + 8 * pc_; pq[p_] = *(const GAS v4u*)(RQ + go_); pk[p_] = *(const GAS v4u*)(RK + go_); } \
            else { pq[p_] = (v4u){0u, 0u, 0u, 0u}; pk[p_] = (v4u){0u, 0u, 0u, 0u}; } } \
        if (!SAMPLE || vrow < 32) pv = *(const GAS v4u*)(RV + (rowbase + (size_t)64 * (c) + vrow) * 1024 + 256 * h + 64 * s + 8 * vpc); else pv = (v4u){0u, 0u, 0u, 0u}; } while (0)
#define RT_WRITE() do { \
        _Pragma("unroll") for (int p_ = 0; p_ < 4; ++p_) { const int idx_ = tid + 512 * p_, row_ = idx_ >> 5, pc_ = idx_ & 31; \
            *(LAS v4u*)(L + RT_QS + row_ * 528 + pc_ * 16) = pq[p_]; *(LAS v4u*)(L + RT_KS + row_ * 528 + pc_ * 16) = pk[p_]; } \
        *(LAS v4u*)(L + RT_VS + vrow * 144 + vpc * 16) = pv; \
        { const float kd_ = exp2f(lg2 * (float)(Lc - 1 - vrow)); v4u d_; \
          d_.x = cvtpk(bflo(pv.x) * kd_, bfhi(pv.x) * kd_); d_.y = cvtpk(bflo(pv.y) * kd_, bfhi(pv.y) * kd_); d_.z = cvtpk(bflo(pv.z) * kd_, bfhi(pv.z) * kd_); d_.w = cvtpk(bflo(pv.w) * kd_, bfhi(pv.w) * kd_); \
          *(LAS v4u*)(L + RT_VDS + vrow * 144 + vpc * 16) = d_; } } while (0)
    RT_LOAD(0); RT_WRITE();
    const int jt = w >> 1, itp = w & 1, dto = w >> 1;
    const float gL = exp2f(lg2 * (float)Lc);
    for (int c = 0; c < NSTEP; ++c) {
        LBAR();
        if (c + 1 < NSTEP) RT_LOAD(c + 1);
        bf16x8 bq[2][8];
        {
            f32x4 sc[2] = {(f32x4){0.f, 0.f, 0.f, 0.f}, (f32x4){0.f, 0.f, 0.f, 0.f}};
            const LAS unsigned char* kp = L + RT_KS + (16 * jt + c15) * 528 + g * 16;
            const LAS unsigned char* qp = L + RT_QS + (32 * itp + c15) * 528 + g * 16;
#pragma unroll
            for (int ks = 0; ks < 8; ++ks) {
                const bf16x8 ak = *(const LAS bf16x8*)(kp + ks * 64);
                bq[0][ks] = *(const LAS bf16x8*)(qp + ks * 64); bq[1][ks] = *(const LAS bf16x8*)(qp + 16 * 528 + ks * 64);
                sc[0] = MFMA16(ak, bq[0][ks], sc[0]); sc[1] = MFMA16(ak, bq[1][ks], sc[1]);
            }
#pragma unroll
            for (int t = 0; t < 2; ++t) {
                const int i = 32 * itp + 16 * t + c15, j0 = 16 * jt + 4 * g;
                float p[4];
#pragma unroll
                for (int r = 0; r < 4; ++r) { const int d = i - (j0 + r); p[r] = sc[t][r] * exp2f(lg2 * (float)(d < 0 ? -d : d)); }
                v2u o; o.x = cvtpk(p[0], p[1]); o.y = cvtpk(p[2], p[3]);
                *(LAS v2u*)(L + RT_PS + i * 144 + j0 * 2) = o;
            }
        }
#pragma unroll
        for (int k2 = 0; k2 < 2; ++k2)
#pragma unroll
            for (int dt = 0; dt < 4; ++dt) { v2u o; o.x = cvtpk(S[k2][dt][0], S[k2][dt][1]); o.y = cvtpk(S[k2][dt][2], S[k2][dt][3]);
                *(LAS v2u*)(L + RT_STS + (16 * dt + c15) * 528 + (16 * (2 * w + k2) + 4 * g) * 2) = o; }
        LBAR();
        {
            f32x4 oc[2] = {(f32x4){0.f, 0.f, 0.f, 0.f}, (f32x4){0.f, 0.f, 0.f, 0.f}};
            const LAS unsigned char* sp = L + RT_STS + (16 * dto + c15) * 528 + g * 16;
#pragma unroll
            for (int ks = 0; ks < 8; ++ks) { const bf16x8 as = *(const LAS bf16x8*)(sp + ks * 64); oc[0] = MFMA16(as, bq[0][ks], oc[0]); oc[1] = MFMA16(as, bq[1][ks], oc[1]); }
#pragma unroll
            for (int t = 0; t < 2; ++t) { const int i = 32 * itp + 16 * t + c15; oc[t] = oc[t] * exp2f(lg2 * (float)(i + 1)); }
#pragma unroll
            for (int k2 = 0; k2 < 2; ++k2) {
                const LAS unsigned char* vp = L + RT_VS + (32 * k2 + 8 * g + q4) * 144 + (16 * dto + 4 * p4) * 2;
                const bf16x8 av = cat8(trd(vp), trd(vp + 4 * 144));
#pragma unroll
                for (int t = 0; t < 2; ++t) { const int i = 32 * itp + 16 * t + c15;
                    const bf16x8 bp = *(const LAS bf16x8*)(L + RT_PS + i * 144 + (32 * k2 + 8 * g) * 2); oc[t] = MFMA16(av, bp, oc[t]); }
            }
#pragma unroll
            for (int t = 0; t < 2; ++t) {
                const int i = 32 * itp + 16 * t + c15;
                float ss = (oc[t][0] * oc[t][0] + oc[t][1] * oc[t][1]) + (oc[t][2] * oc[t][2] + oc[t][3] * oc[t][3]);
                ss += __shfl_xor(ss, 16); ss += __shfl_xor(ss, 32);
                if (g == 0) ((LAS float*)(L + RT_RXS))[dto * 64 + i] = ss;
                if (!SAMPLE || i < 32) { v2u o; o.x = cvtpk(oc[t][0], oc[t][1]); o.y = cvtpk(oc[t][2], oc[t][3]);
                    *(GAS v2u*)(ORET + (rowbase + (size_t)64 * c + i) * 1024 + 256 * h + 64 * s + 16 * dto + 4 * g) = o; }
            }
        }
#pragma unroll
        for (int k2 = 0; k2 < 2; ++k2)
#pragma unroll
            for (int dt = 0; dt < 4; ++dt) S[k2][dt] = S[k2][dt] * gL;
#pragma unroll
        for (int ks = 0; ks < 2; ++ks) {
            const int tok = 32 * ks + 8 * g + q4;
            bf16x8 ak[2];
#pragma unroll
            for (int k2 = 0; k2 < 2; ++k2) { const LAS unsigned char* kp = L + RT_KS + tok * 528 + (16 * (2 * w + k2) + 4 * p4) * 2; ak[k2] = cat8(trd(kp), trd(kp + 4 * 528)); }
#pragma unroll
            for (int dt = 0; dt < 4; ++dt) { const LAS unsigned char* vp = L + RT_VDS + tok * 144 + (16 * dt + 4 * p4) * 2; const bf16x8 bv = cat8(trd(vp), trd(vp + 4 * 144));
                S[0][dt] = MFMA16(ak[0], bv, S[0][dt]); S[1][dt] = MFMA16(ak[1], bv, S[1][dt]); }
        }
        LBAR();
        if (tid < 64 && (!SAMPLE || tid < 32)) { const LAS float* rx = (const LAS float*)(L + RT_RXS);
            RSS[(rowbase + (size_t)64 * c + tid) * 16 + h * 4 + s] = (rx[tid] + rx[64 + tid]) + (rx[128 + tid] + rx[192 + tid]); }
        if (c + 1 < NSTEP) RT_WRITE();
    }
    {
        int ln = lane; asm volatile("" : "+v"(ln));
        float* so = a.out + (SAMPLE ? O_SS : O_SP) + sbase + (size_t)(32 * w + 4 * (ln >> 4)) * 256 + (ln & 15);
#pragma unroll
        for (int k2 = 0; k2 < 2; ++k2)
#pragma unroll
            for (int dt = 0; dt < 4; ++dt)
#pragma unroll
                for (int r = 0; r < 4; ++r) so[(16 * k2 + r) * 256 + 16 * dt] = S[k2][dt][r];
    }
    LBAR();
#undef RT_LOAD
#undef RT_WRITE
}

constexpr int SB_KS = 0, SB_KT = 17408, SB_VS = 52224, SB_VT = 18432, SB_FLAGS = 107520, SB_OS = 0, SB_OSW = 8448;
static_assert(SB_KS + 3 * SB_KT <= SB_VS && SB_VS + 3 * SB_VT <= SB_FLAGS && SB_OS + 8 * SB_OSW <= SB_FLAGS && SB_FLAGS + 64 <= RING_BYTES, "SB LDS map");
constexpr float SB_EXIT = 40.0f * 1.4426950408889634f;
template <bool MASKED>
DI void sb_tile(const LAS unsigned char* kb, const LAS unsigned char* vb, const bf16x8 (&bq)[4], const bf16x8 acs, const bf16x8 ones, int key0, int qpos, float& carry, f32x4 (&oacc)[8]) {
    f32x4 z[4];
#pragma unroll
    for (int j = 0; j < 4; ++j) z[j] = (f32x4){0.f, 0.f, 0.f, 0.f};
#pragma unroll
    for (int ks = 0; ks < 4; ++ks)
#pragma unroll
        for (int j = 0; j < 4; ++j) { const bf16x8 ak = *(const LAS bf16x8*)(kb + j * 16 * 272 + ks * 64); z[j] = MFMA16(ak, bq[ks], z[j]); }
    float s[4][4], t[4];
#pragma unroll
    for (int j = 0; j < 4; ++j) {
        float v[4];
#pragma unroll
        for (int r = 0; r < 4; ++r) { const float zz = fminf(z[j][r], 100.0f); z[j][r] = zz; float vv = __builtin_amdgcn_logf(1.0f + __builtin_amdgcn_exp2f(zz));
            if (MASKED) vv = (key0 + 16 * j + r < qpos) ? vv : 0.f;
            v[r] = vv; }
        s[j][3] = v[3]; s[j][2] = v[3] + v[2]; s[j][1] = s[j][2] + v[1]; s[j][0] = s[j][1] + v[0]; t[j] = s[j][0];
    }
    const unsigned h01 = cvtpk(t[0], t[1]), h23 = cvtpk(t[2], t[3]);
    const unsigned l01 = cvtpk(t[0] - bflo(h01), t[1] - bfhi(h01)), l23 = cvtpk(t[2] - bflo(h23), t[3] - bfhi(h23));
    const bf16x8 bt = __builtin_bit_cast(bf16x8, (v4u){h01, h23, l01, l23});
    const f32x4 zero4 = (f32x4){0.f, 0.f, 0.f, 0.f};
    const f32x4 E = MFMA16(acs, bt, zero4), TOT = MFMA16(ones, bt, zero4);
    unsigned wp[4][2];
#pragma unroll
    for (int j = 0; j < 4; ++j) { const float ec = E[j] + carry; float wv[4];
#pragma unroll
        for (int r = 0; r < 4; ++r) { float ex = __builtin_amdgcn_exp2f((z[j][r] - s[j][r]) - ec); if (MASKED) ex = (key0 + 16 * j + r < qpos) ? ex : 0.f; wv[r] = ex; }
        wp[j][0] = cvtpk(wv[0], wv[1]); wp[j][1] = cvtpk(wv[2], wv[3]); }
    carry += TOT[0];
#pragma unroll
    for (int k2 = 0; k2 < 2; ++k2) { const bf16x8 bw = __builtin_bit_cast(bf16x8, (v4u){wp[2 * k2][0], wp[2 * k2][1], wp[2 * k2 + 1][0], wp[2 * k2 + 1][1]});
#pragma unroll
        for (int dt = 0; dt < 8; ++dt) { const bf16x8 av = cat8(trd(vb + (32 * k2) * 288 + dt * 32), trd(vb + (32 * k2 + 16) * 288 + dt * 32)); oacc[dt] = MFMA16(av, bw, oacc[dt]); } }
}
template <bool SAMPLE>
DI void sb_unit(const Args& a, LAS unsigned char* L, int b, int h, int qb, int tid, int lane, int w) {
    const int c15 = lane & 15, g = lane >> 4, q4 = c15 >> 2, p4 = c15 & 3;
    const bf16* R0 = (const bf16*)(a.ws + WS_R);
    const bf16 *RG = R0 + 3 * REG_E, *SQ = R0 + 4 * REG_E, *SK = R0 + 5 * REG_E, *SV = R0 + 6 * REG_E, *GA = R0 + 7 * REG_E, *GB = R0 + 8 * REG_E;
    const bf16* ORET = (const bf16*)(a.ws + WS_XN);
    bf16* MIX = (bf16*)(a.ws + WS_R);
    const float* RSS = (const float*)(a.ws + WS_RSS);
    const bool wvalid = SAMPLE ? (w < 2) : true;
    const int qwbase = SAMPLE ? PAST + 16 * w : 128 * qb + 16 * w;
    const int qpos = qwbase + c15;
    const size_t wrow0 = SAMPLE ? (size_t)MP + 32 * b + 16 * w : (size_t)4096 * b + qwbase;
    bf16x8 bq[4];
#pragma unroll
    for (int ks = 0; ks < 4; ++ks) bq[ks] = wvalid ? *(const GAS bf16x8*)(SQ + (wrow0 + c15) * 1024 + 128 * h + 32 * ks + 8 * g) : (bf16x8){0, 0, 0, 0, 0, 0, 0, 0};
    bf16x8 ones, acs;
#pragma unroll
    for (int e = 0; e < 8; ++e) { ones[e] = (short)0x3f80; acs[e] = (4 * (e & 3) + g > 4 * (c15 & 3) + (c15 >> 2)) ? (short)0x3f80 : (short)0; }
    const int T0 = SAMPLE ? 64 : 2 * qb + 1;
    float carry = 0.f;
    f32x4 oacc[8];
#pragma unroll
    for (int dt = 0; dt < 8; ++dt) oacc[dt] = (f32x4){0.f, 0.f, 0.f, 0.f};
    const int kl0 = tid >> 4, dp = tid & 15;
    v4u tk[2][2], tv[2][2]; f32x4 fk[2][2][2], fv[2][2][2];
#define SB_LOAD(S_, T_) do { _Pragma("unroll") for (int p_ = 0; p_ < 2; ++p_) { const int kl_ = kl0 + 32 * p_; \
        if (!SAMPLE) { const size_t go_ = ((size_t)4096 * b + 64 * (T_) + kl_) * 1024 + 128 * h + 8 * dp; tk[S_][p_] = *(const GAS v4u*)(SK + go_); tv[S_][p_] = *(const GAS v4u*)(SV + go_); } \
        else { const size_t go_ = (((size_t)b * 4096 + 64 * (T_) + kl_) * 8 + h) * 128 + 8 * dp; \
            fk[S_][p_][0] = *(const GAS f32x4*)(a.ck + go_); fk[S_][p_][1] = *(const GAS f32x4*)(a.ck + go_ + 4); fv[S_][p_][0] = *(const GAS f32x4*)(a.cv + go_); fv[S_][p_][1] = *(const GAS f32x4*)(a.cv + go_ + 4); } } } while (0)
#define SB_PARK(S_, B_) do { _Pragma("unroll") for (int p_ = 0; p_ < 2; ++p_) { const int kl_ = kl0 + 32 * p_; \
        if (SAMPLE) { tk[S_][p_] = (v4u){cvtpk(fk[S_][p_][0][0], fk[S_][p_][0][1]), cvtpk(fk[S_][p_][0][2], fk[S_][p_][0][3]), cvtpk(fk[S_][p_][1][0], fk[S_][p_][1][1]), cvtpk(fk[S_][p_][1][2], fk[S_][p_][1][3])}; \
            tv[S_][p_] = (v4u){cvtpk(fv[S_][p_][0][0], fv[S_][p_][0][1]), cvtpk(fv[S_][p_][0][2], fv[S_][p_][0][3]), cvtpk(fv[S_][p_][1][0], fv[S_][p_][1][1]), cvtpk(fv[S_][p_][1][2], fv[S_][p_][1][3])}; } \
        *(LAS v4u*)(L + SB_KS + (B_) * SB_KT + kl_ * 272 + dp * 16) = tk[S_][p_]; *(LAS v4u*)(L + SB_VS + (B_) * SB_VT + kl_ * 288 + dp * 16) = tv[S_][p_]; } } while (0)
    {
#pragma unroll
        for (int p = 0; p < 2; ++p) { const int kl = kl0 + 32 * p; v4u k0, v0;
            if (!SAMPLE) { const size_t go = ((size_t)4096 * b + 64 * T0 + kl) * 1024 + 128 * h + 8 * dp; k0 = *(const GAS v4u*)(SK + go); v0 = *(const GAS v4u*)(SV + go); }
            else if (kl < 32) { const size_t go = ((size_t)MP + 32 * b + kl) * 1024 + 128 * h + 8 * dp; k0 = *(const GAS v4u*)(SK + go); v0 = *(const GAS v4u*)(SV + go); }
            else { k0 = (v4u){0u, 0u, 0u, 0u}; v0 = (v4u){0u, 0u, 0u, 0u}; }
            *(LAS v4u*)(L + SB_KS + kl * 272 + dp * 16) = k0; *(LAS v4u*)(L + SB_VS + kl * 288 + dp * 16) = v0; }
    }
    if (T0 >= 1) SB_LOAD(0, T0 - 1);
    if (T0 >= 2) SB_LOAD(1, T0 - 2);
    int buf = 0;
    for (int it = 0;; ++it) {
        const int T = T0 - it; const int nb = (buf == 2) ? 0 : buf + 1;
        LBAR();
        if (it > 0) { const LAS unsigned* fl = (const LAS unsigned*)(L + SB_FLAGS) + 8 * ((it - 1) & 1);
            const unsigned any = (fl[0] | fl[1]) | (fl[2] | fl[3]) | (fl[4] | fl[5]) | (fl[6] | fl[7]);
            if (__builtin_amdgcn_readfirstlane(any) == 0u) break; }
        if (T > 0) {
            if (it & 1) { SB_PARK(1, nb); if (T >= 3) SB_LOAD(1, T - 3); }
            else        { SB_PARK(0, nb); if (T >= 3) SB_LOAD(0, T - 3); }
        }
        const bool alive = wvalid && (__ballot(carry < SB_EXIT) != 0ull);
        if (alive && 64 * T < qwbase + 16) {
            const LAS unsigned char* kb = L + SB_KS + buf * SB_KT + c15 * 272 + g * 16;
            const LAS unsigned char* vb = L + SB_VS + buf * SB_VT + (4 * g + q4) * 288 + 8 * p4;
            if (64 * T + 63 < qwbase) sb_tile<false>(kb, vb, bq, acs, ones, 64 * T + 4 * g, qpos, carry, oacc);
            else sb_tile<true>(kb, vb, bq, acs, ones, 64 * T + 4 * g, qpos, carry, oacc);
        }
        { const bool more = wvalid && (carry < SB_EXIT); const unsigned long long bal = __ballot(more);
          if (lane == 0) ((LAS unsigned*)(L + SB_FLAGS))[8 * (it & 1) + w] = (bal != 0ull) ? 1u : 0u; }
        if (T == 0) break;
        buf = nb;
    }
#undef SB_LOAD
#undef SB_PARK
    LBAR();
    if (wvalid) {
        LAS unsigned char* os = L + SB_OS + w * SB_OSW;
#pragma unroll
        for (int dt = 0; dt < 8; ++dt) *(LAS f32x4*)(os + c15 * 528 + (16 * dt + 4 * g) * 4) = oacc[dt];
        const int hr = h >> 1, ch = lane & 15, col = 128 * h + 8 * ch;
        const f32x4 rw0 = *(const f32x4*)(a.rnw + 256 * hr + (col & 255)), rw1 = *(const f32x4*)(a.rnw + 256 * hr + (col & 255) + 4);
        v4u orr[4], rg[4], ga[4], gb[4]; f32x4 rs[4];
#pragma unroll
        for (int k = 0; k < 4; ++k) { const size_t row = wrow0 + 4 * k + (lane >> 4), go = row * 1024 + col;
            orr[k] = *(const GAS v4u*)(ORET + go); rg[k] = *(const GAS v4u*)(RG + go); ga[k] = *(const GAS v4u*)(GA + go); gb[k] = *(const GAS v4u*)(GB + go);
            rs[k] = *(const GAS f32x4*)(RSS + row * 16 + hr * 4); }
        asm volatile("s_waitcnt lgkmcnt(0)" ::: "memory");
#pragma unroll
        for (int k = 0; k < 4; ++k) {
            const int r = 4 * k + (lane >> 4);
            const f32x4 o0 = *(const LAS f32x4*)(os + r * 528 + ch * 32), o1 = *(const LAS f32x4*)(os + r * 528 + ch * 32 + 16);
            const float rstd = 1.0f / sqrtf(((rs[k][0] + rs[k][1]) + (rs[k][2] + rs[k][3])) * (1.0f / 256.0f) + 1e-6f);
            v4u mo;
            mo.x = cvtpk(bflo(ga[k].x) * (bflo(orr[k].x) * rstd * rw0[0] * bflo(rg[k].x)) + bflo(gb[k].x) * o0[0], bfhi(ga[k].x) * (bfhi(orr[k].x) * rstd * rw0[1] * bfhi(rg[k].x)) + bfhi(gb[k].x) * o0[1]);
            mo.y = cvtpk(bflo(ga[k].y) * (bflo(orr[k].y) * rstd * rw0[2] * bflo(rg[k].y)) + bflo(gb[k].y) * o0[2], bfhi(ga[k].y) * (bfhi(orr[k].y) * rstd * rw0[3] * bfhi(rg[k].y)) + bfhi(gb[k].y) * o0[3]);
            mo.z = cvtpk(bflo(ga[k].z) * (bflo(orr[k].z) * rstd * rw1[0] * bflo(rg[k].z)) + bflo(gb[k].z) * o1[0], bfhi(ga[k].z) * (bfhi(orr[k].z) * rstd * rw1[1] * bfhi(rg[k].z)) + bfhi(gb[k].z) * o1[1]);
            mo.w = cvtpk(bflo(ga[k].w) * (bflo(orr[k].w) * rstd * rw1[2] * bflo(rg[k].w)) + bflo(gb[k].w) * o1[2], bfhi(ga[k].w) * (bfhi(orr[k].w) * rstd * rw1[3] * bfhi(rg[k].w)) + bfhi(gb[k].w) * o1[3]);
            *(GAS v4u*)(MIX + (wrow0 + r) * 1024 + col) = mo;
        }
    }
    LBAR();
}

DI void stagger(unsigned bx, unsigned ticks) {
    const unsigned grp = (bx >> 7) & 1u;
    if (grp) { const unsigned long long t1 = __builtin_amdgcn_s_memrealtime() + (unsigned long long)ticks;
        while (__builtin_amdgcn_s_memrealtime() < t1) __builtin_amdgcn_s_sleep(16); }
}
#ifndef STAGGER
#define STAGGER 0
#endif
#ifndef PROBE_DUP
#define PROBE_DUP 0
#endif
__global__ void __launch_bounds__(NWAVES * 64, 2) mk_fwd(Args a) {
    extern __shared__ __attribute__((aligned(16))) unsigned char lds_raw[];
    LAS unsigned char* lds = (LAS unsigned char*)lds_raw;
    const int tid = threadIdx.x;
    const int G = gridDim.x, bx = blockIdx.x, vcu = (G % 8 == 0) ? (bx % 8) * (G / 8) + bx / 8 : bx;
    volatile LAS unsigned* MISC = (volatile LAS unsigned*)(lds + MISC_OFF);
    if (tid < 16) MISC[tid] = 0u;
    __syncthreads();
    XcdBarrier bar = xcd_barrier_post((unsigned*)(a.ws + WS_CTL) + CW_BAR, MISC + 8);
    unsigned char* ws = a.ws;
    bf16* R0 = (bf16*)(ws + WS_R);

#define PHASE_IDS(T_, L_, W_) int T_ = threadIdx.x; asm volatile("" : "+v"(T_)); const int L_ = T_ & 63, W_ = __builtin_amdgcn_readfirstlane(T_ >> 6)
    { PHASE_IDS(t0, l0, w0); (void)t0; p0_prologue(a, lds, vcu, G, w0, l0); }
#if PROBE_DUP == 6
    { PHASE_IDS(t0, l0, w0); (void)t0; p0_prologue(a, lds, vcu, G, w0, l0); }
#endif
    xcd_barrier(bar);

    {
        pg8::Gemm g{(const pg8::bf16_t*)(ws + WS_XN), (const pg8::bf16_t*)(ws + WS_WIN), M, NIN, DM}; pg8::StaticOrder S; S.init(M, NIN, G, bx);
        pg8::EpiIn E{(pg8::bf16_t*)R0, a.out, (const float*)(ws + WS_ROPE), a.qnw, a.knw, (LAS float*)(lds + XCH_OFF)};
#if STAGGER
        stagger((unsigned)bx, 1700u);
#endif
        pg8::gemm_phase<pg8::EpiIn, pg8::StaticOrder, true, true>(lds, g, S, E);
#if PROBE_DUP == 1
        pg8::gemm_phase<pg8::EpiIn, pg8::StaticOrder, true, true>(lds, g, S, E);
#endif
    }
    xcd_barrier(bar);

#if PROBE_DUP == 2
    { PHASE_IDS(t1, l1, w1); for (int u = vcu; u < 512; u += G) ret_unit<true>(a, lds, (u >> 2) >> 2, (u >> 2) & 3, u & 3, t1, l1, w1); }
    { PHASE_IDS(t2, l2, w2); for (int u = vcu; u < 256; u += G) ret_unit<false>(a, lds, (u >> 2) >> 2, (u >> 2) & 3, u & 3, t2, l2, w2); }
#endif
    { PHASE_IDS(t1, l1, w1); for (int u = vcu; u < 512; u += G) ret_unit<true>(a, lds, (u >> 2) >> 2, (u >> 2) & 3, u & 3, t1, l1, w1); }
    { PHASE_IDS(t2, l2, w2); for (int u = vcu; u < 256; u += G) ret_unit<false>(a, lds, (u >> 2) >> 2, (u >> 2) & 3, u & 3, t2, l2, w2); }
    xcd_barrier(bar);

#if PROBE_DUP == 3
    { PHASE_IDS(t3, l3, w3); for (int u = vcu; u < 256; u += G) sb_unit<true>(a, lds, u >> 3, u & 7, 0, t3, l3, w3); }
    { PHASE_IDS(t4, l4, w4); for (int u = vcu; u < 4096; u += G) sb_unit<false>(a, lds, (u >> 5) >> 3, (u >> 5) & 7, u & 31, t4, l4, w4); }
#endif
    { PHASE_IDS(t3, l3, w3); for (int u = vcu; u < 256; u += G) sb_unit<true>(a, lds, u >> 3, u & 7, 0, t3, l3, w3); }
    { PHASE_IDS(t4, l4, w4); for (int u = vcu; u < 4096; u += G) sb_unit<false>(a, lds, (u >> 5) >> 3, (u >> 5) & 7, u & 31, t4, l4, w4); }
    xcd_barrier(bar);

    {
        pg8::Gemm g{(const pg8::bf16_t*)R0, (const pg8::bf16_t*)(ws + WS_WOUT), M, DM, DM}; pg8::StaticOrder S; S.init(M, DM, G, bx);
        pg8::EpiRes1 E{a.xp, a.xs, a.out, (pg8::bf16_t*)(R0 + REG_E), (float*)(ws + WS_SSQ)};
        pg8::gemm_phase<pg8::EpiRes1, pg8::StaticOrder, true, true>(lds, g, S, E);
#if PROBE_DUP == 4
        pg8::gemm_phase<pg8::EpiRes1, pg8::StaticOrder, true, true>(lds, g, S, E);
#endif
    }
    xcd_barrier(bar);

    {
        pg8::Gemm g{(const pg8::bf16_t*)(R0 + REG_E), (const pg8::bf16_t*)(ws + WS_WUP), M, FF, DM}; pg8::StaticOrder S; S.init(M, FF, G, bx);
        pg8::EpiUp E{(pg8::bf16_t*)(R0 + 4 * REG_E), (const float*)(ws + WS_SSQ)};
#if STAGGER
        stagger((unsigned)bx, 1400u);
#endif
        pg8::gemm_phase<pg8::EpiUp, pg8::StaticOrder, true, true>(lds, g, S, E);
#if PROBE_DUP == 5
        pg8::gemm_phase<pg8::EpiUp, pg8::StaticOrder, true, true>(lds, g, S, E);
#endif
#if PROBE_DUP == 7
        { pg8::EpiNull EN{(float*)(ws + WS_SSQ)}; pg8::gemm_phase<pg8::EpiNull, pg8::StaticOrder, true, true>(lds, g, S, EN); }
#endif
    }
    xcd_barrier(bar);

    {
        pg8::Gemm g{(const pg8::bf16_t*)(R0 + 4 * REG_E), (const pg8::bf16_t*)(ws + WS_WDN), M, DM, FF}; pg8::StaticOrder S; S.init(M, DM, G, bx);
        pg8::EpiDown E{a.out};
        pg8::gemm_phase<pg8::EpiDown, pg8::StaticOrder, true, true>(lds, g, S, E);
    }
}

extern "C" void kernel_launch(void* const* d_in, const int* in_sizes, int n_in, void* d_out, int out_size, void* d_ws, size_t ws_size, hipStream_t stream) {
    static int grid = 0;
    if (grid == 0) {
        if (n_in != 14 || in_sizes[0] != MP * DM || out_size != (int)O_END || ws_size < WS_END) {
            fprintf(stderr, "kernel_launch: unexpected shapes: n_in %d in0 %d out %d ws %zu (need %zu)\n", n_in, n_in > 0 ? in_sizes[0] : -1, out_size, ws_size, (size_t)WS_END); grid = -1; return; }
        int dev = 0, cus = 0, per_cu = 0;
        if (hipGetDevice(&dev) != hipSuccess || hipDeviceGetAttribute(&cus, hipDeviceAttributeMultiprocessorCount, dev) != hipSuccess) { grid = -1; return; }
        if (hipFuncSetAttribute((const void*)mk_fwd, hipFuncAttributeMaxDynamicSharedMemorySize, LDS_BYTES) != hipSuccess) { fprintf(stderr, "kernel_launch: hipFuncSetAttribute failed\n"); grid = -1; return; }
        if (hipOccupancyMaxActiveBlocksPerMultiprocessor(&per_cu, (const void*)mk_fwd, NWAVES * 64, LDS_BYTES) != hipSuccess || per_cu < 1) { fprintf(stderr, "kernel_launch: occupancy query reports %d blocks per CU\n", per_cu); }
        (void)hipGetLastError();
        grid = cus;
    }
    if (grid < 0) return;
    if (hipMemsetAsync((char*)d_ws + WS_CTL, 0, CTL_ZERO_BYTES, stream) != hipSuccess) return;
    Args a{};
    a.xp = (const float*)d_in[0]; a.xs = (const float*)d_in[1]; a.ck = (const float*)d_in[2]; a.cv = (const float*)d_in[3]; a.st = (const float*)d_in[4];
    a.nmix = (const float*)d_in[5]; a.win = (const float*)d_in[6]; a.rnw = (const float*)d_in[7]; a.qnw = (const float*)d_in[8]; a.knw = (const float*)d_in[9];
    a.wout = (const float*)d_in[10]; a.nmlp = (const float*)d_in[11]; a.wup = (const float*)d_in[12]; a.wdn = (const float*)d_in[13];
    a.out = (float*)d_out; a.ws = (unsigned char*)d_ws;
    hipLaunchKernelGGL(mk_fwd, dim3(grid), dim3(NWAVES * 64), LDS_BYTES, stream, a);
}
```

```cpp
#ifndef PROBE_DUP
#define PROBE_DUP 0
#endif
#include <hip/hip_runtime.h>
#include <cstdio>
#include <cstdint>
#include <cmath>
namespace pg8 {
#define PG8_LAS __attribute__((address_space(3)))
typedef unsigned short bf16_t;
typedef short bf16x8 __attribute__((ext_vector_type(8)));
typedef float f32x4 __attribute__((ext_vector_type(4)));
typedef unsigned u32x4 __attribute__((ext_vector_type(4)));
constexpr int BM = 256, BK = 64, HALF = 128, HTB = HALF * BK * 2  , STAGE_BYTES = 8 * HTB, NXCD = 8, WGM = 8;

__host__ __device__ __forceinline__ int lds_byte(int r, int c) { const int st = (r >> 4) * 2 + (c >> 5), rr = r & 15, cc = c & 31, ob = rr * 64 + cc * 2; return st * 1024 + (ob ^ (((ob >> 9) & 1) << 5)); }
__host__ __device__ __forceinline__ void stage_rc(int b, int& R, int& C) { const int st = b / 1024, sb = b % 1024, swz = sb ^ (((sb >> 9) & 1) << 5); R = (st >> 1) * 16 + swz / 64; C = (st & 1) * 32 + (swz % 64) / 2; }
__host__ __device__ __forceinline__ int perm32(int rho) { const int n = rho >> 4, i = rho & 15; return 8 * (i >> 2) + 4 * n + (i & 3); }

struct Unit { int pm, pn; };
struct Gemm { const bf16_t* A; const bf16_t* Bt; int M, N, K; };

struct StaticOrder {
    int nM, nN, nwg, G, c;
    __host__ __device__ void init(int M, int N, int G_, int c_) { nM = M / BM; nN = N / BM; nwg = nM * nN; G = G_; c = c_; }
    __host__ __device__ bool next(int i, Unit& u) const {
        const long L = (long)i * G + c; if (L >= nwg) return false;
        int wgid = (int)L; { const int q = nwg / NXCD, r = nwg % NXCD, xcd = wgid % NXCD, off = wgid / NXCD; wgid = (xcd < r ? xcd * (q + 1) : r * (q + 1) + (xcd - r) * q) + off; }
        const int nig = WGM * nN, gid = wgid / nig, fm = gid * WGM, gsz = (nM - fm) < WGM ? (nM - fm) : WGM;
        u.pm = fm + ((wgid % nig) % gsz); u.pn = (wgid % nig) / gsz; return true;
    }
    __device__ __forceinline__ void a_ready(const Unit&) const {}
    __device__ __forceinline__ void done(const Unit&) const {}
};

__device__ __forceinline__ unsigned cvt_pk_bf16(float lo, float hi) { unsigned r; asm volatile("v_cvt_pk_bf16_f32 %0, %1, %2" : "=v"(r) : "v"(lo), "v"(hi)); return r; }
typedef float f32x2 __attribute__((ext_vector_type(2)));

typedef unsigned u32x2 __attribute__((ext_vector_type(2)));
typedef float f32x2_t __attribute__((ext_vector_type(2))); typedef __bf16 bf16x2_t __attribute__((ext_vector_type(2)));
__device__ __forceinline__ unsigned cvtpk(float lo, float hi) { f32x2_t v = {lo, hi}; bf16x2_t b = __builtin_convertvector(v, bf16x2_t); return __builtin_bit_cast(unsigned, b); }
__device__ __forceinline__ void store8(bf16_t* p, const f32x4 a, const f32x4 b) { u32x4 w; w.x = cvtpk(a[0], a[1]); w.y = cvtpk(a[2], a[3]); w.z = cvtpk(b[0], b[1]); w.w = cvtpk(b[2], b[3]); *(u32x4*)p = w; }
__device__ __forceinline__ float sigmoidf_fast(float x) { return __builtin_amdgcn_rcpf(1.0f + __builtin_amdgcn_exp2f(-1.4426950408889634f * x)); }
__device__ __forceinline__ float sumsq4(const f32x4 a) { return (a[0] * a[0] + a[1] * a[1]) + (a[2] * a[2] + a[3] * a[3]); }

constexpr int E_MP = 65536;
constexpr size_t E_REG = (size_t)66560 * 1024;
constexpr size_t EO_KP = 68157440, EO_VP = 135266304, EO_KS = 206569472, EO_VS = 207618048;

__device__ __forceinline__ unsigned ror8(unsigned x) { return (unsigned)__builtin_amdgcn_mov_dpp((int)x, 0x128, 0xf, 0xf, true); }
__device__ __forceinline__ u32x4 ror8v(const u32x4 v) { u32x4 r; r.x = ror8(v.x); r.y = ror8(v.y); r.z = ror8(v.z); r.w = ror8(v.w); return r; }
__device__ __forceinline__ u32x4 pack8(const f32x4 a, const f32x4 b) { u32x4 w; w.x = cvtpk(a[0], a[1]); w.y = cvtpk(a[2], a[3]); w.z = cvtpk(b[0], b[1]); w.w = cvtpk(b[2], b[3]); return w; }
__device__ __forceinline__ void store_rows_bf16(bf16_t* grp, size_t ld, int fr, int fq, const u32x4 P0, const u32x4 P1) {
    const bool lo = fr < 8; const u32x4 snd = lo ? P1 : P0, rcv = ror8v(snd);
    bf16_t* a = grp + (size_t)(fr & 7) * ld + (fq + 4 * (fr >> 3)) * 8;
    *(u32x4*)a = lo ? P0 : rcv; *(u32x4*)(a + 8 * ld) = lo ? rcv : P1;
}
__device__ __forceinline__ void store_rows_f32(float* grp, size_t ld, int fr, int fq, const f32x4 V0, const f32x4 V1) {
    const bool lo = fr < 8; const u32x4 snd = __builtin_bit_cast(u32x4, lo ? V1 : V0), rcv = ror8v(snd);
    float* a = grp + (size_t)(fr & 7) * ld + (2 * fq + (fr >> 3)) * 4;
    *(u32x4*)a = lo ? __builtin_bit_cast(u32x4, V0) : rcv; *(u32x4*)(a + 8 * ld) = lo ? rcv : __builtin_bit_cast(u32x4, V1);
}
struct RowPair { u32x4 a, b; };
__device__ __forceinline__ RowPair load_rows_f32(const float* grp, size_t ld, int fr, int fq) {
    const float* a = grp + (size_t)(fr & 7) * ld + (2 * fq + (fr >> 3)) * 4; RowPair r; r.a = *(const u32x4*)a; r.b = *(const u32x4*)(a + 8 * ld); return r;
}
__device__ __forceinline__ void unswap_rows_f32(const RowPair r, int fr, f32x4& V0, f32x4& V1) {
    const bool lo = fr < 8; const u32x4 snd = lo ? r.b : r.a, rcv = ror8v(snd);
    V0 = __builtin_bit_cast(f32x4, lo ? r.a : rcv); V1 = __builtin_bit_cast(f32x4, lo ? rcv : r.b);
}

struct EpiIn {
    static constexpr bool PERM = true, AFTER_DRAIN = false, DUP_OK = true;
    bf16_t* R; float* out; const float* rope; const float* qw; const float* kw; PG8_LAS float* xch;
    __device__ __forceinline__ void operator()(const f32x4 (&acc)[2][2][4][2], const Unit& u, int wr, int wc, int fr, int fq) const {
        const int tt = u.pn >> 2, hq = u.pn & 3;
        const int rowg = u.pm * BM + wr * 64;
        bf16_t* base = R + (size_t)tt * E_REG + hq * 256 + 64 * wc;
        if (tt <= 1) {
            const float sc = (tt == 1) ? 0.0625f : 1.0f;
            const int cl = 32 * wc + 8 * fq;
            f32x4 tb[2][4];
#define ROPE_LD(g_) do { const int row_ = rowg + fr + ((g_) >> 2) * HALF + ((g_) & 3) * 16; const int pos_ = (row_ < E_MP) ? (row_ & 4095) : (4096 + (row_ & 31)); \
                const f32x4* tp_ = (const f32x4*)(rope + ((size_t)pos_ * 128 + cl) * 2); tb[(g_) & 1][0] = tp_[0]; tb[(g_) & 1][1] = tp_[1]; tb[(g_) & 1][2] = tp_[2]; tb[(g_) & 1][3] = tp_[3]; } while (0)
            ROPE_LD(0);
#pragma unroll
            for (int gi = 0; gi < 8; ++gi) {
                const int ai = gi >> 2, m = gi & 3;
                if (gi < 7) ROPE_LD(gi + 1);
                asm volatile("" ::: "memory");
                f32x4 o1[2], o2[2];
#pragma unroll
                for (int n = 0; n < 2; ++n) {
                    const f32x4 t0 = tb[gi & 1][2 * n], t1 = tb[gi & 1][2 * n + 1], x1 = acc[ai][0][m][n], x2 = acc[ai][1][m][n];
                    o1[n] = (f32x4){x1[0] * t0[0] - x2[0] * t0[1], x1[1] * t0[2] - x2[1] * t0[3], x1[2] * t1[0] - x2[2] * t1[1], x1[3] * t1[2] - x2[3] * t1[3]} * sc;
                    o2[n] = (f32x4){x1[0] * t0[1] + x2[0] * t0[0], x1[1] * t0[3] + x2[1] * t0[2], x1[2] * t1[1] + x2[2] * t1[0], x1[3] * t1[3] + x2[3] * t1[2]} * sc;
                }
                store_rows_bf16(base + (size_t)(rowg + ai * HALF + m * 16) * 1024, 1024, fr, fq, pack8(o1[0], o1[1]), pack8(o2[0], o2[1]));
            }
#undef ROPE_LD
        } else if (tt == 4 || tt == 5) {
            const float* wsrc = ((tt == 4) ? qw : kw) + 64 * (wc & 1) + 8 * fq;
            const f32x4 w00 = *(const f32x4*)(wsrc), w01 = *(const f32x4*)(wsrc + 4), w10 = *(const f32x4*)(wsrc + 32), w11 = *(const f32x4*)(wsrc + 36);
            const float osc = (tt == 4) ? 0.08838834764831845f * 1.4426950408889634f : 1.0f;
#pragma unroll
            for (int ai = 0; ai < 2; ++ai)
#pragma unroll
                for (int m = 0; m < 4; ++m) {
                    float s = (sumsq4(acc[ai][0][m][0]) + sumsq4(acc[ai][0][m][1])) + (sumsq4(acc[ai][1][m][0]) + sumsq4(acc[ai][1][m][1]));
                    s += __shfl_xor(s, 16); s += __shfl_xor(s, 32);
                    if (fq == 0) xch[(ai * HALF + wr * 64 + m * 16 + fr) * 4 + wc] = s;
                }
            asm volatile("s_waitcnt lgkmcnt(0)" ::: "memory"); __builtin_amdgcn_s_barrier(); asm volatile("" ::: "memory");
            float* ok = ((u.pm * BM < E_MP) ? out + EO_KP : out + EO_KS - (size_t)E_MP * 1024) + hq * 256 + 64 * wc;
#pragma unroll
            for (int ai = 0; ai < 2; ++ai)
#pragma unroll
                for (int m = 0; m < 4; ++m) {
                    const int rl = ai * HALF + wr * 64 + m * 16 + fr; const size_t grow = (size_t)(rowg + ai * HALF + m * 16);
                    const f32x4 p = *(const PG8_LAS f32x4*)(xch + rl * 4);
                    const float rstd = osc / sqrtf(((wc < 2) ? (p[0] + p[1]) : (p[2] + p[3])) * (1.0f / 128.0f) + 1e-6f);
                    const f32x4 v00 = acc[ai][0][m][0] * rstd * w00, v01 = acc[ai][0][m][1] * rstd * w01, v10 = acc[ai][1][m][0] * rstd * w10, v11 = acc[ai][1][m][1] * rstd * w11;
                    if (tt == 5) { store_rows_f32(ok + grow * 1024, 1024, fr, fq, v00, v01); store_rows_f32(ok + grow * 1024 + 32, 1024, fr, fq, v10, v11); }
                    store_rows_bf16(base + grow * 1024, 1024, fr, fq, pack8(v00, v01), pack8(v10, v11));
                }
        } else {
            float* ov = ((u.pm * BM < E_MP) ? out + EO_VP : out + EO_VS - (size_t)E_MP * 1024) + hq * 256 + 64 * wc;
#pragma unroll
            for (int ai = 0; ai < 2; ++ai)
#pragma unroll
                for (int m = 0; m < 4; ++m) {
                    const size_t grow = (size_t)(rowg + ai * HALF + m * 16);
                    f32x4 v[2][2];
#pragma unroll
                    for (int bj = 0; bj < 2; ++bj) {
                        v[bj][0] = acc[ai][bj][m][0]; v[bj][1] = acc[ai][bj][m][1];
                        if (tt == 3) {
#pragma unroll
                            for (int e = 0; e < 4; ++e) { v[bj][0][e] *= sigmoidf_fast(v[bj][0][e]); v[bj][1][e] *= sigmoidf_fast(v[bj][1][e]); }
                        } else if (tt >= 7) {
#pragma unroll
                            for (int e = 0; e < 4; ++e) { v[bj][0][e] = sigmoidf_fast(v[bj][0][e]); v[bj][1][e] = sigmoidf_fast(v[bj][1][e]); }
                        }
                    }
                    if (tt == 6) { store_rows_f32(ov + grow * 1024, 1024, fr, fq, v[0][0], v[0][1]); store_rows_f32(ov + grow * 1024 + 32, 1024, fr, fq, v[1][0], v[1][1]); }
                    store_rows_bf16(base + grow * 1024, 1024, fr, fq, pack8(v[0][0], v[0][1]), pack8(v[1][0], v[1][1]));
                }
        }
    }
};

struct EpiRes1 {
    static constexpr bool PERM = true, AFTER_DRAIN = false, DUP_OK = true;
    const float* xp; const float* xs; float* out; bf16_t* XB; float* SSQ;
    __device__ __forceinline__ void operator()(const f32x4 (&acc)[2][2][4][2], const Unit& u, int wr, int wc, int fr, int fq) const {
        const int rowg = u.pm * BM + wr * 64, colw = u.pn * BM + 64 * wc;
        const float* xb = ((u.pm * BM < E_MP) ? xp : xs - (size_t)E_MP * 1024) + colw;
        RowPair xv[2][2];
#define RES_LD(g_) do { const size_t off_ = (size_t)(rowg + ((g_) >> 2) * HALF + ((g_) & 3) * 16) * 1024; xv[(g_) & 1][0] = load_rows_f32(xb + off_, 1024, fr, fq); xv[(g_) & 1][1] = load_rows_f32(xb + off_ + 32, 1024, fr, fq); } while (0)
        RES_LD(0);
#pragma unroll
        for (int gi = 0; gi < 8; ++gi) {
            const int ai = gi >> 2, m = gi & 3;
            if (gi < 7) RES_LD(gi + 1);
            asm volatile("" ::: "memory");
            const size_t grow = (size_t)(rowg + ai * HALF + m * 16); float ss = 0.f;
            f32x4 v[2][2];
#pragma unroll
            for (int bj = 0; bj < 2; ++bj) {
                f32x4 x0, x1; unswap_rows_f32(xv[gi & 1][bj], fr, x0, x1);
                v[bj][0] = acc[ai][bj][m][0] + x0; v[bj][1] = acc[ai][bj][m][1] + x1;
                ss += sumsq4(v[bj][0]) + sumsq4(v[bj][1]);
                store_rows_f32(out + grow * 1024 + colw + 32 * bj, 1024, fr, fq, v[bj][0], v[bj][1]);
            }
            store_rows_bf16(XB + grow * 1024 + colw, 1024, fr, fq, pack8(v[0][0], v[0][1]), pack8(v[1][0], v[1][1]));
            ss += __shfl_xor(ss, 16); ss += __shfl_xor(ss, 32);
            if (fq == 0) SSQ[(grow + fr) * 16 + u.pn * 4 + wc] = ss;
        }
#undef RES_LD
    }
};

struct EpiUp {
    static constexpr bool PERM = true, AFTER_DRAIN = false, DUP_OK = true;
    bf16_t* H; const float* SSQ;
    __device__ __forceinline__ void operator()(const f32x4 (&acc)[2][2][4][2], const Unit& u, int wr, int wc, int fr, int fq) const {
        const int rowg = u.pm * BM + wr * 64, colw = u.pn * BM + 64 * wc;
        f32x4 sq[2][4];
#pragma unroll
        for (int ai = 0; ai < 2; ++ai)
#pragma unroll
            for (int m = 0; m < 4; ++m) sq[ai][m] = *(const f32x4*)(SSQ + (size_t)(rowg + fr + ai * HALF + m * 16) * 16 + 4 * fq);
        asm volatile("" ::: "memory");
#pragma unroll
        for (int ai = 0; ai < 2; ++ai)
#pragma unroll
            for (int m = 0; m < 4; ++m) {
                float t = (sq[ai][m][0] + sq[ai][m][1]) + (sq[ai][m][2] + sq[ai][m][3]);
                t += __shfl_xor(t, 16); t += __shfl_xor(t, 32);
                const float r2 = 1.0f / (t * (1.0f / 1024.0f) + 1e-6f);
                f32x4 v[2][2];
#pragma unroll
                for (int bj = 0; bj < 2; ++bj) {
                    v[bj][0] = acc[ai][bj][m][0]; v[bj][1] = acc[ai][bj][m][1];
#pragma unroll
                    for (int e = 0; e < 4; ++e) { const float a = fmaxf(v[bj][0][e], 0.f), b = fmaxf(v[bj][1][e], 0.f); v[bj][0][e] = a * a * r2; v[bj][1][e] = b * b * r2; }
                }
                store_rows_bf16(H + (size_t)(rowg + ai * HALF + m * 16) * 4096 + colw, 4096, fr, fq, pack8(v[0][0], v[0][1]), pack8(v[1][0], v[1][1]));
            }
    }
};

struct EpiDown {
    static constexpr bool PERM = true, AFTER_DRAIN = false, DUP_OK = false;
    float* out;
    __device__ __forceinline__ void operator()(const f32x4 (&acc)[2][2][4][2], const Unit& u, int wr, int wc, int fr, int fq) const {
        const int rowg = u.pm * BM + wr * 64, colw = u.pn * BM + 64 * wc;
        RowPair xv[2][2];
#define DN_LD(g_) do { const float* o_ = out + (size_t)(rowg + ((g_) >> 2) * HALF + ((g_) & 3) * 16) * 1024 + colw; xv[(g_) & 1][0] = load_rows_f32(o_, 1024, fr, fq); xv[(g_) & 1][1] = load_rows_f32(o_ + 32, 1024, fr, fq); } while (0)
        DN_LD(0);
#pragma unroll
        for (int gi = 0; gi < 8; ++gi) {
            const int ai = gi >> 2, m = gi & 3;
            if (gi < 7) DN_LD(gi + 1);
            asm volatile("" ::: "memory");
            float* o = out + (size_t)(rowg + ai * HALF + m * 16) * 1024 + colw;
#pragma unroll
            for (int bj = 0; bj < 2; ++bj) {
                f32x4 x0, x1; unswap_rows_f32(xv[gi & 1][bj], fr, x0, x1);
                store_rows_f32(o + 32 * bj, 1024, fr, fq, acc[ai][bj][m][0] + x0, acc[ai][bj][m][1] + x1);
            }
        }
#undef DN_LD
    }
};

struct EpiNull {
    static constexpr bool PERM = true, AFTER_DRAIN = false, DUP_OK = false;
    float* sink;
    __device__ __forceinline__ void operator()(const f32x4 (&acc)[2][2][4][2], const Unit& u, int wr, int wc, int fr, int fq) const {
        float t = 0.f;
#pragma unroll
        for (int ai = 0; ai < 2; ++ai)
#pragma unroll
            for (int bj = 0; bj < 2; ++bj)
#pragma unroll
                for (int m = 0; m < 4; ++m)
#pragma unroll
                    for (int n = 0; n < 2; ++n) t += (acc[ai][bj][m][n][0] + acc[ai][bj][m][n][1]) + (acc[ai][bj][m][n][2] + acc[ai][bj][m][n][3]);
        if (t == 123456.789f) sink[u.pm * 7 + u.pn + wr + wc + fr + fq] = t;
    }
};

struct EpiLinear {
    static constexpr bool PERM = true, AFTER_DRAIN = false, DUP_OK = false;
    bf16_t* sink;
    __device__ __forceinline__ void operator()(const f32x4 (&acc)[2][2][4][2], const Unit& u, int wr, int wc, int fr, int fq) const {
#if PROBE_DUP == 11
        const int l_ = fq * 16 + fr;
        bf16_t* base = sink + (size_t)((u.pm * 16 + u.pn) & 255) * 131072 + (size_t)(l_ >> 3) * 1024 + (wr * 4 + wc) * 64 + (l_ & 7) * 8;
#define LIN_STEP 8192
#else
        bf16_t* base = sink + (size_t)((u.pm * 16 + u.pn) & 255) * 65536 + (size_t)(wr * 4 + wc) * 8192 + (fq * 16 + fr) * 8;
#define LIN_STEP 512
#endif
#pragma unroll
        for (int ai = 0; ai < 2; ++ai)
#pragma unroll
            for (int m = 0; m < 4; ++m)
#pragma unroll
                for (int bj = 0; bj < 2; ++bj) store8(base + ((ai * 4 + m) * 2 + bj) * LIN_STEP, acc[ai][bj][m][0], acc[ai][bj][m][1]);
    }
};
template <class Epi, class Sched, bool ALIGN_EPI = false, bool SP2 = false>
__device__ __forceinline__ void gemm_phase(PG8_LAS unsigned char* lds, const Gemm g, const Sched& S, const Epi& E) {
    int tid_ = threadIdx.x; asm volatile("" : "+v"(tid_));
    const int tid = tid_, wid = __builtin_amdgcn_readfirstlane(tid >> 6), lane = tid & 63, wr = wid >> 2, wc = wid & 3, fr = lane & 15, fq = lane >> 4;
    const int K = g.K, nt = K / BK;
    unsigned voffA[2], voffB[2];
#pragma unroll
    for (int i = 0; i < 2; ++i) { int R, C; stage_rc(tid * 16 + i * 8192, R, C); const int Rb = Epi::PERM ? ((R & ~31) + perm32(R & 31)) : R;
        voffA[i] = (unsigned)(R * K + C) * 2u; voffB[i] = (unsigned)(Rb * K + C) * 2u; }
    const size_t kstep = (size_t)(BK * 2);
    const size_t hstep = (size_t)HALF * K * 2;
    const size_t tstep = 2 * hstep;
    const unsigned ldsw = (unsigned)wid * 1024u;
    const int aoff = lds_byte(wr * 64 + fr, fq * 8), boff = lds_byte(wc * 32 + fr, fq * 8);
#define PG8_SA(b, h) (((b) * 2 + (h)) * HTB)
#define PG8_SB(b, h) ((4 + (b) * 2 + (h)) * HTB)
#define PG8_STAGE(bufoff, gbase, voff) do { _Pragma("unroll") for (int _i = 0; _i < 2; ++_i) \
        __builtin_amdgcn_global_load_lds((const unsigned*)((const char*)(gbase) + (voff)[_i]), (PG8_LAS unsigned*)(lds + (bufoff) + ldsw + _i * 8192), 16, 0, 0); } while (0)
#define PG8_LDA(dst, b, h) do { _Pragma("unroll") for (int m = 0; m < 4; ++m) _Pragma("unroll") for (int k = 0; k < 2; ++k) dst[m][k] = *(const PG8_LAS bf16x8*)(lds + PG8_SA(b, h) + aoff + m * 2048 + k * 1024); } while (0)
#define PG8_LDB(dst, b, h) do { _Pragma("unroll") for (int n = 0; n < 2; ++n) _Pragma("unroll") for (int k = 0; k < 2; ++k) dst[n][k] = *(const PG8_LAS bf16x8*)(lds + PG8_SB(b, h) + boff + n * 2048 + k * 1024); } while (0)
#define PG8_MMA(ai, bj, At, Bt) do { __builtin_amdgcn_s_setprio(1); _Pragma("unroll") for (int m = 0; m < 4; ++m) _Pragma("unroll") for (int n = 0; n < 2; ++n) _Pragma("unroll") for (int k = 0; k < 2; ++k) \
        acc[ai][bj][m][n] = __builtin_amdgcn_mfma_f32_16x16x32_bf16(Bt[n][k], At[m][k], acc[ai][bj][m][n], 0, 0, 0); __builtin_amdgcn_s_setprio(0); } while (0)
#define PG8_WAIT_V(n) asm volatile("s_waitcnt vmcnt(" #n ")" ::: "memory")
#define PG8_WAIT_L(n) asm volatile("s_waitcnt lgkmcnt(" #n ")" ::: "memory")
#define PG8_BAR __builtin_amdgcn_s_barrier()
#define PG8_SCHED __builtin_amdgcn_sched_barrier(0)
    Unit cur, nxt; int ui = 0;
    if (!S.next(0, cur)) return;
    f32x4 acc[2][2][4][2];
#pragma unroll
    for (int a = 0; a < 2; ++a)
#pragma unroll
        for (int b = 0; b < 2; ++b)
#pragma unroll
            for (int m = 0; m < 4; ++m)
#pragma unroll
                for (int n = 0; n < 2; ++n) acc[a][b][m][n] = (f32x4){0.f, 0.f, 0.f, 0.f};
    bf16x8 At[4][2], B0[2][2], B1[2][2];
    const char* cA = (const char*)g.A + (size_t)cur.pm * tstep; const char* cB = (const char*)g.Bt + (size_t)cur.pn * tstep;
    S.a_ready(cur);
    if constexpr (SP2) {
        PG8_STAGE(PG8_SB(0, 0), cB, voffB); PG8_STAGE(PG8_SB(0, 1), cB + hstep, voffB); PG8_STAGE(PG8_SA(0, 0), cA, voffA); PG8_STAGE(PG8_SA(0, 1), cA + hstep, voffA);
        if (wr == 1) PG8_BAR;
        PG8_WAIT_V(2); PG8_BAR;
        PG8_STAGE(PG8_SB(1, 0), cB + kstep, voffB); PG8_STAGE(PG8_SA(1, 0), cA + kstep, voffA); PG8_STAGE(PG8_SB(1, 1), cB + hstep + kstep, voffB);
        PG8_WAIT_V(6); PG8_BAR;
    } else {
        PG8_STAGE(PG8_SB(0, 0), cB, voffB); PG8_STAGE(PG8_SA(0, 0), cA, voffA); PG8_STAGE(PG8_SB(0, 1), cB + hstep, voffB); PG8_STAGE(PG8_SA(0, 1), cA + hstep, voffA);
        if (wr == 1) PG8_BAR;
        PG8_WAIT_V(4); PG8_BAR;
        PG8_STAGE(PG8_SB(1, 0), cB + kstep, voffB); PG8_STAGE(PG8_SA(1, 0), cA + kstep, voffA); PG8_STAGE(PG8_SB(1, 1), cB + hstep + kstep, voffB);
        PG8_WAIT_V(6); PG8_BAR;
    }
    for (;;) {
        const bool has_next = S.next(ui + 1, nxt);
        const char* nA = has_next ? (const char*)g.A + (size_t)nxt.pm * tstep : cA; const char* nB = has_next ? (const char*)g.Bt + (size_t)nxt.pn * tstep : cB;
        for (int t = 0; t < nt; t += 2) {
            const bool last = (t == nt - 2);
            const char* a1 = cA + (size_t)(t + 1) * kstep;
            const char* a2 = last ? nA : cA + (size_t)(t + 2) * kstep; const char* b2 = last ? nB : cB + (size_t)(t + 2) * kstep;
            const char* a3 = a2 + kstep; const char* b3 = b2 + kstep;
            if (last && has_next) S.a_ready(nxt);
            if constexpr (SP2) {
            PG8_LDB(B0, 0, 0); PG8_LDB(B1, 0, 1); PG8_SCHED; PG8_LDA(At, 0, 0); PG8_STAGE(PG8_SA(1, 1), a1 + hstep, voffA);
            PG8_WAIT_V(8); PG8_WAIT_L(0); PG8_BAR; PG8_MMA(0, 0, At, B0); PG8_MMA(0, 1, At, B1); PG8_BAR; PG8_SCHED;
            PG8_LDA(At, 0, 1); PG8_STAGE(PG8_SB(0, 0), b2, voffB); PG8_STAGE(PG8_SB(0, 1), b2 + hstep, voffB); PG8_STAGE(PG8_SA(0, 0), a2, voffA);
            PG8_WAIT_V(8); PG8_WAIT_L(0); PG8_BAR; PG8_MMA(1, 0, At, B0); PG8_MMA(1, 1, At, B1); PG8_BAR; PG8_SCHED;
            PG8_LDB(B0, 1, 0); PG8_LDB(B1, 1, 1); PG8_SCHED; PG8_LDA(At, 1, 0); PG8_STAGE(PG8_SA(0, 1), a2 + hstep, voffA);
            PG8_WAIT_V(8); PG8_WAIT_L(0); PG8_BAR; PG8_MMA(0, 0, At, B0); PG8_MMA(0, 1, At, B1); PG8_BAR; PG8_SCHED;
            PG8_LDA(At, 1, 1); PG8_STAGE(PG8_SB(1, 0), b3, voffB); PG8_STAGE(PG8_SB(1, 1), b3 + hstep, voffB); PG8_STAGE(PG8_SA(1, 0), a3, voffA);
            PG8_WAIT_V(8); PG8_WAIT_L(0); PG8_BAR; PG8_MMA(1, 0, At, B0); PG8_MMA(1, 1, At, B1); PG8_BAR; PG8_SCHED;
            } else {
            PG8_LDB(B0, 0, 0); PG8_SCHED; PG8_LDA(At, 0, 0); PG8_STAGE(PG8_SA(1, 1), a1 + hstep, voffA);
            PG8_WAIT_L(8); PG8_BAR; PG8_WAIT_L(0); PG8_MMA(0, 0, At, B0); PG8_BAR; PG8_SCHED;
            PG8_LDB(B1, 0, 1); PG8_STAGE(PG8_SB(0, 0), b2, voffB);
            PG8_BAR; PG8_WAIT_L(0); PG8_MMA(0, 1, At, B1); PG8_BAR;
            PG8_LDA(At, 0, 1); PG8_STAGE(PG8_SA(0, 0), a2, voffA);
            PG8_BAR; PG8_WAIT_L(0); PG8_MMA(1, 0, At, B0); PG8_BAR; PG8_SCHED;
            PG8_STAGE(PG8_SB(0, 1), b2 + hstep, voffB);
            PG8_WAIT_V(6); PG8_BAR; PG8_MMA(1, 1, At, B1); PG8_BAR;
            PG8_LDB(B0, 1, 0); PG8_SCHED; PG8_LDA(At, 1, 0); PG8_STAGE(PG8_SA(0, 1), a2 + hstep, voffA);
            PG8_WAIT_L(8); PG8_BAR; PG8_WAIT_L(0); PG8_MMA(0, 0, At, B0); PG8_BAR; PG8_SCHED;
            PG8_LDB(B1, 1, 1); PG8_STAGE(PG8_SB(1, 0), b3, voffB);
            PG8_BAR; PG8_WAIT_L(0); PG8_MMA(0, 1, At, B1); PG8_BAR;
            PG8_LDA(At, 1, 1); PG8_STAGE(PG8_SA(1, 0), a3, voffA);
            PG8_BAR; PG8_WAIT_L(0); PG8_MMA(1, 0, At, B0); PG8_BAR; PG8_SCHED;
            PG8_STAGE(PG8_SB(1, 1), b3 + hstep, voffB);
            PG8_WAIT_V(6); PG8_BAR; PG8_MMA(1, 1, At, B1); PG8_BAR;
            }
        }
        if constexpr (ALIGN_EPI) { if (wr == 0) PG8_BAR; }
        if constexpr (!Epi::AFTER_DRAIN) { E(acc, cur, wr, wc, fr, fq);
#if defined(PROBE_EPI2)
            if constexpr (Epi::DUP_OK) { asm volatile("" ::: "memory"); E(acc, cur, wr, wc, fr, fq); }
#endif
            S.done(cur); }
        if (!has_next) break;
#pragma unroll
        for (int a = 0; a < 2; ++a)
#pragma unroll
            for (int b = 0; b < 2; ++b)
#pragma unroll
                for (int m = 0; m < 4; ++m)
#pragma unroll
                    for (int n = 0; n < 2; ++n) acc[a][b][m][n] = (f32x4){0.f, 0.f, 0.f, 0.f};
        cur = nxt; cA = nA; cB = nB; ++ui;
        if constexpr (ALIGN_EPI) { if (wr == 1) PG8_BAR; }
    }
    PG8_WAIT_V(0);
    if constexpr (!ALIGN_EPI) { if (wr == 0) PG8_BAR; }
    PG8_BAR;
    if constexpr (Epi::AFTER_DRAIN) { E.fused(acc, cur, wr, wc, fr, fq, lds, wid, lane); S.done(cur); }
#undef PG8_SA
#undef PG8_SB
#undef PG8_STAGE
#undef PG8_LDA
#undef PG8_LDB
#undef PG8_MMA
#undef PG8_WAIT_V
#undef PG8_WAIT_L
#undef PG8_BAR
#undef PG8_SCHED
}
}
#define GAS __attribute__((address_space(1)))
#define LAS __attribute__((address_space(3)))
typedef unsigned short bf16;
typedef unsigned v4u __attribute__((ext_vector_type(4)));
typedef float f32x4 __attribute__((ext_vector_type(4)));
typedef short bf16x8 __attribute__((ext_vector_type(8)));
typedef GAS unsigned gu32;
typedef GAS unsigned long long gu64;
#define RLX_AGENT __ATOMIC_RELAXED, __HIP_MEMORY_SCOPE_AGENT
#define LDS_WAIT() asm volatile("s_waitcnt lgkmcnt(0)" ::: "memory")
#define VM_WAIT() asm volatile("s_waitcnt vmcnt(0)" ::: "memory")
__device__ __forceinline__ unsigned long long rt() { return __builtin_amdgcn_s_memrealtime(); }
__device__ __forceinline__ unsigned f2bf(float f) { unsigned u = __builtin_bit_cast(unsigned, f); return (u + 0x7fffu + ((u >> 16) & 1u)) >> 16; }
__device__ __forceinline__ unsigned pk2(float lo, float hi) { return f2bf(lo) | (f2bf(hi) << 16); }

#define XB_TMO      128
#define XB_XCNT(j)  (256  + 64 * (j))
#define XB_XSUB(j)  (1280 + 64 * (j))
#define XB_XGEN(j)  (2304 + 64 * (j))
#define XB_TOP      3328
#define XB_TOPGEN   3392
#define XCD_BAR_WORDS 3456
#define XB_SPIN_CAP (1u << 18)

__device__ __forceinline__ unsigned xb_ld(unsigned* p)              { return __hip_atomic_load(p, __ATOMIC_RELAXED, __HIP_MEMORY_SCOPE_AGENT); }
__device__ __forceinline__ unsigned xb_add(unsigned* p, unsigned v) { return __hip_atomic_fetch_add(p, v, __ATOMIC_RELAXED, __HIP_MEMORY_SCOPE_AGENT); }
__device__ __forceinline__ unsigned xb_xcc_id() { return (unsigned)__builtin_amdgcn_s_getreg((3 << 11) | 20) & 0xFu; }
#define XB_SPIN(cond, bar) do { unsigned _sp = 0; while (cond) { __builtin_amdgcn_s_sleep(1); \
    if ((++_sp & 255u) == 0u) { if (xb_ld(&(bar)[XB_TMO])) break; if (_sp > XB_SPIN_CAP) { atomicAdd(&(bar)[XB_TMO], 1u); break; } } } } while (0)

struct XcdBarrier {
    unsigned* bar; unsigned x;
    volatile LAS unsigned* st;
};

__device__ __forceinline__ XcdBarrier xcd_barrier_post(unsigned* bar, volatile LAS unsigned* st) {
    XcdBarrier b; b.bar = bar; b.x = xb_xcc_id(); b.st = st;
    if (threadIdx.x == 0) (void)xb_add(&bar[XB_XCNT(b.x)], 1u);
    return b;
}
__device__ __forceinline__ void xcd_barrier_complete(unsigned* bar, unsigned x, unsigned& nloc, unsigned& nx) {
    const unsigned G = gridDim.x * gridDim.y * gridDim.z;
    unsigned sum, cnt, mine, sp = 0u;
    for (;;) {
        sum = 0u; cnt = 0u; mine = 0u;
#pragma unroll
        for (unsigned j = 0; j < 16; ++j) { const unsigned c = xb_ld(&bar[XB_XCNT(j)]); sum += c; cnt += (c > 0u) ? 1u : 0u; mine = (j == x) ? c : mine; }
        if (sum == G) break;
        __builtin_amdgcn_s_sleep(1);
        if ((++sp & 255u) == 0u) { if (xb_ld(&bar[XB_TMO])) break; if (sp > XB_SPIN_CAP) { atomicAdd(&bar[XB_TMO], 1u); break; } }
    }
    nloc = mine > 0u ? mine : 1u; nx = cnt > 0u ? cnt : 1u;
}

__device__ __forceinline__ void xcd_barrier(const XcdBarrier& b) {
    asm volatile("s_waitcnt vmcnt(0)" ::: "memory");
    __syncthreads();
    if (threadIdx.x == 0) {
        unsigned* bar = b.bar;
        __builtin_amdgcn_s_waitcnt(0);
        unsigned nloc = b.st[0], nx = b.st[1];
        if (nloc == 0u) { xcd_barrier_complete(bar, b.x, nloc, nx); b.st[0] = nloc; b.st[1] = nx; }
        const unsigned old = xb_add(&bar[XB_XSUB(b.x)], 1u);
        const unsigned gen = old / nloc;
        if (old + 1u == (gen + 1u) * nloc) {
            __builtin_amdgcn_fence(__ATOMIC_RELEASE, "agent");
            asm volatile("s_waitcnt vmcnt(0)" ::: "memory");
            const unsigned og = xb_add(&bar[XB_TOP], 1u);
            const unsigned tg = og / nx;
            if (og + 1u == (tg + 1u) * nx) xb_add(&bar[XB_TOPGEN], 1u);
            else XB_SPIN(xb_ld(&bar[XB_TOPGEN]) == tg, bar);
            __builtin_amdgcn_fence(__ATOMIC_ACQUIRE, "agent");
            xb_add(&bar[XB_XGEN(b.x)], 1u);
            asm volatile("s_waitcnt vmcnt(0)" ::: "memory");
        } else {
            XB_SPIN(xb_ld(&bar[XB_XGEN(b.x)]) == gen, bar);
            __builtin_amdgcn_fence(__ATOMIC_ACQUIRE, "agent");
            asm volatile("s_waitcnt vmcnt(0)" ::: "memory");
        }
    }
    __syncthreads();
}
typedef float f32x2_pair __attribute__((ext_vector_type(2)));

constexpr int NWAVES = 8;
constexpr int DM = 1024, FF = 4096, NIN = 9216;
constexpr int MP = 65536, MS = 1024, M = MP + MS;
constexpr int PAST = 4096;
constexpr size_t MiB = 1u << 20;
constexpr size_t REG_E = (size_t)M * DM;
constexpr size_t WS_CTL = 0, CTL_ZERO_BYTES = 1 * MiB;
constexpr size_t WS_WIN = 2 * MiB, WS_WOUT = 20 * MiB, WS_WUP = 22 * MiB, WS_WDN = 30 * MiB;
constexpr size_t WS_ROPE = 38 * MiB;
constexpr size_t WS_SSQ = 43 * MiB;
constexpr size_t WS_RSS = 48 * MiB;
constexpr size_t WS_XN = 54 * MiB;
constexpr size_t WS_R = 184 * MiB;
constexpr size_t WS_END = WS_R + 9 * REG_E * 2;
static_assert(WS_ROPE + (size_t)4128 * 128 * 8 <= WS_SSQ && WS_SSQ + (size_t)M * 64 <= WS_RSS && WS_RSS + (size_t)M * 64 <= WS_XN && WS_XN + REG_E * 2 <= WS_R, "ws map");
constexpr size_t O_Y = 0, O_KP = 68157440, O_VP = 135266304, O_SP = 202375168, O_KS = 206569472, O_VS = 207618048, O_SS = 208666624, O_END = 217055232;
constexpr int CW_BAR = 4096;
constexpr int RING_BYTES = 131072, XCH_OFF = RING_BYTES + 512, MISC_OFF = 163840 - 256, LDS_BYTES = 163840;
static_assert(XCH_OFF + 8192 <= MISC_OFF && MISC_OFF + 64 <= LDS_BYTES, "LDS map");

typedef short s16x4 __attribute__((ext_vector_type(4)));
typedef unsigned v2u __attribute__((ext_vector_type(2)));
#define DI __device__ __forceinline__
#define MFMA16(a, b, c) __builtin_amdgcn_mfma_f32_16x16x32_bf16((a), (b), (c), 0, 0, 0)
#define LBAR() do { asm volatile("s_waitcnt lgkmcnt(0)" ::: "memory"); __builtin_amdgcn_s_barrier(); asm volatile("" ::: "memory"); } while (0)
typedef short v4i16_t __attribute__((ext_vector_type(4)));
DI s16x4 trd(const LAS unsigned char* p) { return __builtin_bit_cast(s16x4, __builtin_amdgcn_ds_read_tr16_b64_v4i16((LAS v4i16_t*)p)); }
DI bf16x8 cat8(s16x4 lo, s16x4 hi) { return (bf16x8){lo[0], lo[1], lo[2], lo[3], hi[0], hi[1], hi[2], hi[3]}; }
DI float bflo(unsigned u) { return __uint_as_float(u << 16); }
DI float bfhi(unsigned u) { return __uint_as_float(u & 0xffff0000u); }
using pg8::cvtpk;
DI float wave_sum(float v) {
#pragma unroll
    for (int o = 1; o < 64; o <<= 1) v += __shfl_xor(v, o);
    return v;
}
constexpr float LOG2E = 1.4426950408889634f, LN2 = 0.6931471805599453f;

struct Args {
    const float *xp, *xs, *ck, *cv, *st, *nmix, *win, *rnw, *qnw, *knw, *wout, *nmlp, *wup, *wdn;
    float* out; unsigned char* ws;
};

DI int colpos(int n) { return (n & ~255) | (((n >> 5) & 1) << 7) | (((n >> 6) & 3) << 5) | (n & 31); }
DI void p0_transpose_item(const float* W, int K, int N, bf16* WT, const float* ksc, int pfrom, LAS float* scr, int item, int lane) {
    const int nblk = N / 32, kb = item / nblk, nb = item % nblk, k0 = 64 * kb, n0 = 32 * nb;
#pragma unroll 8
    for (int i = 0; i < 32; ++i) { const int kk = 2 * i + (lane >> 5); float v = W[(size_t)(k0 + kk) * N + n0 + (lane & 31)]; if (ksc) v *= ksc[k0 + kk]; scr[kk * 33 + (lane & 31)] = v; }
    LDS_WAIT(); asm volatile("" ::: "memory");
    const int c = lane & 7;
#pragma unroll
    for (int j = 0; j < 4; ++j) { const int n = (lane >> 3) + 8 * j; const LAS float* s = scr + (8 * c) * 33 + n;
        v4u o; o.x = cvtpk(s[0 * 33], s[1 * 33]); o.y = cvtpk(s[2 * 33], s[3 * 33]); o.z = cvtpk(s[4 * 33], s[5 * 33]); o.w = cvtpk(s[6 * 33], s[7 * 33]);
        const int nn = n0 + n, np = (nn >= pfrom) ? colpos(nn) : nn;
        *(GAS v4u*)(WT + (size_t)np * K + k0 + 8 * c) = o; }
    LDS_WAIT(); asm volatile("" ::: "memory");
}
DI void p0_prologue(const Args& a, LAS unsigned char* lds, int vcu, int G, int wave, int lane) {
    unsigned char* ws = a.ws;
    LAS float* scr = (LAS float*)(lds + wave * 16384);
    const int gw = vcu * NWAVES + wave, NGW = G * NWAVES;
    constexpr int I_IN = (DM / 64) * (NIN / 32), I_O = (DM / 64) * (DM / 32), I_U = (DM / 64) * (FF / 32), I_D = (FF / 64) * (DM / 32);
    constexpr int NITEMS = I_IN + I_O + I_U + I_D;
    for (int it = gw; it < NITEMS; it += NGW) {
        int r = it;
        if (r < I_IN) { p0_transpose_item(a.win, DM, NIN, (bf16*)(ws + WS_WIN), nullptr, 2048, scr, r, lane); continue; } r -= I_IN;
        if (r < I_O) { p0_transpose_item(a.wout, DM, DM, (bf16*)(ws + WS_WOUT), nullptr, 0, scr, r, lane); continue; } r -= I_O;
        if (r < I_U) { p0_transpose_item(a.wup, DM, FF, (bf16*)(ws + WS_WUP), a.nmlp, 0, scr, r, lane); continue; } r -= I_U;
        p0_transpose_item(a.wdn, FF, DM, (bf16*)(ws + WS_WDN), nullptr, 0, scr, r, lane);
    }
    {
        f32x4 wv[4];
#pragma unroll
        for (int j = 0; j < 4; ++j) wv[j] = ((const GAS f32x4*)a.nmix)[lane + 64 * j];
        bf16* XN = (bf16*)(ws + WS_XN);
        for (int m = gw; m < M; m += NGW) {
            const float* xrow = (m < MP) ? a.xp + (size_t)m * DM : a.xs + (size_t)(m - MP) * DM;
            const GAS f32x4* xr = (const GAS f32x4*)xrow + lane;
            f32x4 v[4]; float s = 0.f;
#pragma unroll
            for (int j = 0; j < 4; ++j) { v[j] = xr[64 * j]; s += (v[j].x * v[j].x + v[j].y * v[j].y) + (v[j].z * v[j].z + v[j].w * v[j].w); }
            const float rstd = 1.0f / sqrtf(wave_sum(s) * (1.0f / DM) + 1e-6f);
            GAS v2u* o8 = (GAS v2u*)(XN + (size_t)m * DM) + lane;
#pragma unroll
            for (int j = 0; j < 4; ++j) { const f32x4 y = v[j] * rstd * wv[j]; v2u o; o.x = cvtpk(y.x, y.y); o.y = cvtpk(y.z, y.w); o8[64 * j] = o; }
        }
    }
    {
        float* rope = (float*)(ws + WS_ROPE);
        for (int idx = gw * 64 + lane; idx < 4128 * 128; idx += NGW * 64) {
            const int pos = idx >> 7, j = idx & 127;
            const float inv = powf(10000.0f, -(float)j * (1.0f / 128.0f));
            const float ang = (float)pos * inv;
            float sn, cs; sincosf(ang, &sn, &cs);
            *(GAS f32x2_pair*)(rope + (size_t)idx * 2) = (f32x2_pair){cs, sn};
        }
    }
}

constexpr int RT_QS = 0, RT_KS = 33792, RT_VS = 67584, RT_VDS = 76800, RT_PS = 86016, RT_STS = 95232, RT_RXS = 129024;
static_assert(RT_RXS + 1024 <= RING_BYTES, "retention LDS map");
template <bool SAMPLE>
DI void ret_unit(const Args& a, LAS unsigned char* L, int b, int h, int s, int tid, int lane, int w) {
    const int c15 = lane & 15, g = lane >> 4, q4 = c15 >> 2, p4 = c15 & 3;
    constexpr int Lc = SAMPLE ? 32 : 64, NSTEP = SAMPLE ? 1 : 64;
    const float lg2 = log2f(1.0f - exp2f(-5.0f - (float)h));
    const size_t rowbase = SAMPLE ? (size_t)MP + 32 * b : (size_t)4096 * b;
    const bf16* RQ = (const bf16*)(a.ws + WS_R), *RK = RQ + REG_E, *RV = RQ + 2 * REG_E;
    bf16* ORET = (bf16*)(a.ws + WS_XN);
    float* RSS = (float*)(a.ws + WS_RSS);
    f32x4 S[2][4];
    const size_t sbase = ((size_t)(b * 4 + h) * 256) * 256 + 64 * s;
    {
        const float* sp0 = a.st + sbase + (size_t)(128 * (w & 1) + 32 * (w >> 1) + 4 * g) * 256 + c15;
#pragma unroll
        for (int k2 = 0; k2 < 2; ++k2)
#pragma unroll
            for (int dt = 0; dt < 4; ++dt)
#pragma unroll
                for (int r = 0; r < 4; ++r) S[k2][dt][r] = SAMPLE ? sp0[(16 * k2 + r) * 256 + 16 * dt] : 0.f;
    }
    v4u pq[4], pk[4], pv;
    const int vrow = tid >> 3, vpc = tid & 7;
#define RT_LOAD(c) do { \
        _Pragma("unroll") for (int p_ = 0; p_ < 4; ++p_) { const int idx_ = tid + 512 * p_, row_ = idx_ >> 5, pc_ = idx_ & 31; \
            if (!SAMPLE || row_ < 32) { const size_t go_ = (rowbase + (size_t)64 * (c) + row_) * 1024 + 256 * h + 8 * pc_; pq[p_] = *(const GAS v4u*)(RQ + go_); pk[p_] = *(const GAS v4u*)(RK + go_); } \
            else { pq[p_] = (v4u){0u, 0u, 0u, 0u}; pk[p_] = (v4u){0u, 0u, 0u, 0u}; } } \
        if (!SAMPLE || vrow < 32) pv = *(const GAS v4u*)(RV + (rowbase + (size_t)64 * (c) + vrow) * 1024 + 256 * h + 64 * s + 8 * vpc); else pv = (v4u){0u, 0u, 0u, 0u}; } while (0)
#define RT_WRITE() do { \
        _Pragma("unroll") for (int p_ = 0; p_ < 4; ++p_) { const int idx_ = tid + 512 * p_, row_ = idx_ >> 5, pc_ = idx_ & 31; \
            *(LAS v4u*)(L + RT_QS + row_ * 528 + pc_ * 16) = pq[p_]; *(LAS v4u*)(L + RT_KS + row_ * 528 + pc_ * 16) = pk[p_]; } \
        *(LAS v4u*)(L + RT_VS + vrow * 144 + vpc * 16) = pv; \
        { const float kd_ = exp2f(lg2 * (float)(Lc - 1 - vrow)); v4u d_; \
          d_.x = cvtpk(bflo(pv.x) * kd_, bfhi(pv.x) * kd_); d_.y = cvtpk(bflo(pv.y) * kd_, bfhi(pv.y) * kd_); d_.z = cvtpk(bflo(pv.z) * kd_, bfhi(pv.z) * kd_); d_.w = cvtpk(bflo(pv.w) * kd_, bfhi(pv.w) * kd_); \
          *(LAS v4u*)(L + RT_VDS + vrow * 144 + vpc * 16) = d_; } } while (0)
    RT_LOAD(0); RT_WRITE();
    const int jt = w >> 1, itp = w & 1, dto = w >> 1;
    const float gL = exp2f(lg2 * (float)Lc);
    for (int c = 0; c < NSTEP; ++c) {
        LBAR();
        if (c + 1 < NSTEP) RT_LOAD(c + 1);
        bf16x8 bq[2][8];
        {
            f32x4 sc[2] = {(f32x4){0.f, 0.f, 0.f, 0.f}, (f32x4){0.f, 0.f, 0.f, 0.f}};
            const LAS unsigned char* kp = L + RT_KS + (16 * jt + c15) * 528 + g * 16;
            const LAS unsigned char* qp = L + RT_QS + (32 * itp + c15) * 528 + g * 16;
#pragma unroll
            for (int ks = 0; ks < 8; ++ks) {
                const bf16x8 ak = *(const LAS bf16x8*)(kp + ks * 64);
                bq[0][ks] = *(const LAS bf16x8*)(qp + ks * 64); bq[1][ks] = *(const LAS bf16x8*)(qp + 16 * 528 + ks * 64);
                sc[0] = MFMA16(ak, bq[0][ks], sc[0]); sc[1] = MFMA16(ak, bq[1][ks], sc[1]);
            }
#pragma unroll
            for (int t = 0; t < 2; ++t) {
                const int i = 32 * itp + 16 * t + c15, j0 = 16 * jt + 4 * g;
                float p[4];
#pragma unroll
                for (int r = 0; r < 4; ++r) { const int d = i - (j0 + r); p[r] = sc[t][r] * exp2f(lg2 * (float)(d < 0 ? -d : d)); }
                v2u o; o.x = cvtpk(p[0], p[1]); o.y = cvtpk(p[2], p[3]);
                *(LAS v2u*)(L + RT_PS + i * 144 + j0 * 2) = o;
            }
        }
#pragma unroll
        for (int k2 = 0; k2 < 2; ++k2)
#pragma unroll
            for (int dt = 0; dt < 4; ++dt) { v2u o; o.x = cvtpk(S[k2][dt][0], S[k2][dt][1]); o.y = cvtpk(S[k2][dt][2], S[k2][dt][3]);
                *(LAS v2u*)(L + RT_STS + (16 * dt + c15) * 528 + (16 * (2 * w + k2) + 4 * g) * 2) = o; }
        LBAR();
        {
            f32x4 oc[2] = {(f32x4){0.f, 0.f, 0.f, 0.f}, (f32x4){0.f, 0.f, 0.f, 0.f}};
            const LAS unsigned char* sp = L + RT_STS + (16 * dto + c15) * 528 + g * 16;
#pragma unroll
            for (int ks = 0; ks < 8; ++ks) { const bf16x8 as = *(const LAS bf16x8*)(sp + ks * 64); oc[0] = MFMA16(as, bq[0][ks], oc[0]); oc[1] = MFMA16(as, bq[1][ks], oc[1]); }
#pragma unroll
            for (int t = 0; t < 2; ++t) { const int i = 32 * itp + 16 * t + c15; oc[t] = oc[t] * exp2f(lg2 * (float)(i + 1)); }
#pragma unroll
            for (int k2 = 0; k2 < 2; ++k2) {
                const LAS unsigned char* vp = L + RT_VS + (32 * k2 + 8 * g + q4) * 144 + (16 * dto + 4 * p4) * 2;
                const bf16x8 av = cat8(trd(vp), trd(vp + 4 * 144));
#pragma unroll
                for (int t = 0; t < 2; ++t) { const int i = 32 * itp + 16 * t + c15;
                    const bf16x8 bp = *(const LAS bf16x8*)(L + RT_PS + i * 144 + (32 * k2 + 8 * g) * 2); oc[t] = MFMA16(av, bp, oc[t]); }
            }
#pragma unroll
            for (int t = 0; t < 2; ++t) {
                const int i = 32 * itp + 16 * t + c15;
                float ss = (oc[t][0] * oc[t][0] + oc[t][1] * oc[t][1]) + (oc[t][2] * oc[t][2] + oc[t][3] * oc[t][3]);
                ss += __shfl_xor(ss, 16); ss += __shfl_xor(ss, 32);
                if (g == 0) ((LAS float*)(L + RT_RXS))[dto * 64 + i] = ss;
                if (!SAMPLE || i < 32) { v2u o; o.x = cvtpk(oc[t][0], oc[t][1]); o.y = cvtpk(oc[t][2], oc[t][3]);
                    *(GAS v2u*)(ORET + (rowbase + (size_t)64 * c + i) * 1024 + 256 * h + 64 * s + 16 * dto + 4 * g) = o; }
            }
        }
#pragma unroll
        for (int k2 = 0; k2 < 2; ++k2)
#pragma unroll
            for (int dt = 0; dt < 4; ++dt) S[k2][dt] = S[k2][dt] * gL;
#pragma unroll
        for (int ks = 0; ks < 2; ++ks) {
            const int tok = 32 * ks + 8 * g + q4;
            bf16x8 ak[2];
#pragma unroll
            for (int k2 = 0; k2 < 2; ++k2) { const LAS unsigned char* kp = L + RT_KS + tok * 528 + (16 * (2 * w + k2) + 4 * p4) * 2; ak[k2] = cat8(trd(kp), trd(kp + 4 * 528)); }
#pragma unroll
            for (int dt = 0; dt < 4; ++dt) { const LAS unsigned char* vp = L + RT_VDS + tok * 144 + (16 * dt + 4 * p4) * 2; const bf16x8 bv = cat8(trd(vp), trd(vp + 4 * 144));
                S[0][dt] = MFMA16(ak[0], bv, S[0][dt]); S[1][dt] = MFMA16(ak[1], bv, S[1][dt]); }
        }
        LBAR();
        if (tid < 64 && (!SAMPLE || tid < 32)) { const LAS float* rx = (const LAS float*)(L + RT_RXS);
            RSS[(rowbase + (size_t)64 * c + tid) * 16 + h * 4 + s] = (rx[tid] + rx[64 + tid]) + (rx[128 + tid] + rx[192 + tid]); }
        if (c + 1 < NSTEP) RT_WRITE();
    }
    {
        int ln = lane; asm volatile("" : "+v"(ln));
        float* so = a.out + (SAMPLE ? O_SS : O_SP) + sbase + (size_t)(128 * (w & 1) + 32 * (w >> 1) + 4 * (ln >> 4)) * 256 + (ln & 15);
#pragma unroll
        for (int k2 = 0; k2 < 2; ++k2)
#pragma unroll
            for (int dt = 0; dt < 4; ++dt)
#pragma unroll
                for (int r = 0; r < 4; ++r) so[(16 * k2 + r) * 256 + 16 * dt] = S[k2][dt][r];
    }
    LBAR();
#undef RT_LOAD
#undef RT_WRITE
}

constexpr int SB_KS = 0, SB_KT = 17408, SB_VS = 52224, SB_VT = 18432, SB_FLAGS = 107520, SB_OS = 0, SB_OSW = 8448;
static_assert(SB_KS + 3 * SB_KT <= SB_VS && SB_VS + 3 * SB_VT <= SB_FLAGS && SB_OS + 8 * SB_OSW <= SB_FLAGS && SB_FLAGS + 64 <= RING_BYTES, "SB LDS map");
constexpr float SB_EXIT = 40.0f * 1.4426950408889634f;
template <bool MASKED>
DI void sb_tile(const LAS unsigned char* kb, const LAS unsigned char* vb, const bf16x8 (&bq)[4], const bf16x8 acs, const bf16x8 ones, int key0, int qpos, float& carry, f32x4 (&oacc)[8]) {
    f32x4 z[4];
#pragma unroll
    for (int j = 0; j < 4; ++j) z[j] = (f32x4){0.f, 0.f, 0.f, 0.f};
    {
        bf16x8 ak[2][4];
#pragma unroll
        for (int j = 0; j < 4; ++j) ak[0][j] = *(const LAS bf16x8*)(kb + j * 16 * 272);
#pragma unroll
        for (int ks = 0; ks < 4; ++ks) {
            if (ks < 3) {
#pragma unroll
                for (int j = 0; j < 4; ++j) ak[(ks + 1) & 1][j] = *(const LAS bf16x8*)(kb + j * 16 * 272 + (ks + 1) * 64);
            }
            __builtin_amdgcn_sched_barrier(0);
#pragma unroll
            for (int j = 0; j < 4; ++j) z[j] = MFMA16(ak[ks & 1][j], bq[ks], z[j]);
            __builtin_amdgcn_sched_barrier(0);
        }
    }
    float s[4][4], t[4];
#pragma unroll
    for (int j = 0; j < 4; ++j) {
        float v[4];
#pragma unroll
        for (int r = 0; r < 4; ++r) { const float zz = fminf(z[j][r], 100.0f); z[j][r] = zz; float vv = __builtin_amdgcn_logf(1.0f + __builtin_amdgcn_exp2f(zz));
            if (MASKED) vv = (key0 + 16 * j + r < qpos) ? vv : 0.f;
            v[r] = vv; }
        s[j][3] = v[3]; s[j][2] = v[3] + v[2]; s[j][1] = s[j][2] + v[1]; s[j][0] = s[j][1] + v[0]; t[j] = s[j][0];
    }
    const unsigned h01 = cvtpk(t[0], t[1]), h23 = cvtpk(t[2], t[3]);
    const unsigned l01 = cvtpk(t[0] - bflo(h01), t[1] - bfhi(h01)), l23 = cvtpk(t[2] - bflo(h23), t[3] - bfhi(h23));
    const bf16x8 bt = __builtin_bit_cast(bf16x8, (v4u){h01, h23, l01, l23});
    const f32x4 zero4 = (f32x4){0.f, 0.f, 0.f, 0.f};
    const f32x4 E = MFMA16(acs, bt, zero4), TOT = MFMA16(ones, bt, zero4);
    unsigned wp[4][2];
#pragma unroll
    for (int j = 0; j < 4; ++j) { const float ec = E[j] + carry; float wv[4];
#pragma unroll
        for (int r = 0; r < 4; ++r) { float ex = __builtin_amdgcn_exp2f((z[j][r] - s[j][r]) - ec); if (MASKED) ex = (key0 + 16 * j + r < qpos) ? ex : 0.f; wv[r] = ex; }
        wp[j][0] = cvtpk(wv[0], wv[1]); wp[j][1] = cvtpk(wv[2], wv[3]); }
    carry += TOT[0];
#pragma unroll
    for (int k2 = 0; k2 < 2; ++k2) { const bf16x8 bw = __builtin_bit_cast(bf16x8, (v4u){wp[2 * k2][0], wp[2 * k2][1], wp[2 * k2 + 1][0], wp[2 * k2 + 1][1]});
#pragma unroll
        for (int dt = 0; dt < 8; ++dt) { const bf16x8 av = cat8(trd(vb + (32 * k2) * 288 + dt * 32), trd(vb + (32 * k2 + 16) * 288 + dt * 32)); oacc[dt] = MFMA16(av, bw, oacc[dt]); } }
}
template <bool SAMPLE>
DI void sb_unit(const Args& a, LAS unsigned char* L, int b, int h, int qb, int tid, int lane, int w) {
    const int c15 = lane & 15, g = lane >> 4, q4 = c15 >> 2, p4 = c15 & 3;
    const bf16* R0 = (const bf16*)(a.ws + WS_R);
    const bf16 *RG = R0 + 3 * REG_E, *SQ = R0 + 4 * REG_E, *SK = R0 + 5 * REG_E, *SV = R0 + 6 * REG_E, *GA = R0 + 7 * REG_E, *GB = R0 + 8 * REG_E;
    const bf16* ORET = (const bf16*)(a.ws + WS_XN);
    bf16* MIX = (bf16*)(a.ws + WS_R);
    const float* RSS = (const float*)(a.ws + WS_RSS);
    const bool wvalid = SAMPLE ? (w < 2) : true;
    const int qwbase = SAMPLE ? PAST + 16 * w : 128 * qb + 16 * w;
    const int qpos = qwbase + c15;
    const size_t wrow0 = SAMPLE ? (size_t)MP + 32 * b + 16 * w : (size_t)4096 * b + qwbase;
    bf16x8 bq[4];
#pragma unroll
    for (int ks = 0; ks < 4; ++ks) bq[ks] = wvalid ? *(const GAS bf16x8*)(SQ + (wrow0 + c15) * 1024 + 128 * h + 32 * ks + 8 * g) : (bf16x8){0, 0, 0, 0, 0, 0, 0, 0};
    bf16x8 ones, acs;
#pragma unroll
    for (int e = 0; e < 8; ++e) { ones[e] = (short)0x3f80; acs[e] = (4 * (e & 3) + g > 4 * (c15 & 3) + (c15 >> 2)) ? (short)0x3f80 : (short)0; }
    const int T0 = SAMPLE ? 64 : 2 * qb + 1;
    float carry = 0.f;
    f32x4 oacc[8];
#pragma unroll
    for (int dt = 0; dt < 8; ++dt) oacc[dt] = (f32x4){0.f, 0.f, 0.f, 0.f};
    const int kl0 = tid >> 4, dp = tid & 15;
    v4u tk[2][2], tv[2][2]; f32x4 fk[2][2][2], fv[2][2][2];
#define SB_LOAD(S_, T_) do { _Pragma("unroll") for (int p_ = 0; p_ < 2; ++p_) { const int kl_ = kl0 + 32 * p_; \
        if (!SAMPLE) { const size_t go_ = ((size_t)4096 * b + 64 * (T_) + kl_) * 1024 + 128 * h + 8 * dp; tk[S_][p_] = *(const GAS v4u*)(SK + go_); tv[S_][p_] = *(const GAS v4u*)(SV + go_); } \
        else { const size_t go_ = (((size_t)b * 4096 + 64 * (T_) + kl_) * 8 + h) * 128 + 8 * dp; \
            fk[S_][p_][0] = *(const GAS f32x4*)(a.ck + go_); fk[S_][p_][1] = *(const GAS f32x4*)(a.ck + go_ + 4); fv[S_][p_][0] = *(const GAS f32x4*)(a.cv + go_); fv[S_][p_][1] = *(const GAS f32x4*)(a.cv + go_ + 4); } } } while (0)
#define SB_PARK(S_, B_) do { _Pragma("unroll") for (int p_ = 0; p_ < 2; ++p_) { const int kl_ = kl0 + 32 * p_; \
        if (SAMPLE) { tk[S_][p_] = (v4u){cvtpk(fk[S_][p_][0][0], fk[S_][p_][0][1]), cvtpk(fk[S_][p_][0][2], fk[S_][p_][0][3]), cvtpk(fk[S_][p_][1][0], fk[S_][p_][1][1]), cvtpk(fk[S_][p_][1][2], fk[S_][p_][1][3])}; \
            tv[S_][p_] = (v4u){cvtpk(fv[S_][p_][0][0], fv[S_][p_][0][1]), cvtpk(fv[S_][p_][0][2], fv[S_][p_][0][3]), cvtpk(fv[S_][p_][1][0], fv[S_][p_][1][1]), cvtpk(fv[S_][p_][1][2], fv[S_][p_][1][3])}; } \
        *(LAS v4u*)(L + SB_KS + (B_) * SB_KT + kl_ * 272 + dp * 16) = tk[S_][p_]; *(LAS v4u*)(L + SB_VS + (B_) * SB_VT + kl_ * 288 + dp * 16) = tv[S_][p_]; } } while (0)
    {
#pragma unroll
        for (int p = 0; p < 2; ++p) { const int kl = kl0 + 32 * p; v4u k0, v0;
            if (!SAMPLE) { const size_t go = ((size_t)4096 * b + 64 * T0 + kl) * 1024 + 128 * h + 8 * dp; k0 = *(const GAS v4u*)(SK + go); v0 = *(const GAS v4u*)(SV + go); }
            else if (kl < 32) { const size_t go = ((size_t)MP + 32 * b + kl) * 1024 + 128 * h + 8 * dp; k0 = *(const GAS v4u*)(SK + go); v0 = *(const GAS v4u*)(SV + go); }
            else { k0 = (v4u){0u, 0u, 0u, 0u}; v0 = (v4u){0u, 0u, 0u, 0u}; }
            *(LAS v4u*)(L + SB_KS + kl * 272 + dp * 16) = k0; *(LAS v4u*)(L + SB_VS + kl * 288 + dp * 16) = v0; }
    }
    if (T0 >= 1) SB_LOAD(0, T0 - 1);
    if (T0 >= 2) SB_LOAD(1, T0 - 2);
    int buf = 0;
    for (int it = 0;; ++it) {
        const int T = T0 - it; const int nb = (buf == 2) ? 0 : buf + 1;
        LBAR();
        if (it > 0) { const LAS unsigned* fl = (const LAS unsigned*)(L + SB_FLAGS) + 8 * ((it - 1) & 1);
            const unsigned any = (fl[0] | fl[1]) | (fl[2] | fl[3]) | (fl[4] | fl[5]) | (fl[6] | fl[7]);
            if (__builtin_amdgcn_readfirstlane(any) == 0u) break; }
        if (T > 0) {
            if (it & 1) { SB_PARK(1, nb); if (T >= 3) SB_LOAD(1, T - 3); }
            else        { SB_PARK(0, nb); if (T >= 3) SB_LOAD(0, T - 3); }
        }
        const bool alive = wvalid && (__ballot(carry < SB_EXIT) != 0ull);
        if (alive && 64 * T < qwbase + 16) {
            const LAS unsigned char* kb = L + SB_KS + buf * SB_KT + c15 * 272 + g * 16;
            const LAS unsigned char* vb = L + SB_VS + buf * SB_VT + (4 * g + q4) * 288 + 8 * p4;
            if (64 * T + 63 < qwbase) sb_tile<false>(kb, vb, bq, acs, ones, 64 * T + 4 * g, qpos, carry, oacc);
            else sb_tile<true>(kb, vb, bq, acs, ones, 64 * T + 4 * g, qpos, carry, oacc);
        }
        { const bool more = wvalid && (carry < SB_EXIT); const unsigned long long bal = __ballot(more);
          if (lane == 0) ((LAS unsigned*)(L + SB_FLAGS))[8 * (it & 1) + w] = (bal != 0ull) ? 1u : 0u; }
        if (T == 0) break;
        buf = nb;
    }
#undef SB_LOAD
#undef SB_PARK
    LBAR();
    if (wvalid) {
        LAS unsigned char* os = L + SB_OS + w * SB_OSW;
#pragma unroll
        for (int dt = 0; dt < 8; ++dt) *(LAS f32x4*)(os + c15 * 528 + (16 * dt + 4 * g) * 4) = oacc[dt];
        const int hr = h >> 1, ch = lane & 15, col = 128 * h + 8 * ch;
        const f32x4 rw0 = *(const f32x4*)(a.rnw + 256 * hr + (col & 255)), rw1 = *(const f32x4*)(a.rnw + 256 * hr + (col & 255) + 4);
        v4u orr[4], rg[4], ga[4], gb[4]; f32x4 rs[4];
#pragma unroll
        for (int k = 0; k < 4; ++k) { const size_t row = wrow0 + 4 * k + (lane >> 4), go = row * 1024 + col;
            orr[k] = *(const GAS v4u*)(ORET + go); rg[k] = *(const GAS v4u*)(RG + go); ga[k] = *(const GAS v4u*)(GA + go); gb[k] = *(const GAS v4u*)(GB + go);
            rs[k] = *(const GAS f32x4*)(RSS + row * 16 + hr * 4); }
        asm volatile("s_waitcnt lgkmcnt(0)" ::: "memory");
#pragma unroll
        for (int k = 0; k < 4; ++k) {
            const int r = 4 * k + (lane >> 4);
            const f32x4 o0 = *(const LAS f32x4*)(os + r * 528 + ch * 32), o1 = *(const LAS f32x4*)(os + r * 528 + ch * 32 + 16);
            const float rstd = 1.0f / sqrtf(((rs[k][0] + rs[k][1]) + (rs[k][2] + rs[k][3])) * (1.0f / 256.0f) + 1e-6f);
            v4u mo;
            mo.x = cvtpk(bflo(ga[k].x) * (bflo(orr[k].x) * rstd * rw0[0] * bflo(rg[k].x)) + bflo(gb[k].x) * o0[0], bfhi(ga[k].x) * (bfhi(orr[k].x) * rstd * rw0[1] * bfhi(rg[k].x)) + bfhi(gb[k].x) * o0[1]);
            mo.y = cvtpk(bflo(ga[k].y) * (bflo(orr[k].y) * rstd * rw0[2] * bflo(rg[k].y)) + bflo(gb[k].y) * o0[2], bfhi(ga[k].y) * (bfhi(orr[k].y) * rstd * rw0[3] * bfhi(rg[k].y)) + bfhi(gb[k].y) * o0[3]);
            mo.z = cvtpk(bflo(ga[k].z) * (bflo(orr[k].z) * rstd * rw1[0] * bflo(rg[k].z)) + bflo(gb[k].z) * o1[0], bfhi(ga[k].z) * (bfhi(orr[k].z) * rstd * rw1[1] * bfhi(rg[k].z)) + bfhi(gb[k].z) * o1[1]);
            mo.w = cvtpk(bflo(ga[k].w) * (bflo(orr[k].w) * rstd * rw1[2] * bflo(rg[k].w)) + bflo(gb[k].w) * o1[2], bfhi(ga[k].w) * (bfhi(orr[k].w) * rstd * rw1[3] * bfhi(rg[k].w)) + bfhi(gb[k].w) * o1[3]);
            *(GAS v4u*)(MIX + (wrow0 + r) * 1024 + col) = mo;
        }
    }
    LBAR();
}

constexpr int SW_SLOT = 35840, SW_KOFF = 0, SW_VOFF = 17408, SW_FLAGS = 4 * SW_SLOT;
static_assert(SW_FLAGS + 64 <= MISC_OFF && 2 * SW_SLOT >= 8 * SB_OSW, "SB stream LDS map");
DI void sw_fill(LAS unsigned char* L, const bf16* SK, const bf16* SV, size_t rowb, int h, int T, int tid) {
    const int kl0 = tid >> 4, dp = tid & 15; LAS unsigned char* sl = L + (T & 3) * SW_SLOT;
#pragma unroll
    for (int p = 0; p < 2; ++p) { const int kl = kl0 + 32 * p; const size_t go = (rowb + 64 * T + kl) * 1024 + 128 * h + 8 * dp;
        const v4u k0 = *(const GAS v4u*)(SK + go), v0 = *(const GAS v4u*)(SV + go);
        *(LAS v4u*)(sl + SW_KOFF + kl * 272 + dp * 16) = k0; *(LAS v4u*)(sl + SW_VOFF + kl * 288 + dp * 16) = v0; }
}
DI void sb_stream(const Args& a, LAS unsigned char* L, int b, int h, int qb0, int tid, int lane, int w) {
    const int c15 = lane & 15, g = lane >> 4, q4 = c15 >> 2, p4 = c15 & 3;
    const bf16* R0 = (const bf16*)(a.ws + WS_R);
    const bf16 *RG = R0 + 3 * REG_E, *SQ = R0 + 4 * REG_E, *SK = R0 + 5 * REG_E, *SV = R0 + 6 * REG_E, *GA = R0 + 7 * REG_E, *GB = R0 + 8 * REG_E;
    const bf16* ORET = (const bf16*)(a.ws + WS_XN);
    bf16* MIX = (bf16*)(a.ws + WS_R);
    const float* RSS = (const float*)(a.ws + WS_RSS);
    const size_t rowb = (size_t)4096 * b;
    bf16x8 ones, acs;
#pragma unroll
    for (int e = 0; e < 8; ++e) { ones[e] = (short)0x3f80; acs[e] = (4 * (e & 3) + g > 4 * (c15 & 3) + (c15 >> 2)) ? (short)0x3f80 : (short)0; }
    const int kl0 = tid >> 4, dp = tid & 15;
    LAS unsigned* flags = (LAS unsigned*)(L + SW_FLAGS);
    for (int T = (2 * qb0 - 2 > 0 ? 2 * qb0 - 2 : 0); T <= 2 * qb0 + 1; ++T) sw_fill(L, SK, SV, rowb, h, T, tid);
    bf16x8 bq[4];
#pragma unroll
    for (int ks = 0; ks < 4; ++ks) bq[ks] = *(const GAS bf16x8*)(SQ + (rowb + 128 * qb0 + 16 * w + c15) * 1024 + 128 * h + 32 * ks + 8 * g);
    asm volatile("s_waitcnt vmcnt(0)" : "+v"(bq[0]), "+v"(bq[1]), "+v"(bq[2]), "+v"(bq[3]) :: "memory");
    for (int qb = qb0; qb < qb0 + 16; ++qb) {
        const int T0 = 2 * qb + 1, qwbase = 128 * qb + 16 * w, qpos = qwbase + c15;
        const bool has_next = (qb + 1 < qb0 + 16);
        LBAR();
        v4u nk[2][2], nv[2][2]; bf16x8 bqn[4];
        if (has_next) {
#pragma unroll
            for (int tt = 0; tt < 2; ++tt)
#pragma unroll
                for (int p = 0; p < 2; ++p) { const size_t go = (rowb + 64 * (T0 + 1 + tt) + kl0 + 32 * p) * 1024 + 128 * h + 8 * dp; nk[tt][p] = *(const GAS v4u*)(SK + go); nv[tt][p] = *(const GAS v4u*)(SV + go); }
#pragma unroll
            for (int ks = 0; ks < 4; ++ks) bqn[ks] = *(const GAS bf16x8*)(SQ + (rowb + 128 * (qb + 1) + 16 * w + c15) * 1024 + 128 * h + 32 * ks + 8 * g);
        }
        float carry = 0.f;
        f32x4 oacc[8];
#pragma unroll
        for (int dt = 0; dt < 8; ++dt) oacc[dt] = (f32x4){0.f, 0.f, 0.f, 0.f};
        const int Tlow = (T0 - 3 > 0) ? T0 - 3 : 0;
        for (int T = T0; T >= Tlow; --T) {
            if (__ballot(carry < SB_EXIT) == 0ull) break;
            if (64 * T < qwbase + 16) {
                const LAS unsigned char* sl = L + (T & 3) * SW_SLOT;
                const LAS unsigned char* kb = sl + SW_KOFF + c15 * 272 + g * 16;
                const LAS unsigned char* vb = sl + SW_VOFF + (4 * g + q4) * 288 + 8 * p4;
                if (64 * T + 63 < qwbase) sb_tile<false>(kb, vb, bq, acs, ones, 64 * T + 4 * g, qpos, carry, oacc);
                else sb_tile<true>(kb, vb, bq, acs, ones, 64 * T + 4 * g, qpos, carry, oacc);
            }
        }
        { const unsigned long long bal = __ballot(carry < SB_EXIT); if (lane == 0) flags[w] = (bal != 0ull) ? 1u : 0u; }
        LBAR();
        {
            unsigned any = (flags[0] | flags[1]) | (flags[2] | flags[3]) | (flags[4] | flags[5]) | (flags[6] | flags[7]);
            if (__builtin_amdgcn_readfirstlane(any) != 0u && Tlow > 0) {
                int T = Tlow - 1;
                for (;;) {
                    LBAR();
                    {   LAS unsigned char* sl = L + (T0 & 3) * SW_SLOT;
#pragma unroll
                        for (int p = 0; p < 2; ++p) { const int kl = kl0 + 32 * p; const size_t go = (rowb + 64 * T + kl) * 1024 + 128 * h + 8 * dp;
                            const v4u k0 = *(const GAS v4u*)(SK + go), v0 = *(const GAS v4u*)(SV + go);
                            *(LAS v4u*)(sl + SW_KOFF + kl * 272 + dp * 16) = k0; *(LAS v4u*)(sl + SW_VOFF + kl * 288 + dp * 16) = v0; } }
                    LBAR();
                    if (__ballot(carry < SB_EXIT) != 0ull) {
                        const LAS unsigned char* sl = L + (T0 & 3) * SW_SLOT;
                        sb_tile<false>(sl + SW_KOFF + c15 * 272 + g * 16, sl + SW_VOFF + (4 * g + q4) * 288 + 8 * p4, bq, acs, ones, 64 * T + 4 * g, qpos, carry, oacc);
                    }
                    { const unsigned long long bal = __ballot(carry < SB_EXIT); if (lane == 0) flags[w] = (bal != 0ull) ? 1u : 0u; }
                    LBAR();
                    any = (flags[0] | flags[1]) | (flags[2] | flags[3]) | (flags[4] | flags[5]) | (flags[6] | flags[7]);
                    if (__builtin_amdgcn_readfirstlane(any) == 0u || T == 0) break;
                    --T;
                }
                LBAR();
                sw_fill(L, SK, SV, rowb, h, T0, tid);
                LBAR();
            }
        }
        {
            LAS unsigned char* os = L + ((T0 - 3) & 2) * SW_SLOT + w * SB_OSW;
#pragma unroll
            for (int dt = 0; dt < 8; ++dt) *(LAS f32x4*)(os + c15 * 528 + (16 * dt + 4 * g) * 4) = oacc[dt];
            const int hr = h >> 1, ch = lane & 15, col = 128 * h + 8 * ch;
            const size_t wrow0 = rowb + qwbase;
            const f32x4 rw0 = *(const f32x4*)(a.rnw + 256 * hr + (col & 255)), rw1 = *(const f32x4*)(a.rnw + 256 * hr + (col & 255) + 4);
            v4u orr[4], rg[4], ga[4], gb[4]; f32x4 rs[4];
#pragma unroll
            for (int k = 0; k < 4; ++k) { const size_t row = wrow0 + 4 * k + (lane >> 4), go = row * 1024 + col;
                orr[k] = *(const GAS v4u*)(ORET + go); rg[k] = *(const GAS v4u*)(RG + go); ga[k] = *(const GAS v4u*)(GA + go); gb[k] = *(const GAS v4u*)(GB + go);
                rs[k] = *(const GAS f32x4*)(RSS + row * 16 + hr * 4); }
            asm volatile("s_waitcnt lgkmcnt(0)" ::: "memory");
#pragma unroll
            for (int k = 0; k < 4; ++k) {
                const int r = 4 * k + (lane >> 4);
                const f32x4 o0 = *(const LAS f32x4*)(os + r * 528 + ch * 32), o1 = *(const LAS f32x4*)(os + r * 528 + ch * 32 + 16);
                const float rstd = 1.0f / sqrtf(((rs[k][0] + rs[k][1]) + (rs[k][2] + rs[k][3])) * (1.0f / 256.0f) + 1e-6f);
                v4u mo;
                mo.x = cvtpk(bflo(ga[k].x) * (bflo(orr[k].x) * rstd * rw0[0] * bflo(rg[k].x)) + bflo(gb[k].x) * o0[0], bfhi(ga[k].x) * (bfhi(orr[k].x) * rstd * rw0[1] * bfhi(rg[k].x)) + bfhi(gb[k].x) * o0[1]);
                mo.y = cvtpk(bflo(ga[k].y) * (bflo(orr[k].y) * rstd * rw0[2] * bflo(rg[k].y)) + bflo(gb[k].y) * o0[2], bfhi(ga[k].y) * (bfhi(orr[k].y) * rstd * rw0[3] * bfhi(rg[k].y)) + bfhi(gb[k].y) * o0[3]);
                mo.z = cvtpk(bflo(ga[k].z) * (bflo(orr[k].z) * rstd * rw1[0] * bflo(rg[k].z)) + bflo(gb[k].z) * o1[0], bfhi(ga[k].z) * (bfhi(orr[k].z) * rstd * rw1[1] * bfhi(rg[k].z)) + bfhi(gb[k].z) * o1[1]);
                mo.w = cvtpk(bflo(ga[k].w) * (bflo(orr[k].w) * rstd * rw1[2] * bflo(rg[k].w)) + bflo(gb[k].w) * o1[2], bfhi(ga[k].w) * (bfhi(orr[k].w) * rstd * rw1[3] * bfhi(rg[k].w)) + bfhi(gb[k].w) * o1[3]);
                *(GAS v4u*)(MIX + (wrow0 + r) * 1024 + col) = mo;
            }
        }
        LBAR();
        if (has_next) {
#pragma unroll
            for (int tt = 0; tt < 2; ++tt) { LAS unsigned char* sl = L + ((T0 + 1 + tt) & 3) * SW_SLOT;
#pragma unroll
                for (int p = 0; p < 2; ++p) { const int kl = kl0 + 32 * p; *(LAS v4u*)(sl + SW_KOFF + kl * 272 + dp * 16) = nk[tt][p]; *(LAS v4u*)(sl + SW_VOFF + kl * 288 + dp * 16) = nv[tt][p]; } }
#pragma unroll
            for (int ks = 0; ks < 4; ++ks) bq[ks] = bqn[ks];
            asm volatile("" : "+v"(bq[0]), "+v"(bq[1]), "+v"(bq[2]), "+v"(bq[3]));
        }
    }
    LBAR();
}

DI void stagger(unsigned bx, unsigned ticks) {
    const unsigned grp = (bx >> 7) & 1u;
    if (grp) { const unsigned long long t1 = __builtin_amdgcn_s_memrealtime() + (unsigned long long)ticks;
        while (__builtin_amdgcn_s_memrealtime() < t1) __builtin_amdgcn_s_sleep(16); }
}
#ifndef STAGGER
#define STAGGER 0
#endif
__global__ void __launch_bounds__(NWAVES * 64, 2) mk_fwd(Args a) {
    extern __shared__ __attribute__((aligned(16))) unsigned char lds_raw[];
    LAS unsigned char* lds = (LAS unsigned char*)lds_raw;
    const int tid = threadIdx.x;
    const int G = gridDim.x, bx = blockIdx.x, vcu = (G % 8 == 0) ? (bx % 8) * (G / 8) + bx / 8 : bx;
    volatile LAS unsigned* MISC = (volatile LAS unsigned*)(lds + MISC_OFF);
    if (tid < 16) MISC[tid] = 0u;
    __syncthreads();
    XcdBarrier bar = xcd_barrier_post((unsigned*)(a.ws + WS_CTL) + CW_BAR, MISC + 8);
    unsigned char* ws = a.ws;
    bf16* R0 = (bf16*)(ws + WS_R);

#define PHASE_IDS(T_, L_, W_) int T_ = threadIdx.x; asm volatile("" : "+v"(T_)); const int L_ = T_ & 63, W_ = __builtin_amdgcn_readfirstlane(T_ >> 6)
    { PHASE_IDS(t0, l0, w0); (void)t0; p0_prologue(a, lds, vcu, G, w0, l0); }
#if PROBE_DUP == 6
    { PHASE_IDS(t0, l0, w0); (void)t0; p0_prologue(a, lds, vcu, G, w0, l0); }
#endif
    xcd_barrier(bar);

    {
        pg8::Gemm g{(const pg8::bf16_t*)(ws + WS_XN), (const pg8::bf16_t*)(ws + WS_WIN), M, NIN, DM}; pg8::StaticOrder S; S.init(M, NIN, G, bx);
        pg8::EpiIn E{(pg8::bf16_t*)R0, a.out, (const float*)(ws + WS_ROPE), a.qnw, a.knw, (LAS float*)(lds + XCH_OFF)};
#if STAGGER
        stagger((unsigned)bx, 1700u);
#endif
        pg8::gemm_phase<pg8::EpiIn, pg8::StaticOrder, true, true>(lds, g, S, E);
#if PROBE_DUP == 1
        pg8::gemm_phase<pg8::EpiIn, pg8::StaticOrder, true, true>(lds, g, S, E);
#endif
    }
    xcd_barrier(bar);

#if PROBE_DUP == 2
    { PHASE_IDS(t1, l1, w1); for (int u = vcu; u < 512; u += G) ret_unit<true>(a, lds, (u >> 2) >> 2, (u >> 2) & 3, u & 3, t1, l1, w1); }
    { PHASE_IDS(t2, l2, w2); for (int u = vcu; u < 256; u += G) ret_unit<false>(a, lds, (u >> 2) >> 2, (u >> 2) & 3, u & 3, t2, l2, w2); }
#endif
    { PHASE_IDS(t1, l1, w1); for (int u = vcu; u < 512; u += G) ret_unit<true>(a, lds, (u >> 2) >> 2, (u >> 2) & 3, u & 3, t1, l1, w1); }
    { PHASE_IDS(t2, l2, w2); for (int u = vcu; u < 256; u += G) ret_unit<false>(a, lds, (u >> 2) >> 2, (u >> 2) & 3, u & 3, t2, l2, w2); }
    xcd_barrier(bar);

#if PROBE_DUP == 3 || PROBE_DUP == 8
    { PHASE_IDS(t3, l3, w3); for (int u = vcu; u < 256; u += G) sb_unit<true>(a, lds, u >> 3, u & 7, 0, t3, l3, w3); }
#endif
#if PROBE_DUP == 3 || PROBE_DUP == 9
    { PHASE_IDS(t4, l4, w4); for (int u = vcu; u < 256; u += G) sb_stream(a, lds, (u >> 1) >> 3, (u >> 1) & 7, 16 * (u & 1), t4, l4, w4); }
#endif
    { PHASE_IDS(t3, l3, w3); for (int u = vcu; u < 256; u += G) sb_unit<true>(a, lds, u >> 3, u & 7, 0, t3, l3, w3); }
    { PHASE_IDS(t4, l4, w4); for (int u = vcu; u < 256; u += G) sb_stream(a, lds, (u >> 1) >> 3, (u >> 1) & 7, 16 * (u & 1), t4, l4, w4); }
    xcd_barrier(bar);

    {
        pg8::Gemm g{(const pg8::bf16_t*)R0, (const pg8::bf16_t*)(ws + WS_WOUT), M, DM, DM}; pg8::StaticOrder S; S.init(M, DM, G, bx);
        pg8::EpiRes1 E{a.xp, a.xs, a.out, (pg8::bf16_t*)(R0 + REG_E), (float*)(ws + WS_SSQ)};
        pg8::gemm_phase<pg8::EpiRes1, pg8::StaticOrder, true, true>(lds, g, S, E);
#if PROBE_DUP == 4
        pg8::gemm_phase<pg8::EpiRes1, pg8::StaticOrder, true, true>(lds, g, S, E);
#endif
    }
    xcd_barrier(bar);

    {
        pg8::Gemm g{(const pg8::bf16_t*)(R0 + REG_E), (const pg8::bf16_t*)(ws + WS_WUP), M, FF, DM}; pg8::StaticOrder S; S.init(M, FF, G, bx);
        pg8::EpiUp E{(pg8::bf16_t*)(R0 + 4 * REG_E), (const float*)(ws + WS_SSQ)};
#if STAGGER
        stagger((unsigned)bx, 1400u);
#endif
        pg8::gemm_phase<pg8::EpiUp, pg8::StaticOrder, true, true>(lds, g, S, E);
#if PROBE_DUP == 5
        pg8::gemm_phase<pg8::EpiUp, pg8::StaticOrder, true, true>(lds, g, S, E);
#endif
#if PROBE_DUP == 7
        { pg8::EpiNull EN{(float*)(ws + WS_SSQ)}; pg8::gemm_phase<pg8::EpiNull, pg8::StaticOrder, true, true>(lds, g, S, EN); }
#endif
#if PROBE_DUP == 10 || PROBE_DUP == 11
        { pg8::EpiLinear EL{(pg8::bf16_t*)(R0 + 2 * REG_E)}; pg8::gemm_phase<pg8::EpiLinear, pg8::StaticOrder, true, true>(lds, g, S, EL); }
#endif
    }
    xcd_barrier(bar);

    {
        pg8::Gemm g{(const pg8::bf16_t*)(R0 + 4 * REG_E), (const pg8::bf16_t*)(ws + WS_WDN), M, DM, FF}; pg8::StaticOrder S; S.init(M, DM, G, bx);
        pg8::EpiDown E{a.out};
        pg8::gemm_phase<pg8::EpiDown, pg8::StaticOrder, true, true>(lds, g, S, E);
    }
}

extern "C" void kernel_launch(void* const* d_in, const int* in_sizes, int n_in, void* d_out, int out_size, void* d_ws, size_t ws_size, hipStream_t stream) {
    static int grid = 0;
    if (grid == 0) {
        if (n_in != 14 || in_sizes[0] != MP * DM || out_size != (int)O_END || ws_size < WS_END) {
            fprintf(stderr, "kernel_launch: unexpected shapes: n_in %d in0 %d out %d ws %zu (need %zu)\n", n_in, n_in > 0 ? in_sizes[0] : -1, out_size, ws_size, (size_t)WS_END); grid = -1; return; }
        int dev = 0, cus = 0, per_cu = 0;
        if (hipGetDevice(&dev) != hipSuccess || hipDeviceGetAttribute(&cus, hipDeviceAttributeMultiprocessorCount, dev) != hipSuccess) { grid = -1; return; }
        if (hipFuncSetAttribute((const void*)mk_fwd, hipFuncAttributeMaxDynamicSharedMemorySize, LDS_BYTES) != hipSuccess) { fprintf(stderr, "kernel_launch: hipFuncSetAttribute failed\n"); grid = -1; return; }
        if (hipOccupancyMaxActiveBlocksPerMultiprocessor(&per_cu, (const void*)mk_fwd, NWAVES * 64, LDS_BYTES) != hipSuccess || per_cu < 1) { fprintf(stderr, "kernel_launch: occupancy query reports %d blocks per CU\n", per_cu); }
        (void)hipGetLastError();
        grid = cus;
    }
    if (grid < 0) return;
    if (hipMemsetAsync((char*)d_ws + WS_CTL, 0, CTL_ZERO_BYTES, stream) != hipSuccess) return;
    Args a{};
    a.xp = (const float*)d_in[0]; a.xs = (const float*)d_in[1]; a.ck = (const float*)d_in[2]; a.cv = (const float*)d_in[3]; a.st = (const float*)d_in[4];
    a.nmix = (const float*)d_in[5]; a.win = (const float*)d_in[6]; a.rnw = (const float*)d_in[7]; a.qnw = (const float*)d_in[8]; a.knw = (const float*)d_in[9];
    a.wout = (const float*)d_in[10]; a.nmlp = (const float*)d_in[11]; a.wup = (const float*)d_in[12]; a.wdn = (const float*)d_in[13];
    a.out = (float*)d_out; a.ws = (unsigned char*)d_ws;
    hipLaunchKernelGGL(mk_fwd, dim3(grid), dim3(NWAVES * 64), LDS_BYTES, stream, a);
}
```

```cpp
#ifndef PROBE_DUP
#define PROBE_DUP 0
#endif
#include <hip/hip_runtime.h>
#include <cstdio>
#include <cstdint>
#include <cmath>
namespace pg8 {
#define PG8_LAS __attribute__((address_space(3)))
typedef unsigned short bf16_t;
typedef short bf16x8 __attribute__((ext_vector_type(8)));
typedef float f32x4 __attribute__((ext_vector_type(4)));
typedef unsigned u32x4 __attribute__((ext_vector_type(4)));
constexpr int BM = 256, BK = 64, HALF = 128, HTB = HALF * BK * 2  , STAGE_BYTES = 8 * HTB, NXCD = 8, WGM = 8;

__host__ __device__ __forceinline__ int lds_byte(int r, int c) { const int st = (r >> 4) * 2 + (c >> 5), rr = r & 15, cc = c & 31, ob = rr * 64 + cc * 2; return st * 1024 + (ob ^ (((ob >> 9) & 1) << 5)); }
__host__ __device__ __forceinline__ void stage_rc(int b, int& R, int& C) { const int st = b / 1024, sb = b % 1024, swz = sb ^ (((sb >> 9) & 1) << 5); R = (st >> 1) * 16 + swz / 64; C = (st & 1) * 32 + (swz % 64) / 2; }
__host__ __device__ __forceinline__ int perm32(int rho) { const int n = rho >> 4, i = rho & 15; return 8 * (i >> 2) + 4 * n + (i & 3); }

struct Unit { int pm, pn; };
struct Gemm { const bf16_t* A; const bf16_t* Bt; int M, N, K; int nt; };

struct StaticOrder {
    int nM, nN, nwg, G, c;
    __host__ __device__ void init(int M, int N, int G_, int c_) { nM = M / BM; nN = N / BM; nwg = nM * nN; G = G_; c = c_; }
    __host__ __device__ bool next(int i, Unit& u) const {
        const long L = (long)i * G + c; if (L >= nwg) return false;
        int wgid = (int)L; { const int q = nwg / NXCD, r = nwg % NXCD, xcd = wgid % NXCD, off = wgid / NXCD; wgid = (xcd < r ? xcd * (q + 1) : r * (q + 1) + (xcd - r) * q) + off; }
        const int nig = WGM * nN, gid = wgid / nig, fm = gid * WGM, gsz = (nM - fm) < WGM ? (nM - fm) : WGM;
        u.pm = fm + ((wgid % nig) % gsz); u.pn = (wgid % nig) / gsz; return true;
    }
    __device__ __forceinline__ void a_ready(const Unit&) const {}
    __device__ __forceinline__ void done(const Unit&) const {}
};

__device__ __forceinline__ unsigned cvt_pk_bf16(float lo, float hi) { unsigned r; asm volatile("v_cvt_pk_bf16_f32 %0, %1, %2" : "=v"(r) : "v"(lo), "v"(hi)); return r; }
typedef float f32x2 __attribute__((ext_vector_type(2)));

typedef unsigned u32x2 __attribute__((ext_vector_type(2)));
typedef float f32x2_t __attribute__((ext_vector_type(2))); typedef __bf16 bf16x2_t __attribute__((ext_vector_type(2)));
__device__ __forceinline__ unsigned cvtpk(float lo, float hi) { f32x2_t v = {lo, hi}; bf16x2_t b = __builtin_convertvector(v, bf16x2_t); return __builtin_bit_cast(unsigned, b); }
__device__ __forceinline__ void store8(bf16_t* p, const f32x4 a, const f32x4 b) { u32x4 w; w.x = cvtpk(a[0], a[1]); w.y = cvtpk(a[2], a[3]); w.z = cvtpk(b[0], b[1]); w.w = cvtpk(b[2], b[3]); *(u32x4*)p = w; }
__device__ __forceinline__ float sigmoidf_fast(float x) { return __builtin_amdgcn_rcpf(1.0f + __builtin_amdgcn_exp2f(-1.4426950408889634f * x)); }
__device__ __forceinline__ float sumsq4(const f32x4 a) { return (a[0] * a[0] + a[1] * a[1]) + (a[2] * a[2] + a[3] * a[3]); }

constexpr int E_MP = 65536;
constexpr size_t E_REG = (size_t)66560 * 1024;
constexpr size_t EO_KP = 68157440, EO_VP = 135266304, EO_KS = 206569472, EO_VS = 207618048;

__device__ __forceinline__ unsigned ror8(unsigned x) { return (unsigned)__builtin_amdgcn_mov_dpp((int)x, 0x128, 0xf, 0xf, true); }
__device__ __forceinline__ u32x4 ror8v(const u32x4 v) { u32x4 r; r.x = ror8(v.x); r.y = ror8(v.y); r.z = ror8(v.z); r.w = ror8(v.w); return r; }
__device__ __forceinline__ u32x4 pack8(const f32x4 a, const f32x4 b) { u32x4 w; w.x = cvtpk(a[0], a[1]); w.y = cvtpk(a[2], a[3]); w.z = cvtpk(b[0], b[1]); w.w = cvtpk(b[2], b[3]); return w; }
__device__ __forceinline__ void store_rows_bf16(bf16_t* grp, size_t ld, int fr, int fq, const u32x4 P0, const u32x4 P1) {
    const bool lo = fr < 8; const u32x4 snd = lo ? P1 : P0, rcv = ror8v(snd);
    bf16_t* a = grp + (size_t)(fr & 7) * ld + (fq + 4 * (fr >> 3)) * 8;
    __builtin_nontemporal_store(lo ? P0 : rcv, (u32x4*)a); __builtin_nontemporal_store(lo ? rcv : P1, (u32x4*)(a + 8 * ld));
}
__device__ __forceinline__ void store_rows_f32(float* grp, size_t ld, int fr, int fq, const f32x4 V0, const f32x4 V1) {
    const bool lo = fr < 8; const u32x4 snd = __builtin_bit_cast(u32x4, lo ? V1 : V0), rcv = ror8v(snd);
    float* a = grp + (size_t)(fr & 7) * ld + (2 * fq + (fr >> 3)) * 4;
    __builtin_nontemporal_store(lo ? __builtin_bit_cast(u32x4, V0) : rcv, (u32x4*)a); __builtin_nontemporal_store(lo ? rcv : __builtin_bit_cast(u32x4, V1), (u32x4*)(a + 8 * ld));
}
struct RowPair { u32x4 a, b; };
__device__ __forceinline__ RowPair load_rows_f32(const float* grp, size_t ld, int fr, int fq) {
    const float* a = grp + (size_t)(fr & 7) * ld + (2 * fq + (fr >> 3)) * 4; RowPair r; r.a = __builtin_nontemporal_load((const u32x4*)a); r.b = __builtin_nontemporal_load((const u32x4*)(a + 8 * ld)); return r;
}
__device__ __forceinline__ void unswap_rows_f32(const RowPair r, int fr, f32x4& V0, f32x4& V1) {
    const bool lo = fr < 8; const u32x4 snd = lo ? r.b : r.a, rcv = ror8v(snd);
    V0 = __builtin_bit_cast(f32x4, lo ? r.a : rcv); V1 = __builtin_bit_cast(f32x4, lo ? rcv : r.b);
}

struct EpiIn {
    static constexpr bool PERM = true, AFTER_DRAIN = false, DUP_OK = true;
    bf16_t* R; float* out; const float* rope; const float* qw; const float* kw; PG8_LAS float* xch;
    __device__ __forceinline__ void operator()(const f32x4 (&acc)[2][2][4][2], const Unit& u, int wr, int wc, int fr, int fq) const {
        const int tt = u.pn >> 2, hq = u.pn & 3;
        const int rowg = u.pm * BM + wr * 64;
        bf16_t* base = R + (size_t)tt * E_REG + hq * 256 + 64 * wc;
        if (tt <= 1) {
            const float sc = (tt == 1) ? 0.0625f : 1.0f;
            const int cl = 32 * wc + 8 * fq;
            f32x4 tb[2][4];
#define ROPE_LD(g_) do { const int row_ = rowg + fr + ((g_) >> 2) * HALF + ((g_) & 3) * 16; const int pos_ = (row_ < E_MP) ? (row_ & 4095) : (4096 + (row_ & 31)); \
                const f32x4* tp_ = (const f32x4*)(rope + ((size_t)pos_ * 128 + cl) * 2); tb[(g_) & 1][0] = tp_[0]; tb[(g_) & 1][1] = tp_[1]; tb[(g_) & 1][2] = tp_[2]; tb[(g_) & 1][3] = tp_[3]; } while (0)
            ROPE_LD(0);
#pragma unroll
            for (int gi = 0; gi < 8; ++gi) {
                const int ai = gi >> 2, m = gi & 3;
                if (gi < 7) ROPE_LD(gi + 1);
                asm volatile("" ::: "memory");
                f32x4 o1[2], o2[2];
#pragma unroll
                for (int n = 0; n < 2; ++n) {
                    const f32x4 t0 = tb[gi & 1][2 * n], t1 = tb[gi & 1][2 * n + 1], x1 = acc[ai][0][m][n], x2 = acc[ai][1][m][n];
                    o1[n] = (f32x4){x1[0] * t0[0] - x2[0] * t0[1], x1[1] * t0[2] - x2[1] * t0[3], x1[2] * t1[0] - x2[2] * t1[1], x1[3] * t1[2] - x2[3] * t1[3]} * sc;
                    o2[n] = (f32x4){x1[0] * t0[1] + x2[0] * t0[0], x1[1] * t0[3] + x2[1] * t0[2], x1[2] * t1[1] + x2[2] * t1[0], x1[3] * t1[3] + x2[3] * t1[2]} * sc;
                }
                store_rows_bf16(base + (size_t)(rowg + ai * HALF + m * 16) * 1024, 1024, fr, fq, pack8(o1[0], o1[1]), pack8(o2[0], o2[1]));
            }
#undef ROPE_LD
        } else if (tt == 4 || tt == 5) {
            const float* wsrc = ((tt == 4) ? qw : kw) + 64 * (wc & 1) + 8 * fq;
            const f32x4 w00 = *(const f32x4*)(wsrc), w01 = *(const f32x4*)(wsrc + 4), w10 = *(const f32x4*)(wsrc + 32), w11 = *(const f32x4*)(wsrc + 36);
            const float osc = (tt == 4) ? 0.08838834764831845f * 1.4426950408889634f : 1.0f;
#pragma unroll
            for (int ai = 0; ai < 2; ++ai)
#pragma unroll
                for (int m = 0; m < 4; ++m) {
                    float s = (sumsq4(acc[ai][0][m][0]) + sumsq4(acc[ai][0][m][1])) + (sumsq4(acc[ai][1][m][0]) + sumsq4(acc[ai][1][m][1]));
                    s += __shfl_xor(s, 16); s += __shfl_xor(s, 32);
                    if (fq == 0) xch[(ai * HALF + wr * 64 + m * 16 + fr) * 4 + wc] = s;
                }
            asm volatile("s_waitcnt lgkmcnt(0)" ::: "memory"); __builtin_amdgcn_s_barrier(); asm volatile("" ::: "memory");
            float* ok = ((u.pm * BM < E_MP) ? out + EO_KP : out + EO_KS - (size_t)E_MP * 1024) + hq * 256 + 64 * wc;
#pragma unroll
            for (int ai = 0; ai < 2; ++ai)
#pragma unroll
                for (int m = 0; m < 4; ++m) {
                    const int rl = ai * HALF + wr * 64 + m * 16 + fr; const size_t grow = (size_t)(rowg + ai * HALF + m * 16);
                    const f32x4 p = *(const PG8_LAS f32x4*)(xch + rl * 4);
                    const float rstd = osc / sqrtf(((wc < 2) ? (p[0] + p[1]) : (p[2] + p[3])) * (1.0f / 128.0f) + 1e-6f);
                    const f32x4 v00 = acc[ai][0][m][0] * rstd * w00, v01 = acc[ai][0][m][1] * rstd * w01, v10 = acc[ai][1][m][0] * rstd * w10, v11 = acc[ai][1][m][1] * rstd * w11;
                    if (tt == 5) { store_rows_f32(ok + grow * 1024, 1024, fr, fq, v00, v01); store_rows_f32(ok + grow * 1024 + 32, 1024, fr, fq, v10, v11); }
                    store_rows_bf16(base + grow * 1024, 1024, fr, fq, pack8(v00, v01), pack8(v10, v11));
                }
        } else {
            float* ov = ((u.pm * BM < E_MP) ? out + EO_VP : out + EO_VS - (size_t)E_MP * 1024) + hq * 256 + 64 * wc;
#pragma unroll
            for (int ai = 0; ai < 2; ++ai)
#pragma unroll
                for (int m = 0; m < 4; ++m) {
                    const size_t grow = (size_t)(rowg + ai * HALF + m * 16);
                    f32x4 v[2][2];
#pragma unroll
                    for (int bj = 0; bj < 2; ++bj) {
                        v[bj][0] = acc[ai][bj][m][0]; v[bj][1] = acc[ai][bj][m][1];
                        if (tt == 3) {
#pragma unroll
                            for (int e = 0; e < 4; ++e) { v[bj][0][e] *= sigmoidf_fast(v[bj][0][e]); v[bj][1][e] *= sigmoidf_fast(v[bj][1][e]); }
                        } else if (tt >= 7) {
#pragma unroll
                            for (int e = 0; e < 4; ++e) { v[bj][0][e] = sigmoidf_fast(v[bj][0][e]); v[bj][1][e] = sigmoidf_fast(v[bj][1][e]); }
                        }
                    }
                    if (tt == 6) { store_rows_f32(ov + grow * 1024, 1024, fr, fq, v[0][0], v[0][1]); store_rows_f32(ov + grow * 1024 + 32, 1024, fr, fq, v[1][0], v[1][1]); }
                    store_rows_bf16(base + grow * 1024, 1024, fr, fq, pack8(v[0][0], v[0][1]), pack8(v[1][0], v[1][1]));
                }
        }
    }
};

struct EpiRes1 {
    static constexpr bool PERM = true, AFTER_DRAIN = false, DUP_OK = true;
    const float* xp; const float* xs; float* out; bf16_t* XB; float* SSQ;
    __device__ __forceinline__ void operator()(const f32x4 (&acc)[2][2][4][2], const Unit& u, int wr, int wc, int fr, int fq) const {
        const int rowg = u.pm * BM + wr * 64, colw = u.pn * BM + 64 * wc;
        const float* xb = ((u.pm * BM < E_MP) ? xp : xs - (size_t)E_MP * 1024) + colw;
        RowPair xv[2][2];
#define RES_LD(g_) do { const size_t off_ = (size_t)(rowg + ((g_) >> 2) * HALF + ((g_) & 3) * 16) * 1024; xv[(g_) & 1][0] = load_rows_f32(xb + off_, 1024, fr, fq); xv[(g_) & 1][1] = load_rows_f32(xb + off_ + 32, 1024, fr, fq); } while (0)
        RES_LD(0);
#pragma unroll
        for (int gi = 0; gi < 8; ++gi) {
            const int ai = gi >> 2, m = gi & 3;
            if (gi < 7) RES_LD(gi + 1);
            asm volatile("" ::: "memory");
            const size_t grow = (size_t)(rowg + ai * HALF + m * 16); float ss = 0.f;
            f32x4 v[2][2];
#pragma unroll
            for (int bj = 0; bj < 2; ++bj) {
                f32x4 x0, x1; unswap_rows_f32(xv[gi & 1][bj], fr, x0, x1);
                v[bj][0] = acc[ai][bj][m][0] + x0; v[bj][1] = acc[ai][bj][m][1] + x1;
                ss += sumsq4(v[bj][0]) + sumsq4(v[bj][1]);
                store_rows_f32(out + grow * 1024 + colw + 32 * bj, 1024, fr, fq, v[bj][0], v[bj][1]);
            }
            store_rows_bf16(XB + grow * 1024 + colw, 1024, fr, fq, pack8(v[0][0], v[0][1]), pack8(v[1][0], v[1][1]));
            ss += __shfl_xor(ss, 16); ss += __shfl_xor(ss, 32);
            if (fq == 0) SSQ[(grow + fr) * 16 + u.pn * 4 + wc] = ss;
        }
#undef RES_LD
    }
};

struct EpiUp {
    static constexpr bool PERM = true, AFTER_DRAIN = false, DUP_OK = true;
    bf16_t* H; const float* SSQ;
    __device__ __forceinline__ void operator()(const f32x4 (&acc)[2][2][4][2], const Unit& u, int wr, int wc, int fr, int fq) const {
        const int rowg = u.pm * BM + wr * 64, colw = u.pn * BM + 64 * wc;
        f32x4 sq[2][4];
#pragma unroll
        for (int ai = 0; ai < 2; ++ai)
#pragma unroll
            for (int m = 0; m < 4; ++m) sq[ai][m] = *(const f32x4*)(SSQ + (size_t)(rowg + fr + ai * HALF + m * 16) * 16 + 4 * fq);
        asm volatile("" ::: "memory");
#pragma unroll
        for (int ai = 0; ai < 2; ++ai)
#pragma unroll
            for (int m = 0; m < 4; ++m) {
                float t = (sq[ai][m][0] + sq[ai][m][1]) + (sq[ai][m][2] + sq[ai][m][3]);
                t += __shfl_xor(t, 16); t += __shfl_xor(t, 32);
                const float r2 = 1.0f / (t * (1.0f / 1024.0f) + 1e-6f);
                f32x4 v[2][2];
#pragma unroll
                for (int bj = 0; bj < 2; ++bj) {
                    v[bj][0] = acc[ai][bj][m][0]; v[bj][1] = acc[ai][bj][m][1];
#pragma unroll
                    for (int e = 0; e < 4; ++e) { const float a = fmaxf(v[bj][0][e], 0.f), b = fmaxf(v[bj][1][e], 0.f); v[bj][0][e] = a * a * r2; v[bj][1][e] = b * b * r2; }
                }
                store_rows_bf16(H + (size_t)(rowg + ai * HALF + m * 16) * 4096 + colw, 4096, fr, fq, pack8(v[0][0], v[0][1]), pack8(v[1][0], v[1][1]));
            }
    }
};

struct EpiDown {
    static constexpr bool PERM = true, AFTER_DRAIN = false, DUP_OK = false;
    float* out;
    __device__ __forceinline__ void operator()(const f32x4 (&acc)[2][2][4][2], const Unit& u, int wr, int wc, int fr, int fq) const {
        const int rowg = u.pm * BM + wr * 64, colw = u.pn * BM + 64 * wc;
        RowPair xv[2][2];
#define DN_LD(g_) do { const float* o_ = out + (size_t)(rowg + ((g_) >> 2) * HALF + ((g_) & 3) * 16) * 1024 + colw; xv[(g_) & 1][0] = load_rows_f32(o_, 1024, fr, fq); xv[(g_) & 1][1] = load_rows_f32(o_ + 32, 1024, fr, fq); } while (0)
        DN_LD(0);
#pragma unroll
        for (int gi = 0; gi < 8; ++gi) {
            const int ai = gi >> 2, m = gi & 3;
            if (gi < 7) DN_LD(gi + 1);
            asm volatile("" ::: "memory");
            float* o = out + (size_t)(rowg + ai * HALF + m * 16) * 1024 + colw;
#pragma unroll
            for (int bj = 0; bj < 2; ++bj) {
                f32x4 x0, x1; unswap_rows_f32(xv[gi & 1][bj], fr, x0, x1);
                store_rows_f32(o + 32 * bj, 1024, fr, fq, acc[ai][bj][m][0] + x0, acc[ai][bj][m][1] + x1);
            }
        }
#undef DN_LD
    }
};

struct OneUnit {
    int pm, pn;
    __device__ __forceinline__ bool next(int i, Unit& u) const { if (i != 0) return false; u.pm = pm; u.pn = pn; return true; }
    __device__ __forceinline__ void a_ready(const Unit&) const {}
    __device__ __forceinline__ void done(const Unit&) const {}
};
struct EpiPartial {
    static constexpr bool PERM = true, AFTER_DRAIN = false, DUP_OK = false;
    float* part;
    __device__ __forceinline__ void operator()(const f32x4 (&acc)[2][2][4][2], const Unit& u, int wr, int wc, int fr, int fq) const {
        const int rowg = (u.pm - 256) * BM + wr * 64, colw = u.pn * BM + 64 * wc;
#pragma unroll
        for (int ai = 0; ai < 2; ++ai)
#pragma unroll
            for (int m = 0; m < 4; ++m)
#pragma unroll
                for (int bj = 0; bj < 2; ++bj) store_rows_f32(part + (size_t)(rowg + ai * HALF + m * 16) * 1024 + colw + 32 * bj, 1024, fr, fq, acc[ai][bj][m][0], acc[ai][bj][m][1]);
    }
};

struct EpiNull {
    static constexpr bool PERM = true, AFTER_DRAIN = false, DUP_OK = false;
    float* sink;
    __device__ __forceinline__ void operator()(const f32x4 (&acc)[2][2][4][2], const Unit& u, int wr, int wc, int fr, int fq) const {
        float t = 0.f;
#pragma unroll
        for (int ai = 0; ai < 2; ++ai)
#pragma unroll
            for (int bj = 0; bj < 2; ++bj)
#pragma unroll
                for (int m = 0; m < 4; ++m)
#pragma unroll
                    for (int n = 0; n < 2; ++n) t += (acc[ai][bj][m][n][0] + acc[ai][bj][m][n][1]) + (acc[ai][bj][m][n][2] + acc[ai][bj][m][n][3]);
        if (t == 123456.789f) sink[u.pm * 7 + u.pn + wr + wc + fr + fq] = t;
    }
};

struct EpiLinear {
    static constexpr bool PERM = true, AFTER_DRAIN = false, DUP_OK = false;
    bf16_t* sink;
    __device__ __forceinline__ void operator()(const f32x4 (&acc)[2][2][4][2], const Unit& u, int wr, int wc, int fr, int fq) const {
#if PROBE_DUP == 11
        const int l_ = fq * 16 + fr;
        bf16_t* base = sink + (size_t)((u.pm * 16 + u.pn) & 255) * 131072 + (size_t)(l_ >> 3) * 1024 + (wr * 4 + wc) * 64 + (l_ & 7) * 8;
#define LIN_STEP 8192
#else
        bf16_t* base = sink + (size_t)((u.pm * 16 + u.pn) & 255) * 65536 + (size_t)(wr * 4 + wc) * 8192 + (fq * 16 + fr) * 8;
#define LIN_STEP 512
#endif
#pragma unroll
        for (int ai = 0; ai < 2; ++ai)
#pragma unroll
            for (int m = 0; m < 4; ++m)
#pragma unroll
                for (int bj = 0; bj < 2; ++bj) store8(base + ((ai * 4 + m) * 2 + bj) * LIN_STEP, acc[ai][bj][m][0], acc[ai][bj][m][1]);
    }
};
template <class Epi, class Sched, bool ALIGN_EPI = false, bool SP2 = false>
__device__ __forceinline__ void gemm_phase(PG8_LAS unsigned char* lds, const Gemm g, const Sched& S, const Epi& E) {
    int tid_ = threadIdx.x; asm volatile("" : "+v"(tid_));
    const int tid = tid_, wid = __builtin_amdgcn_readfirstlane(tid >> 6), lane = tid & 63, wr = wid >> 2, wc = wid & 3, fr = lane & 15, fq = lane >> 4;
    const int K = g.K, nt = g.nt ? g.nt : K / BK;
    unsigned voffA[2], voffB[2];
#pragma unroll
    for (int i = 0; i < 2; ++i) { int R, C; stage_rc(tid * 16 + i * 8192, R, C); const int Rb = Epi::PERM ? ((R & ~31) + perm32(R & 31)) : R;
        voffA[i] = (unsigned)(R * K + C) * 2u; voffB[i] = (unsigned)(Rb * K + C) * 2u; }
    const size_t kstep = (size_t)(BK * 2);
    const size_t hstep = (size_t)HALF * K * 2;
    const size_t tstep = 2 * hstep;
    const unsigned ldsw = (unsigned)wid * 1024u;
    const int aoff = lds_byte(wr * 64 + fr, fq * 8), boff = lds_byte(wc * 32 + fr, fq * 8);
#define PG8_SA(b, h) (((b) * 2 + (h)) * HTB)
#define PG8_SB(b, h) ((4 + (b) * 2 + (h)) * HTB)
#define PG8_STAGE(bufoff, gbase, voff) do { _Pragma("unroll") for (int _i = 0; _i < 2; ++_i) \
        __builtin_amdgcn_global_load_lds((const unsigned*)((const char*)(gbase) + (voff)[_i]), (PG8_LAS unsigned*)(lds + (bufoff) + ldsw + _i * 8192), 16, 0, 0); } while (0)
#define PG8_LDA(dst, b, h) do { _Pragma("unroll") for (int m = 0; m < 4; ++m) _Pragma("unroll") for (int k = 0; k < 2; ++k) dst[m][k] = *(const PG8_LAS bf16x8*)(lds + PG8_SA(b, h) + aoff + m * 2048 + k * 1024); } while (0)
#define PG8_LDB(dst, b, h) do { _Pragma("unroll") for (int n = 0; n < 2; ++n) _Pragma("unroll") for (int k = 0; k < 2; ++k) dst[n][k] = *(const PG8_LAS bf16x8*)(lds + PG8_SB(b, h) + boff + n * 2048 + k * 1024); } while (0)
#define PG8_MMA(ai, bj, At, Bt) do { __builtin_amdgcn_s_setprio(1); _Pragma("unroll") for (int m = 0; m < 4; ++m) _Pragma("unroll") for (int n = 0; n < 2; ++n) _Pragma("unroll") for (int k = 0; k < 2; ++k) \
        acc[ai][bj][m][n] = __builtin_amdgcn_mfma_f32_16x16x32_bf16(Bt[n][k], At[m][k], acc[ai][bj][m][n], 0, 0, 0); __builtin_amdgcn_s_setprio(0); } while (0)
#define PG8_WAIT_V(n) asm volatile("s_waitcnt vmcnt(" #n ")" ::: "memory")
#define PG8_WAIT_L(n) asm volatile("s_waitcnt lgkmcnt(" #n ")" ::: "memory")
#define PG8_BAR __builtin_amdgcn_s_barrier()
#define PG8_SCHED __builtin_amdgcn_sched_barrier(0)
    Unit cur, nxt; int ui = 0;
    if (!S.next(0, cur)) return;
    f32x4 acc[2][2][4][2];
#pragma unroll
    for (int a = 0; a < 2; ++a)
#pragma unroll
        for (int b = 0; b < 2; ++b)
#pragma unroll
            for (int m = 0; m < 4; ++m)
#pragma unroll
                for (int n = 0; n < 2; ++n) acc[a][b][m][n] = (f32x4){0.f, 0.f, 0.f, 0.f};
    bf16x8 At[4][2], B0[2][2], B1[2][2];
    const char* cA = (const char*)g.A + (size_t)cur.pm * tstep; const char* cB = (const char*)g.Bt + (size_t)cur.pn * tstep;
    S.a_ready(cur);
    if constexpr (SP2) {
        PG8_STAGE(PG8_SB(0, 0), cB, voffB); PG8_STAGE(PG8_SB(0, 1), cB + hstep, voffB); PG8_STAGE(PG8_SA(0, 0), cA, voffA); PG8_STAGE(PG8_SA(0, 1), cA + hstep, voffA);
        if (wr == 1) PG8_BAR;
        PG8_WAIT_V(2); PG8_BAR;
        PG8_STAGE(PG8_SB(1, 0), cB + kstep, voffB); PG8_STAGE(PG8_SA(1, 0), cA + kstep, voffA); PG8_STAGE(PG8_SB(1, 1), cB + hstep + kstep, voffB);
        PG8_WAIT_V(6); PG8_BAR;
    } else {
        PG8_STAGE(PG8_SB(0, 0), cB, voffB); PG8_STAGE(PG8_SA(0, 0), cA, voffA); PG8_STAGE(PG8_SB(0, 1), cB + hstep, voffB); PG8_STAGE(PG8_SA(0, 1), cA + hstep, voffA);
        if (wr == 1) PG8_BAR;
        PG8_WAIT_V(4); PG8_BAR;
        PG8_STAGE(PG8_SB(1, 0), cB + kstep, voffB); PG8_STAGE(PG8_SA(1, 0), cA + kstep, voffA); PG8_STAGE(PG8_SB(1, 1), cB + hstep + kstep, voffB);
        PG8_WAIT_V(6); PG8_BAR;
    }
    for (;;) {
        const bool has_next = S.next(ui + 1, nxt);
        const char* nA = has_next ? (const char*)g.A + (size_t)nxt.pm * tstep : cA; const char* nB = has_next ? (const char*)g.Bt + (size_t)nxt.pn * tstep : cB;
        for (int t = 0; t < nt; t += 2) {
            const bool last = (t == nt - 2);
            const char* a1 = cA + (size_t)(t + 1) * kstep;
            const char* a2 = last ? nA : cA + (size_t)(t + 2) * kstep; const char* b2 = last ? nB : cB + (size_t)(t + 2) * kstep;
            const char* a3 = a2 + kstep; const char* b3 = b2 + kstep;
            if (last && has_next) S.a_ready(nxt);
            if constexpr (SP2) {
            PG8_LDB(B0, 0, 0); PG8_LDB(B1, 0, 1); PG8_SCHED; PG8_LDA(At, 0, 0); PG8_STAGE(PG8_SA(1, 1), a1 + hstep, voffA);
            PG8_WAIT_V(8); PG8_WAIT_L(0); PG8_BAR; PG8_MMA(0, 0, At, B0); PG8_MMA(0, 1, At, B1); PG8_BAR; PG8_SCHED;
            PG8_LDA(At, 0, 1); PG8_STAGE(PG8_SB(0, 0), b2, voffB); PG8_STAGE(PG8_SB(0, 1), b2 + hstep, voffB); PG8_STAGE(PG8_SA(0, 0), a2, voffA);
            PG8_WAIT_V(8); PG8_WAIT_L(0); PG8_BAR; PG8_MMA(1, 0, At, B0); PG8_MMA(1, 1, At, B1); PG8_BAR; PG8_SCHED;
            PG8_LDB(B0, 1, 0); PG8_LDB(B1, 1, 1); PG8_SCHED; PG8_LDA(At, 1, 0); PG8_STAGE(PG8_SA(0, 1), a2 + hstep, voffA);
            PG8_WAIT_V(8); PG8_WAIT_L(0); PG8_BAR; PG8_MMA(0, 0, At, B0); PG8_MMA(0, 1, At, B1); PG8_BAR; PG8_SCHED;
            PG8_LDA(At, 1, 1); PG8_STAGE(PG8_SB(1, 0), b3, voffB); PG8_STAGE(PG8_SB(1, 1), b3 + hstep, voffB); PG8_STAGE(PG8_SA(1, 0), a3, voffA);
            PG8_WAIT_V(8); PG8_WAIT_L(0); PG8_BAR; PG8_MMA(1, 0, At, B0); PG8_MMA(1, 1, At, B1); PG8_BAR; PG8_SCHED;
            } else {
            PG8_LDB(B0, 0, 0); PG8_SCHED; PG8_LDA(At, 0, 0); PG8_STAGE(PG8_SA(1, 1), a1 + hstep, voffA);
            PG8_WAIT_L(8); PG8_BAR; PG8_WAIT_L(0); PG8_MMA(0, 0, At, B0); PG8_BAR; PG8_SCHED;
            PG8_LDB(B1, 0, 1); PG8_STAGE(PG8_SB(0, 0), b2, voffB);
            PG8_BAR; PG8_WAIT_L(0); PG8_MMA(0, 1, At, B1); PG8_BAR;
            PG8_LDA(At, 0, 1); PG8_STAGE(PG8_SA(0, 0), a2, voffA);
            PG8_BAR; PG8_WAIT_L(0); PG8_MMA(1, 0, At, B0); PG8_BAR; PG8_SCHED;
            PG8_STAGE(PG8_SB(0, 1), b2 + hstep, voffB);
            PG8_WAIT_V(6); PG8_BAR; PG8_MMA(1, 1, At, B1); PG8_BAR;
            PG8_LDB(B0, 1, 0); PG8_SCHED; PG8_LDA(At, 1, 0); PG8_STAGE(PG8_SA(0, 1), a2 + hstep, voffA);
            PG8_WAIT_L(8); PG8_BAR; PG8_WAIT_L(0); PG8_MMA(0, 0, At, B0); PG8_BAR; PG8_SCHED;
            PG8_LDB(B1, 1, 1); PG8_STAGE(PG8_SB(1, 0), b3, voffB);
            PG8_BAR; PG8_WAIT_L(0); PG8_MMA(0, 1, At, B1); PG8_BAR;
            PG8_LDA(At, 1, 1); PG8_STAGE(PG8_SA(1, 0), a3, voffA);
            PG8_BAR; PG8_WAIT_L(0); PG8_MMA(1, 0, At, B0); PG8_BAR; PG8_SCHED;
            PG8_STAGE(PG8_SB(1, 1), b3 + hstep, voffB);
            PG8_WAIT_V(6); PG8_BAR; PG8_MMA(1, 1, At, B1); PG8_BAR;
            }
        }
        if constexpr (ALIGN_EPI) { if (wr == 0) PG8_BAR; }
        if constexpr (!Epi::AFTER_DRAIN) { E(acc, cur, wr, wc, fr, fq);
#if defined(PROBE_EPI2)
            if constexpr (Epi::DUP_OK) { asm volatile("" ::: "memory"); E(acc, cur, wr, wc, fr, fq); }
#endif
            S.done(cur); }
        if (!has_next) break;
#pragma unroll
        for (int a = 0; a < 2; ++a)
#pragma unroll
            for (int b = 0; b < 2; ++b)
#pragma unroll
                for (int m = 0; m < 4; ++m)
#pragma unroll
                    for (int n = 0; n < 2; ++n) acc[a][b][m][n] = (f32x4){0.f, 0.f, 0.f, 0.f};
        cur = nxt; cA = nA; cB = nB; ++ui;
        if constexpr (ALIGN_EPI) { if (wr == 1) PG8_BAR; }
    }
    PG8_WAIT_V(0);
    if constexpr (!ALIGN_EPI) { if (wr == 0) PG8_BAR; }
    PG8_BAR;
    if constexpr (Epi::AFTER_DRAIN) { E.fused(acc, cur, wr, wc, fr, fq, lds, wid, lane); S.done(cur); }
#undef PG8_SA
#undef PG8_SB
#undef PG8_STAGE
#undef PG8_LDA
#undef PG8_LDB
#undef PG8_MMA
#undef PG8_WAIT_V
#undef PG8_WAIT_L
#undef PG8_BAR
#undef PG8_SCHED
}
}
#define GAS __attribute__((address_space(1)))
#define LAS __attribute__((address_space(3)))
typedef unsigned short bf16;
typedef unsigned v4u __attribute__((ext_vector_type(4)));
typedef float f32x4 __attribute__((ext_vector_type(4)));
typedef short bf16x8 __attribute__((ext_vector_type(8)));
typedef GAS unsigned gu32;
typedef GAS unsigned long long gu64;
#define RLX_AGENT __ATOMIC_RELAXED, __HIP_MEMORY_SCOPE_AGENT
#define LDS_WAIT() asm volatile("s_waitcnt lgkmcnt(0)" ::: "memory")
#define VM_WAIT() asm volatile("s_waitcnt vmcnt(0)" ::: "memory")
__device__ __forceinline__ unsigned long long rt() { return __builtin_amdgcn_s_memrealtime(); }
__device__ __forceinline__ unsigned f2bf(float f) { unsigned u = __builtin_bit_cast(unsigned, f); return (u + 0x7fffu + ((u >> 16) & 1u)) >> 16; }
__device__ __forceinline__ unsigned pk2(float lo, float hi) { return f2bf(lo) | (f2bf(hi) << 16); }

#define XB_TMO      128
#define XB_XCNT(j)  (256  + 64 * (j))
#define XB_XSUB(j)  (1280 + 64 * (j))
#define XB_XGEN(j)  (2304 + 64 * (j))
#define XB_TOP      3328
#define XB_TOPGEN   3392
#define XCD_BAR_WORDS 3456
#define XB_SPIN_CAP (1u << 18)

__device__ __forceinline__ unsigned xb_ld(unsigned* p)              { return __hip_atomic_load(p, __ATOMIC_RELAXED, __HIP_MEMORY_SCOPE_AGENT); }
__device__ __forceinline__ unsigned xb_add(unsigned* p, unsigned v) { return __hip_atomic_fetch_add(p, v, __ATOMIC_RELAXED, __HIP_MEMORY_SCOPE_AGENT); }
__device__ __forceinline__ unsigned xb_xcc_id() { return (unsigned)__builtin_amdgcn_s_getreg((3 << 11) | 20) & 0xFu; }
#define XB_SPIN(cond, bar) do { unsigned _sp = 0; while (cond) { __builtin_amdgcn_s_sleep(1); \
    if ((++_sp & 255u) == 0u) { if (xb_ld(&(bar)[XB_TMO])) break; if (_sp > XB_SPIN_CAP) { atomicAdd(&(bar)[XB_TMO], 1u); break; } } } } while (0)

struct XcdBarrier {
    unsigned* bar; unsigned x;
    volatile LAS unsigned* st;
};

__device__ __forceinline__ XcdBarrier xcd_barrier_post(unsigned* bar, volatile LAS unsigned* st) {
    XcdBarrier b; b.bar = bar; b.x = xb_xcc_id(); b.st = st;
    if (threadIdx.x == 0) (void)xb_add(&bar[XB_XCNT(b.x)], 1u);
    return b;
}
__device__ __forceinline__ void xcd_barrier_complete(unsigned* bar, unsigned x, unsigned& nloc, unsigned& nx) {
    const unsigned G = gridDim.x * gridDim.y * gridDim.z;
    unsigned sum, cnt, mine, sp = 0u;
    for (;;) {
        sum = 0u; cnt = 0u; mine = 0u;
#pragma unroll
        for (unsigned j = 0; j < 16; ++j) { const unsigned c = xb_ld(&bar[XB_XCNT(j)]); sum += c; cnt += (c > 0u) ? 1u : 0u; mine = (j == x) ? c : mine; }
        if (sum == G) break;
        __builtin_amdgcn_s_sleep(1);
        if ((++sp & 255u) == 0u) { if (xb_ld(&bar[XB_TMO])) break; if (sp > XB_SPIN_CAP) { atomicAdd(&bar[XB_TMO], 1u); break; } }
    }
    nloc = mine > 0u ? mine : 1u; nx = cnt > 0u ? cnt : 1u;
}

__device__ __forceinline__ void xcd_barrier(const XcdBarrier& b) {
    asm volatile("s_waitcnt vmcnt(0)" ::: "memory");
    __syncthreads();
    if (threadIdx.x == 0) {
        unsigned* bar = b.bar;
        __builtin_amdgcn_s_waitcnt(0);
        unsigned nloc = b.st[0], nx = b.st[1];
        if (nloc == 0u) { xcd_barrier_complete(bar, b.x, nloc, nx); b.st[0] = nloc; b.st[1] = nx; }
        const unsigned old = xb_add(&bar[XB_XSUB(b.x)], 1u);
        const unsigned gen = old / nloc;
        if (old + 1u == (gen + 1u) * nloc) {
            __builtin_amdgcn_fence(__ATOMIC_RELEASE, "agent");
            asm volatile("s_waitcnt vmcnt(0)" ::: "memory");
            const unsigned og = xb_add(&bar[XB_TOP], 1u);
            const unsigned tg = og / nx;
            if (og + 1u == (tg + 1u) * nx) xb_add(&bar[XB_TOPGEN], 1u);
            else XB_SPIN(xb_ld(&bar[XB_TOPGEN]) == tg, bar);
            __builtin_amdgcn_fence(__ATOMIC_ACQUIRE, "agent");
            xb_add(&bar[XB_XGEN(b.x)], 1u);
            asm volatile("s_waitcnt vmcnt(0)" ::: "memory");
        } else {
            XB_SPIN(xb_ld(&bar[XB_XGEN(b.x)]) == gen, bar);
            __builtin_amdgcn_fence(__ATOMIC_ACQUIRE, "agent");
            asm volatile("s_waitcnt vmcnt(0)" ::: "memory");
        }
    }
    __syncthreads();
}
typedef float f32x2_pair __attribute__((ext_vector_type(2)));

constexpr int NWAVES = 8;
constexpr int DM = 1024, FF = 4096, NIN = 9216;
constexpr int MP = 65536, MS = 1024, M = MP + MS;
constexpr int PAST = 4096;
constexpr size_t MiB = 1u << 20;
constexpr size_t REG_E = (size_t)M * DM;
constexpr size_t WS_CTL = 0, CTL_ZERO_BYTES = 1 * MiB;
constexpr size_t WS_WIN = 2 * MiB, WS_WOUT = 20 * MiB, WS_WUP = 22 * MiB, WS_WDN = 30 * MiB;
constexpr size_t WS_ROPE = 38 * MiB;
constexpr size_t WS_SSQ = 43 * MiB;
constexpr size_t WS_RSS = 48 * MiB;
constexpr size_t WS_XN = 54 * MiB;
constexpr size_t WS_R = 184 * MiB;
constexpr size_t WS_END = WS_R + 9 * REG_E * 2;
static_assert(WS_ROPE + (size_t)4128 * 128 * 8 <= WS_SSQ && WS_SSQ + (size_t)M * 64 <= WS_RSS && WS_RSS + (size_t)M * 64 <= WS_XN && WS_XN + REG_E * 2 <= WS_R, "ws map");
constexpr size_t O_Y = 0, O_KP = 68157440, O_VP = 135266304, O_SP = 202375168, O_KS = 206569472, O_VS = 207618048, O_SS = 208666624, O_END = 217055232;
constexpr int CW_BAR = 4096;
constexpr int RING_BYTES = 131072, XCH_OFF = RING_BYTES + 512, MISC_OFF = 163840 - 256, LDS_BYTES = 163840;
static_assert(XCH_OFF + 8192 <= MISC_OFF && MISC_OFF + 64 <= LDS_BYTES, "LDS map");

typedef short s16x4 __attribute__((ext_vector_type(4)));
typedef unsigned v2u __attribute__((ext_vector_type(2)));
#define DI __device__ __forceinline__
#define MFMA16(a, b, c) __builtin_amdgcn_mfma_f32_16x16x32_bf16((a), (b), (c), 0, 0, 0)
#define LBAR() do { asm volatile("s_waitcnt lgkmcnt(0)" ::: "memory"); __builtin_amdgcn_s_barrier(); asm volatile("" ::: "memory"); } while (0)
typedef short v4i16_t __attribute__((ext_vector_type(4)));
DI s16x4 trd(const LAS unsigned char* p) { return __builtin_bit_cast(s16x4, __builtin_amdgcn_ds_read_tr16_b64_v4i16((LAS v4i16_t*)p)); }
DI bf16x8 cat8(s16x4 lo, s16x4 hi) { return (bf16x8){lo[0], lo[1], lo[2], lo[3], hi[0], hi[1], hi[2], hi[3]}; }
DI float bflo(unsigned u) { return __uint_as_float(u << 16); }
DI float bfhi(unsigned u) { return __uint_as_float(u & 0xffff0000u); }
using pg8::cvtpk;
DI float wave_sum(float v) {
#pragma unroll
    for (int o = 1; o < 64; o <<= 1) v += __shfl_xor(v, o);
    return v;
}
constexpr float LOG2E = 1.4426950408889634f, LN2 = 0.6931471805599453f;

struct Args {
    const float *xp, *xs, *ck, *cv, *st, *nmix, *win, *rnw, *qnw, *knw, *wout, *nmlp, *wup, *wdn;
    float* out; unsigned char* ws;
};

DI int colpos(int n) { return (n & ~255) | (((n >> 5) & 1) << 7) | (((n >> 6) & 3) << 5) | (n & 31); }
DI void p0_transpose_item(const float* W, int K, int N, bf16* WT, const float* ksc, int pfrom, LAS float* scr, int item, int lane) {
    const int nblk = N / 32, kb = item / nblk, nb = item % nblk, k0 = 64 * kb, n0 = 32 * nb;
#pragma unroll 8
    for (int i = 0; i < 32; ++i) { const int kk = 2 * i + (lane >> 5); float v = W[(size_t)(k0 + kk) * N + n0 + (lane & 31)]; if (ksc) v *= ksc[k0 + kk]; scr[kk * 33 + (lane & 31)] = v; }
    LDS_WAIT(); asm volatile("" ::: "memory");
    const int c = lane & 7;
#pragma unroll
    for (int j = 0; j < 4; ++j) { const int n = (lane >> 3) + 8 * j; const LAS float* s = scr + (8 * c) * 33 + n;
        v4u o; o.x = cvtpk(s[0 * 33], s[1 * 33]); o.y = cvtpk(s[2 * 33], s[3 * 33]); o.z = cvtpk(s[4 * 33], s[5 * 33]); o.w = cvtpk(s[6 * 33], s[7 * 33]);
        const int nn = n0 + n, np = (nn >= pfrom) ? colpos(nn) : nn;
        *(GAS v4u*)(WT + (size_t)np * K + k0 + 8 * c) = o; }
    LDS_WAIT(); asm volatile("" ::: "memory");
}
DI void p0_prologue(const Args& a, LAS unsigned char* lds, int vcu, int G, int wave, int lane) {
    unsigned char* ws = a.ws;
    LAS float* scr = (LAS float*)(lds + wave * 16384);
    const int gw = vcu * NWAVES + wave, NGW = G * NWAVES;
    constexpr int I_IN = (DM / 64) * (NIN / 32), I_O = (DM / 64) * (DM / 32), I_U = (DM / 64) * (FF / 32), I_D = (FF / 64) * (DM / 32);
    constexpr int NITEMS = I_IN + I_O + I_U + I_D;
    for (int it = gw; it < NITEMS; it += NGW) {
        int r = it;
        if (r < I_IN) { p0_transpose_item(a.win, DM, NIN, (bf16*)(ws + WS_WIN), nullptr, 2048, scr, r, lane); continue; } r -= I_IN;
        if (r < I_O) { p0_transpose_item(a.wout, DM, DM, (bf16*)(ws + WS_WOUT), nullptr, 0, scr, r, lane); continue; } r -= I_O;
        if (r < I_U) { p0_transpose_item(a.wup, DM, FF, (bf16*)(ws + WS_WUP), a.nmlp, 0, scr, r, lane); continue; } r -= I_U;
        p0_transpose_item(a.wdn, FF, DM, (bf16*)(ws + WS_WDN), nullptr, 0, scr, r, lane);
    }
    {
        f32x4 wv[4];
#pragma unroll
        for (int j = 0; j < 4; ++j) wv[j] = ((const GAS f32x4*)a.nmix)[lane + 64 * j];
        bf16* XN = (bf16*)(ws + WS_XN);
        for (int m = gw; m < M; m += NGW) {
            const float* xrow = (m < MP) ? a.xp + (size_t)m * DM : a.xs + (size_t)(m - MP) * DM;
            const GAS f32x4* xr = (const GAS f32x4*)xrow + lane;
            f32x4 v[4]; float s = 0.f;
#pragma unroll
            for (int j = 0; j < 4; ++j) { v[j] = __builtin_nontemporal_load(&xr[64 * j]); s += (v[j].x * v[j].x + v[j].y * v[j].y) + (v[j].z * v[j].z + v[j].w * v[j].w); }
            const float rstd = 1.0f / sqrtf(wave_sum(s) * (1.0f / DM) + 1e-6f);
            GAS v2u* o8 = (GAS v2u*)(XN + (size_t)m * DM) + lane;
#pragma unroll
            for (int j = 0; j < 4; ++j) { const f32x4 y = v[j] * rstd * wv[j]; v2u o; o.x = cvtpk(y.x, y.y); o.y = cvtpk(y.z, y.w); __builtin_nontemporal_store(o, &o8[64 * j]); }
        }
    }
    {
        float* rope = (float*)(ws + WS_ROPE);
        for (int idx = gw * 64 + lane; idx < 4128 * 128; idx += NGW * 64) {
            const int pos = idx >> 7, j = idx & 127;
            const float inv = powf(10000.0f, -(float)j * (1.0f / 128.0f));
            const float ang = (float)pos * inv;
            float sn, cs; sincosf(ang, &sn, &cs);
            *(GAS f32x2_pair*)(rope + (size_t)idx * 2) = (f32x2_pair){cs, sn};
        }
    }
}

constexpr int RT_QS = 0, RT_KS = 33792, RT_VS = 67584, RT_VDS = 76800, RT_PS = 86016, RT_STS = 95232, RT_RXS = 129024;
static_assert(RT_RXS + 1024 <= RING_BYTES, "retention LDS map");
template <bool SAMPLE>
DI void ret_unit(const Args& a, LAS unsigned char* L, int b, int h, int s, int tid, int lane, int w) {
    const int c15 = lane & 15, g = lane >> 4, q4 = c15 >> 2, p4 = c15 & 3;
    constexpr int Lc = SAMPLE ? 32 : 64, NSTEP = SAMPLE ? 1 : 64;
    const float lg2 = log2f(1.0f - exp2f(-5.0f - (float)h));
    const size_t rowbase = SAMPLE ? (size_t)MP + 32 * b : (size_t)4096 * b;
    const bf16* RQ = (const bf16*)(a.ws + WS_R), *RK = RQ + REG_E, *RV = RQ + 2 * REG_E;
    bf16* ORET = (bf16*)(a.ws + WS_XN);
    float* RSS = (float*)(a.ws + WS_RSS);
    f32x4 S[2][4];
    const size_t sbase = ((size_t)(b * 4 + h) * 256) * 256 + 64 * s;
    {
        const float* sp0 = a.st + sbase + (size_t)(128 * (w & 1) + 32 * (w >> 1) + 4 * g) * 256 + c15;
#pragma unroll
        for (int k2 = 0; k2 < 2; ++k2)
#pragma unroll
            for (int dt = 0; dt < 4; ++dt)
#pragma unroll
                for (int r = 0; r < 4; ++r) S[k2][dt][r] = SAMPLE ? sp0[(16 * k2 + r) * 256 + 16 * dt] : 0.f;
    }
    v4u pq[4], pk[4], pv;
    const int vrow = tid >> 3, vpc = tid & 7;
#define RT_LOAD(c) do { \
        _Pragma("unroll") for (int p_ = 0; p_ < 4; ++p_) { const int idx_ = tid + 512 * p_, row_ = idx_ >> 5, pc_ = idx_ & 31; \
            if (!SAMPLE || row_ < 32) { const size_t go_ = (rowbase + (size_t)64 * (c) + row_) * 1024 + 256 * h + 8 * pc_; pq[p_] = *(const GAS v4u*)(RQ + go_); pk[p_] = *(const GAS v4u*)(RK + go_); } \
            else { pq[p_] = (v4u){0u, 0u, 0u, 0u}; pk[p_] = (v4u){0u, 0u, 0u, 0u}; } } \
        if (!SAMPLE || vrow < 32) pv = *(const GAS v4u*)(RV + (rowbase + (size_t)64 * (c) + vrow) * 1024 + 256 * h + 64 * s + 8 * vpc); else pv = (v4u){0u, 0u, 0u, 0u}; } while (0)
#define RT_WRITE() do { \
        _Pragma("unroll") for (int p_ = 0; p_ < 4; ++p_) { const int idx_ = tid + 512 * p_, row_ = idx_ >> 5, pc_ = idx_ & 31; \
            *(LAS v4u*)(L + RT_QS + row_ * 528 + pc_ * 16) = pq[p_]; *(LAS v4u*)(L + RT_KS + row_ * 528 + pc_ * 16) = pk[p_]; } \
        *(LAS v4u*)(L + RT_VS + vrow * 144 + vpc * 16) = pv; \
        { const float kd_ = exp2f(lg2 * (float)(Lc - 1 - vrow)); v4u d_; \
          d_.x = cvtpk(bflo(pv.x) * kd_, bfhi(pv.x) * kd_); d_.y = cvtpk(bflo(pv.y) * kd_, bfhi(pv.y) * kd_); d_.z = cvtpk(bflo(pv.z) * kd_, bfhi(pv.z) * kd_); d_.w = cvtpk(bflo(pv.w) * kd_, bfhi(pv.w) * kd_); \
          *(LAS v4u*)(L + RT_VDS + vrow * 144 + vpc * 16) = d_; } } while (0)
    RT_LOAD(0); RT_WRITE();
    const int jt = w >> 1, itp = w & 1, dto = w >> 1;
    const float gL = exp2f(lg2 * (float)Lc);
    for (int c = 0; c < NSTEP; ++c) {
        LBAR();
        if (c + 1 < NSTEP) RT_LOAD(c + 1);
        bf16x8 bq[2][8];
        {
            f32x4 sc[2] = {(f32x4){0.f, 0.f, 0.f, 0.f}, (f32x4){0.f, 0.f, 0.f, 0.f}};
            const LAS unsigned char* kp = L + RT_KS + (16 * jt + c15) * 528 + g * 16;
            const LAS unsigned char* qp = L + RT_QS + (32 * itp + c15) * 528 + g * 16;
#pragma unroll
            for (int ks = 0; ks < 8; ++ks) {
                const bf16x8 ak = *(const LAS bf16x8*)(kp + ks * 64);
                bq[0][ks] = *(const LAS bf16x8*)(qp + ks * 64); bq[1][ks] = *(const LAS bf16x8*)(qp + 16 * 528 + ks * 64);
                sc[0] = MFMA16(ak, bq[0][ks], sc[0]); sc[1] = MFMA16(ak, bq[1][ks], sc[1]);
            }
#pragma unroll
            for (int t = 0; t < 2; ++t) {
                const int i = 32 * itp + 16 * t + c15, j0 = 16 * jt + 4 * g;
                float p[4];
#pragma unroll
                for (int r = 0; r < 4; ++r) { const int d = i - (j0 + r); p[r] = sc[t][r] * exp2f(lg2 * (float)(d < 0 ? -d : d)); }
                v2u o; o.x = cvtpk(p[0], p[1]); o.y = cvtpk(p[2], p[3]);
                *(LAS v2u*)(L + RT_PS + i * 144 + j0 * 2) = o;
            }
        }
#pragma unroll
        for (int k2 = 0; k2 < 2; ++k2)
#pragma unroll
            for (int dt = 0; dt < 4; ++dt) { v2u o; o.x = cvtpk(S[k2][dt][0], S[k2][dt][1]); o.y = cvtpk(S[k2][dt][2], S[k2][dt][3]);
                *(LAS v2u*)(L + RT_STS + (16 * dt + c15) * 528 + (16 * (2 * w + k2) + 4 * g) * 2) = o; }
        LBAR();
        {
            f32x4 oc[2] = {(f32x4){0.f, 0.f, 0.f, 0.f}, (f32x4){0.f, 0.f, 0.f, 0.f}};
            const LAS unsigned char* sp = L + RT_STS + (16 * dto + c15) * 528 + g * 16;
#pragma unroll
            for (int ks = 0; ks < 8; ++ks) { const bf16x8 as = *(const LAS bf16x8*)(sp + ks * 64); oc[0] = MFMA16(as, bq[0][ks], oc[0]); oc[1] = MFMA16(as, bq[1][ks], oc[1]); }
#pragma unroll
            for (int t = 0; t < 2; ++t) { const int i = 32 * itp + 16 * t + c15; oc[t] = oc[t] * exp2f(lg2 * (float)(i + 1)); }
#pragma unroll
            for (int k2 = 0; k2 < 2; ++k2) {
                const LAS unsigned char* vp = L + RT_VS + (32 * k2 + 8 * g + q4) * 144 + (16 * dto + 4 * p4) * 2;
                const bf16x8 av = cat8(trd(vp), trd(vp + 4 * 144));
#pragma unroll
                for (int t = 0; t < 2; ++t) { const int i = 32 * itp + 16 * t + c15;
                    const bf16x8 bp = *(const LAS bf16x8*)(L + RT_PS + i * 144 + (32 * k2 + 8 * g) * 2); oc[t] = MFMA16(av, bp, oc[t]); }
            }
#pragma unroll
            for (int t = 0; t < 2; ++t) {
                const int i = 32 * itp + 16 * t + c15;
                float ss = (oc[t][0] * oc[t][0] + oc[t][1] * oc[t][1]) + (oc[t][2] * oc[t][2] + oc[t][3] * oc[t][3]);
                ss += __shfl_xor(ss, 16); ss += __shfl_xor(ss, 32);
                if (g == 0) ((LAS float*)(L + RT_RXS))[dto * 64 + i] = ss;
                if (!SAMPLE || i < 32) { v2u o; o.x = cvtpk(oc[t][0], oc[t][1]); o.y = cvtpk(oc[t][2], oc[t][3]);
                    __builtin_nontemporal_store(o, (GAS v2u*)(ORET + (rowbase + (size_t)64 * c + i) * 1024 + 256 * h + 64 * s + 16 * dto + 4 * g)); }
            }
        }
#pragma unroll
        for (int k2 = 0; k2 < 2; ++k2)
#pragma unroll
            for (int dt = 0; dt < 4; ++dt) S[k2][dt] = S[k2][dt] * gL;
#pragma unroll
        for (int ks = 0; ks < 2; ++ks) {
            const int tok = 32 * ks + 8 * g + q4;
            bf16x8 ak[2];
#pragma unroll
            for (int k2 = 0; k2 < 2; ++k2) { const LAS unsigned char* kp = L + RT_KS + tok * 528 + (16 * (2 * w + k2) + 4 * p4) * 2; ak[k2] = cat8(trd(kp), trd(kp + 4 * 528)); }
#pragma unroll
            for (int dt = 0; dt < 4; ++dt) { const LAS unsigned char* vp = L + RT_VDS + tok * 144 + (16 * dt + 4 * p4) * 2; const bf16x8 bv = cat8(trd(vp), trd(vp + 4 * 144));
                S[0][dt] = MFMA16(ak[0], bv, S[0][dt]); S[1][dt] = MFMA16(ak[1], bv, S[1][dt]); }
        }
        LBAR();
        if (tid < 64 && (!SAMPLE || tid < 32)) { const LAS float* rx = (const LAS float*)(L + RT_RXS);
            RSS[(rowbase + (size_t)64 * c + tid) * 16 + h * 4 + s] = (rx[tid] + rx[64 + tid]) + (rx[128 + tid] + rx[192 + tid]); }
        if (c + 1 < NSTEP) RT_WRITE();
    }
    {
        int ln = lane; asm volatile("" : "+v"(ln));
        float* so = a.out + (SAMPLE ? O_SS : O_SP) + sbase + (size_t)(128 * (w & 1) + 32 * (w >> 1) + 4 * (ln >> 4)) * 256 + (ln & 15);
#pragma unroll
        for (int k2 = 0; k2 < 2; ++k2)
#pragma unroll
            for (int dt = 0; dt < 4; ++dt)
#pragma unroll
                for (int r = 0; r < 4; ++r) so[(16 * k2 + r) * 256 + 16 * dt] = S[k2][dt][r];
    }
    LBAR();
#undef RT_LOAD
#undef RT_WRITE
}

constexpr int SB_KS = 0, SB_KT = 17408, SB_VS = 52224, SB_VT = 18432, SB_FLAGS = 107520, SB_OS = 0, SB_OSW = 8448;
static_assert(SB_KS + 3 * SB_KT <= SB_VS && SB_VS + 3 * SB_VT <= SB_FLAGS && SB_OS + 8 * SB_OSW <= SB_FLAGS && SB_FLAGS + 64 <= RING_BYTES, "SB LDS map");
constexpr float SB_EXIT = 40.0f * 1.4426950408889634f;
template <bool MASKED>
DI void sb_tile(const LAS unsigned char* kb, const LAS unsigned char* vb, const bf16x8 (&bq)[4], const bf16x8 acs, const bf16x8 ones, int key0, int qpos, float& carry, f32x4 (&oacc)[8]) {
    f32x4 z[4];
#pragma unroll
    for (int j = 0; j < 4; ++j) z[j] = (f32x4){0.f, 0.f, 0.f, 0.f};
    {
        bf16x8 ak[2][4];
#pragma unroll
        for (int j = 0; j < 4; ++j) ak[0][j] = *(const LAS bf16x8*)(kb + j * 16 * 272);
#pragma unroll
        for (int ks = 0; ks < 4; ++ks) {
            if (ks < 3) {
#pragma unroll
                for (int j = 0; j < 4; ++j) ak[(ks + 1) & 1][j] = *(const LAS bf16x8*)(kb + j * 16 * 272 + (ks + 1) * 64);
            }
            __builtin_amdgcn_sched_barrier(0);
#pragma unroll
            for (int j = 0; j < 4; ++j) z[j] = MFMA16(ak[ks & 1][j], bq[ks], z[j]);
            __builtin_amdgcn_sched_barrier(0);
        }
    }
    float s[4][4], t[4];
#pragma unroll
    for (int j = 0; j < 4; ++j) {
        float v[4];
#pragma unroll
        for (int r = 0; r < 4; ++r) { const float zz = fminf(z[j][r], 100.0f); z[j][r] = zz; float vv = __builtin_amdgcn_logf(1.0f + __builtin_amdgcn_exp2f(zz));
            if (MASKED) vv = (key0 + 16 * j + r < qpos) ? vv : 0.f;
            v[r] = vv; }
        s[j][3] = v[3]; s[j][2] = v[3] + v[2]; s[j][1] = s[j][2] + v[1]; s[j][0] = s[j][1] + v[0]; t[j] = s[j][0];
    }
    const unsigned h01 = cvtpk(t[0], t[1]), h23 = cvtpk(t[2], t[3]);
    const unsigned l01 = cvtpk(t[0] - bflo(h01), t[1] - bfhi(h01)), l23 = cvtpk(t[2] - bflo(h23), t[3] - bfhi(h23));
    const bf16x8 bt = __builtin_bit_cast(bf16x8, (v4u){h01, h23, l01, l23});
    const f32x4 zero4 = (f32x4){0.f, 0.f, 0.f, 0.f};
    const f32x4 E = MFMA16(acs, bt, zero4), TOT = MFMA16(ones, bt, zero4);
    unsigned wp[4][2];
#pragma unroll
    for (int j = 0; j < 4; ++j) { const float ec = E[j] + carry; float wv[4];
#pragma unroll
        for (int r = 0; r < 4; ++r) { float ex = __builtin_amdgcn_exp2f((z[j][r] - s[j][r]) - ec); if (MASKED) ex = (key0 + 16 * j + r < qpos) ? ex : 0.f; wv[r] = ex; }
        wp[j][0] = cvtpk(wv[0], wv[1]); wp[j][1] = cvtpk(wv[2], wv[3]); }
    carry += TOT[0];
#pragma unroll
    for (int k2 = 0; k2 < 2; ++k2) { const bf16x8 bw = __builtin_bit_cast(bf16x8, (v4u){wp[2 * k2][0], wp[2 * k2][1], wp[2 * k2 + 1][0], wp[2 * k2 + 1][1]});
#pragma unroll
        for (int dt = 0; dt < 8; ++dt) { const bf16x8 av = cat8(trd(vb + (32 * k2) * 288 + dt * 32), trd(vb + (32 * k2 + 16) * 288 + dt * 32)); oacc[dt] = MFMA16(av, bw, oacc[dt]); } }
}
template <bool SAMPLE>
DI void sb_unit(const Args& a, LAS unsigned char* L, int b, int h, int qb, int tid, int lane, int w) {
    const int c15 = lane & 15, g = lane >> 4, q4 = c15 >> 2, p4 = c15 & 3;
    const bf16* R0 = (const bf16*)(a.ws + WS_R);
    const bf16 *RG = R0 + 3 * REG_E, *SQ = R0 + 4 * REG_E, *SK = R0 + 5 * REG_E, *SV = R0 + 6 * REG_E, *GA = R0 + 7 * REG_E, *GB = R0 + 8 * REG_E;
    const bf16* ORET = (const bf16*)(a.ws + WS_XN);
    bf16* MIX = (bf16*)(a.ws + WS_R);
    const float* RSS = (const float*)(a.ws + WS_RSS);
    const bool wvalid = SAMPLE ? (w < 2) : true;
    const int qwbase = SAMPLE ? PAST + 16 * w : 128 * qb + 16 * w;
    const int qpos = qwbase + c15;
    const size_t wrow0 = SAMPLE ? (size_t)MP + 32 * b + 16 * w : (size_t)4096 * b + qwbase;
    bf16x8 bq[4];
#pragma unroll
    for (int ks = 0; ks < 4; ++ks) bq[ks] = wvalid ? *(const GAS bf16x8*)(SQ + (wrow0 + c15) * 1024 + 128 * h + 32 * ks + 8 * g) : (bf16x8){0, 0, 0, 0, 0, 0, 0, 0};
    bf16x8 ones, acs;
#pragma unroll
    for (int e = 0; e < 8; ++e) { ones[e] = (short)0x3f80; acs[e] = (4 * (e & 3) + g > 4 * (c15 & 3) + (c15 >> 2)) ? (short)0x3f80 : (short)0; }
    const int T0 = SAMPLE ? 64 : 2 * qb + 1;
    float carry = 0.f;
    f32x4 oacc[8];
#pragma unroll
    for (int dt = 0; dt < 8; ++dt) oacc[dt] = (f32x4){0.f, 0.f, 0.f, 0.f};
    const int kl0 = tid >> 4, dp = tid & 15;
    v4u tk[2][2], tv[2][2]; f32x4 fk[2][2][2], fv[2][2][2];
#define SB_LOAD(S_, T_) do { _Pragma("unroll") for (int p_ = 0; p_ < 2; ++p_) { const int kl_ = kl0 + 32 * p_; \
        if (!SAMPLE) { const size_t go_ = ((size_t)4096 * b + 64 * (T_) + kl_) * 1024 + 128 * h + 8 * dp; tk[S_][p_] = *(const GAS v4u*)(SK + go_); tv[S_][p_] = *(const GAS v4u*)(SV + go_); } \
        else { const size_t go_ = (((size_t)b * 4096 + 64 * (T_) + kl_) * 8 + h) * 128 + 8 * dp; \
            fk[S_][p_][0] = __builtin_nontemporal_load((const GAS f32x4*)(a.ck + go_)); fk[S_][p_][1] = __builtin_nontemporal_load((const GAS f32x4*)(a.ck + go_ + 4)); fv[S_][p_][0] = __builtin_nontemporal_load((const GAS f32x4*)(a.cv + go_)); fv[S_][p_][1] = __builtin_nontemporal_load((const GAS f32x4*)(a.cv + go_ + 4)); } } } while (0)
#define SB_PARK(S_, B_) do { _Pragma("unroll") for (int p_ = 0; p_ < 2; ++p_) { const int kl_ = kl0 + 32 * p_; \
        if (SAMPLE) { tk[S_][p_] = (v4u){cvtpk(fk[S_][p_][0][0], fk[S_][p_][0][1]), cvtpk(fk[S_][p_][0][2], fk[S_][p_][0][3]), cvtpk(fk[S_][p_][1][0], fk[S_][p_][1][1]), cvtpk(fk[S_][p_][1][2], fk[S_][p_][1][3])}; \
            tv[S_][p_] = (v4u){cvtpk(fv[S_][p_][0][0], fv[S_][p_][0][1]), cvtpk(fv[S_][p_][0][2], fv[S_][p_][0][3]), cvtpk(fv[S_][p_][1][0], fv[S_][p_][1][1]), cvtpk(fv[S_][p_][1][2], fv[S_][p_][1][3])}; } \
        *(LAS v4u*)(L + SB_KS + (B_) * SB_KT + kl_ * 272 + dp * 16) = tk[S_][p_]; *(LAS v4u*)(L + SB_VS + (B_) * SB_VT + kl_ * 288 + dp * 16) = tv[S_][p_]; } } while (0)
    {
#pragma unroll
        for (int p = 0; p < 2; ++p) { const int kl = kl0 + 32 * p; v4u k0, v0;
            if (!SAMPLE) { const size_t go = ((size_t)4096 * b + 64 * T0 + kl) * 1024 + 128 * h + 8 * dp; k0 = *(const GAS v4u*)(SK + go); v0 = *(const GAS v4u*)(SV + go); }
            else if (kl < 32) { const size_t go = ((size_t)MP + 32 * b + kl) * 1024 + 128 * h + 8 * dp; k0 = *(const GAS v4u*)(SK + go); v0 = *(const GAS v4u*)(SV + go); }
            else { k0 = (v4u){0u, 0u, 0u, 0u}; v0 = (v4u){0u, 0u, 0u, 0u}; }
            *(LAS v4u*)(L + SB_KS + kl * 272 + dp * 16) = k0; *(LAS v4u*)(L + SB_VS + kl * 288 + dp * 16) = v0; }
    }
    if (T0 >= 1) SB_LOAD(0, T0 - 1);
    if (T0 >= 2) SB_LOAD(1, T0 - 2);
    int buf = 0;
    for (int it = 0;; ++it) {
        const int T = T0 - it; const int nb = (buf == 2) ? 0 : buf + 1;
        LBAR();
        if (it > 0) { const LAS unsigned* fl = (const LAS unsigned*)(L + SB_FLAGS) + 8 * ((it - 1) & 1);
            const unsigned any = (fl[0] | fl[1]) | (fl[2] | fl[3]) | (fl[4] | fl[5]) | (fl[6] | fl[7]);
            if (__builtin_amdgcn_readfirstlane(any) == 0u) break; }
        if (T > 0) {
            if (it & 1) { SB_PARK(1, nb); if (T >= 3) SB_LOAD(1, T - 3); }
            else        { SB_PARK(0, nb); if (T >= 3) SB_LOAD(0, T - 3); }
        }
        const bool alive = wvalid && (__ballot(carry < SB_EXIT) != 0ull);
        if (alive && 64 * T < qwbase + 16) {
            const LAS unsigned char* kb = L + SB_KS + buf * SB_KT + c15 * 272 + g * 16;
            const LAS unsigned char* vb = L + SB_VS + buf * SB_VT + (4 * g + q4) * 288 + 8 * p4;
            if (64 * T + 63 < qwbase) sb_tile<false>(kb, vb, bq, acs, ones, 64 * T + 4 * g, qpos, carry, oacc);
            else sb_tile<true>(kb, vb, bq, acs, ones, 64 * T + 4 * g, qpos, carry, oacc);
        }
        { const bool more = wvalid && (carry < SB_EXIT); const unsigned long long bal = __ballot(more);
          if (lane == 0) ((LAS unsigned*)(L + SB_FLAGS))[8 * (it & 1) + w] = (bal != 0ull) ? 1u : 0u; }
        if (T == 0) break;
        buf = nb;
    }
#undef SB_LOAD
#undef SB_PARK
    LBAR();
    if (wvalid) {
        LAS unsigned char* os = L + SB_OS + w * SB_OSW;
#pragma unroll
        for (int dt = 0; dt < 8; ++dt) *(LAS f32x4*)(os + c15 * 528 + (16 * dt + 4 * g) * 4) = oacc[dt];
        const int hr = h >> 1, ch = lane & 15, col = 128 * h + 8 * ch;
        const f32x4 rw0 = *(const f32x4*)(a.rnw + 256 * hr + (col & 255)), rw1 = *(const f32x4*)(a.rnw + 256 * hr + (col & 255) + 4);
        v4u orr[4], rg[4], ga[4], gb[4]; f32x4 rs[4];
#pragma unroll
        for (int k = 0; k < 4; ++k) { const size_t row = wrow0 + 4 * k + (lane >> 4), go = row * 1024 + col;
            orr[k] = *(const GAS v4u*)(ORET + go); rg[k] = *(const GAS v4u*)(RG + go); ga[k] = *(const GAS v4u*)(GA + go); gb[k] = *(const GAS v4u*)(GB + go);
            rs[k] = *(const GAS f32x4*)(RSS + row * 16 + hr * 4); }
        asm volatile("s_waitcnt lgkmcnt(0)" ::: "memory");
#pragma unroll
        for (int k = 0; k < 4; ++k) {
            const int r = 4 * k + (lane >> 4);
            const f32x4 o0 = *(const LAS f32x4*)(os + r * 528 + ch * 32), o1 = *(const LAS f32x4*)(os + r * 528 + ch * 32 + 16);
            const float rstd = 1.0f / sqrtf(((rs[k][0] + rs[k][1]) + (rs[k][2] + rs[k][3])) * (1.0f / 256.0f) + 1e-6f);
            v4u mo;
            mo.x = cvtpk(bflo(ga[k].x) * (bflo(orr[k].x) * rstd * rw0[0] * bflo(rg[k].x)) + bflo(gb[k].x) * o0[0], bfhi(ga[k].x) * (bfhi(orr[k].x) * rstd * rw0[1] * bfhi(rg[k].x)) + bfhi(gb[k].x) * o0[1]);
            mo.y = cvtpk(bflo(ga[k].y) * (bflo(orr[k].y) * rstd * rw0[2] * bflo(rg[k].y)) + bflo(gb[k].y) * o0[2], bfhi(ga[k].y) * (bfhi(orr[k].y) * rstd * rw0[3] * bfhi(rg[k].y)) + bfhi(gb[k].y) * o0[3]);
            mo.z = cvtpk(bflo(ga[k].z) * (bflo(orr[k].z) * rstd * rw1[0] * bflo(rg[k].z)) + bflo(gb[k].z) * o1[0], bfhi(ga[k].z) * (bfhi(orr[k].z) * rstd * rw1[1] * bfhi(rg[k].z)) + bfhi(gb[k].z) * o1[1]);
            mo.w = cvtpk(bflo(ga[k].w) * (bflo(orr[k].w) * rstd * rw1[2] * bflo(rg[k].w)) + bflo(gb[k].w) * o1[2], bfhi(ga[k].w) * (bfhi(orr[k].w) * rstd * rw1[3] * bfhi(rg[k].w)) + bfhi(gb[k].w) * o1[3]);
            __builtin_nontemporal_store(mo, (GAS v4u*)(MIX + (wrow0 + r) * 1024 + col));
        }
    }
    LBAR();
}

constexpr int SW_SLOT = 35840, SW_KOFF = 0, SW_VOFF = 17408, SW_FLAGS = 4 * SW_SLOT;
static_assert(SW_FLAGS + 64 <= MISC_OFF && 2 * SW_SLOT >= 8 * SB_OSW, "SB stream LDS map");
DI void sw_fill(LAS unsigned char* L, const bf16* SK, const bf16* SV, size_t rowb, int h, int T, int tid) {
    const int kl0 = tid >> 4, dp = tid & 15; LAS unsigned char* sl = L + (T & 3) * SW_SLOT;
#pragma unroll
    for (int p = 0; p < 2; ++p) { const int kl = kl0 + 32 * p; const size_t go = (rowb + 64 * T + kl) * 1024 + 128 * h + 8 * dp;
        const v4u k0 = *(const GAS v4u*)(SK + go), v0 = *(const GAS v4u*)(SV + go);
        *(LAS v4u*)(sl + SW_KOFF + kl * 272 + dp * 16) = k0; *(LAS v4u*)(sl + SW_VOFF + kl * 288 + dp * 16) = v0; }
}
DI void sb_stream(const Args& a, LAS unsigned char* L, int b, int h, int qb0, int tid, int lane, int w) {
    const int c15 = lane & 15, g = lane >> 4, q4 = c15 >> 2, p4 = c15 & 3;
    const bf16* R0 = (const bf16*)(a.ws + WS_R);
    const bf16 *RG = R0 + 3 * REG_E, *SQ = R0 + 4 * REG_E, *SK = R0 + 5 * REG_E, *SV = R0 + 6 * REG_E, *GA = R0 + 7 * REG_E, *GB = R0 + 8 * REG_E;
    const bf16* ORET = (const bf16*)(a.ws + WS_XN);
    bf16* MIX = (bf16*)(a.ws + WS_R);
    const float* RSS = (const float*)(a.ws + WS_RSS);
    const size_t rowb = (size_t)4096 * b;
    bf16x8 ones, acs;
#pragma unroll
    for (int e = 0; e < 8; ++e) { ones[e] = (short)0x3f80; acs[e] = (4 * (e & 3) + g > 4 * (c15 & 3) + (c15 >> 2)) ? (short)0x3f80 : (short)0; }
    const int kl0 = tid >> 4, dp = tid & 15;
    LAS unsigned* flags = (LAS unsigned*)(L + SW_FLAGS);
    for (int T = (2 * qb0 - 2 > 0 ? 2 * qb0 - 2 : 0); T <= 2 * qb0 + 1; ++T) sw_fill(L, SK, SV, rowb, h, T, tid);
    bf16x8 bq[4];
#pragma unroll
    for (int ks = 0; ks < 4; ++ks) bq[ks] = *(const GAS bf16x8*)(SQ + (rowb + 128 * qb0 + 16 * w + c15) * 1024 + 128 * h + 32 * ks + 8 * g);
    asm volatile("s_waitcnt vmcnt(0)" : "+v"(bq[0]), "+v"(bq[1]), "+v"(bq[2]), "+v"(bq[3]) :: "memory");
    for (int qb = qb0; qb < qb0 + 16; ++qb) {
        const int T0 = 2 * qb + 1, qwbase = 128 * qb + 16 * w, qpos = qwbase + c15;
        const bool has_next = (qb + 1 < qb0 + 16);
        LBAR();
        v4u nk[2][2], nv[2][2]; bf16x8 bqn[4];
        if (has_next) {
#pragma unroll
            for (int tt = 0; tt < 2; ++tt)
#pragma unroll
                for (int p = 0; p < 2; ++p) { const size_t go = (rowb + 64 * (T0 + 1 + tt) + kl0 + 32 * p) * 1024 + 128 * h + 8 * dp; nk[tt][p] = __builtin_nontemporal_load((const GAS v4u*)(SK + go)); nv[tt][p] = __builtin_nontemporal_load((const GAS v4u*)(SV + go)); }
#pragma unroll
            for (int ks = 0; ks < 4; ++ks) bqn[ks] = *(const GAS bf16x8*)(SQ + (rowb + 128 * (qb + 1) + 16 * w + c15) * 1024 + 128 * h + 32 * ks + 8 * g);
        }
        float carry = 0.f;
        f32x4 oacc[8];
#pragma unroll
        for (int dt = 0; dt < 8; ++dt) oacc[dt] = (f32x4){0.f, 0.f, 0.f, 0.f};
        const int Tlow = (T0 - 3 > 0) ? T0 - 3 : 0;
        for (int T = T0; T >= Tlow; --T) {
            if (__ballot(carry < SB_EXIT) == 0ull) break;
            if (64 * T < qwbase + 16) {
                const LAS unsigned char* sl = L + (T & 3) * SW_SLOT;
                const LAS unsigned char* kb = sl + SW_KOFF + c15 * 272 + g * 16;
                const LAS unsigned char* vb = sl + SW_VOFF + (4 * g + q4) * 288 + 8 * p4;
                if (64 * T + 63 < qwbase) sb_tile<false>(kb, vb, bq, acs, ones, 64 * T + 4 * g, qpos, carry, oacc);
                else sb_tile<true>(kb, vb, bq, acs, ones, 64 * T + 4 * g, qpos, carry, oacc);
            }
        }
        { const unsigned long long bal = __ballot(carry < SB_EXIT); if (lane == 0) flags[w] = (bal != 0ull) ? 1u : 0u; }
        LBAR();
        {
            unsigned any = (flags[0] | flags[1]) | (flags[2] | flags[3]) | (flags[4] | flags[5]) | (flags[6] | flags[7]);
            if (__builtin_amdgcn_readfirstlane(any) != 0u && Tlow > 0) {
                int T = Tlow - 1;
                for (;;) {
                    LBAR();
                    {   LAS unsigned char* sl = L + (T0 & 3) * SW_SLOT;
#pragma unroll
                        for (int p = 0; p < 2; ++p) { const int kl = kl0 + 32 * p; const size_t go = (rowb + 64 * T + kl) * 1024 + 128 * h + 8 * dp;
                            const v4u k0 = *(const GAS v4u*)(SK + go), v0 = *(const GAS v4u*)(SV + go);
                            *(LAS v4u*)(sl + SW_KOFF + kl * 272 + dp * 16) = k0; *(LAS v4u*)(sl + SW_VOFF + kl * 288 + dp * 16) = v0; } }
                    LBAR();
                    if (__ballot(carry < SB_EXIT) != 0ull) {
                        const LAS unsigned char* sl = L + (T0 & 3) * SW_SLOT;
                        sb_tile<false>(sl + SW_KOFF + c15 * 272 + g * 16, sl + SW_VOFF + (4 * g + q4) * 288 + 8 * p4, bq, acs, ones, 64 * T + 4 * g, qpos, carry, oacc);
                    }
                    { const unsigned long long bal = __ballot(carry < SB_EXIT); if (lane == 0) flags[w] = (bal != 0ull) ? 1u : 0u; }
                    LBAR();
                    any = (flags[0] | flags[1]) | (flags[2] | flags[3]) | (flags[4] | flags[5]) | (flags[6] | flags[7]);
                    if (__builtin_amdgcn_readfirstlane(any) == 0u || T == 0) break;
                    --T;
                }
                LBAR();
                sw_fill(L, SK, SV, rowb, h, T0, tid);
                LBAR();
            }
        }
        {
            LAS unsigned char* os = L + ((T0 - 3) & 2) * SW_SLOT + w * SB_OSW;
#pragma unroll
            for (int dt = 0; dt < 8; ++dt) *(LAS f32x4*)(os + c15 * 528 + (16 * dt + 4 * g) * 4) = oacc[dt];
            const int hr = h >> 1, ch = lane & 15, col = 128 * h + 8 * ch;
            const size_t wrow0 = rowb + qwbase;
            const f32x4 rw0 = *(const f32x4*)(a.rnw + 256 * hr + (col & 255)), rw1 = *(const f32x4*)(a.rnw + 256 * hr + (col & 255) + 4);
            v4u orr[4], rg[4], ga[4], gb[4]; f32x4 rs[4];
#pragma unroll
            for (int k = 0; k < 4; ++k) { const size_t row = wrow0 + 4 * k + (lane >> 4), go = row * 1024 + col;
                orr[k] = __builtin_nontemporal_load((const GAS v4u*)(ORET + go)); rg[k] = __builtin_nontemporal_load((const GAS v4u*)(RG + go)); ga[k] = __builtin_nontemporal_load((const GAS v4u*)(GA + go)); gb[k] = __builtin_nontemporal_load((const GAS v4u*)(GB + go));
                rs[k] = *(const GAS f32x4*)(RSS + row * 16 + hr * 4); }
            asm volatile("s_waitcnt lgkmcnt(0)" ::: "memory");
#pragma unroll
            for (int k = 0; k < 4; ++k) {
                const int r = 4 * k + (lane >> 4);
                const f32x4 o0 = *(const LAS f32x4*)(os + r * 528 + ch * 32), o1 = *(const LAS f32x4*)(os + r * 528 + ch * 32 + 16);
                const float rstd = 1.0f / sqrtf(((rs[k][0] + rs[k][1]) + (rs[k][2] + rs[k][3])) * (1.0f / 256.0f) + 1e-6f);
                v4u mo;
                mo.x = cvtpk(bflo(ga[k].x) * (bflo(orr[k].x) * rstd * rw0[0] * bflo(rg[k].x)) + bflo(gb[k].x) * o0[0], bfhi(ga[k].x) * (bfhi(orr[k].x) * rstd * rw0[1] * bfhi(rg[k].x)) + bfhi(gb[k].x) * o0[1]);
                mo.y = cvtpk(bflo(ga[k].y) * (bflo(orr[k].y) * rstd * rw0[2] * bflo(rg[k].y)) + bflo(gb[k].y) * o0[2], bfhi(ga[k].y) * (bfhi(orr[k].y) * rstd * rw0[3] * bfhi(rg[k].y)) + bfhi(gb[k].y) * o0[3]);
                mo.z = cvtpk(bflo(ga[k].z) * (bflo(orr[k].z) * rstd * rw1[0] * bflo(rg[k].z)) + bflo(gb[k].z) * o1[0], bfhi(ga[k].z) * (bfhi(orr[k].z) * rstd * rw1[1] * bfhi(rg[k].z)) + bfhi(gb[k].z) * o1[1]);
                mo.w = cvtpk(bflo(ga[k].w) * (bflo(orr[k].w) * rstd * rw1[2] * bflo(rg[k].w)) + bflo(gb[k].w) * o1[2], bfhi(ga[k].w) * (bfhi(orr[k].w) * rstd * rw1[3] * bfhi(rg[k].w)) + bfhi(gb[k].w) * o1[3]);
                __builtin_nontemporal_store(mo, (GAS v4u*)(MIX + (wrow0 + r) * 1024 + col));
            }
        }
        LBAR();
        if (has_next) {
#pragma unroll
            for (int tt = 0; tt < 2; ++tt) { LAS unsigned char* sl = L + ((T0 + 1 + tt) & 3) * SW_SLOT;
#pragma unroll
                for (int p = 0; p < 2; ++p) { const int kl = kl0 + 32 * p; *(LAS v4u*)(sl + SW_KOFF + kl * 272 + dp * 16) = nk[tt][p]; *(LAS v4u*)(sl + SW_VOFF + kl * 288 + dp * 16) = nv[tt][p]; } }
#pragma unroll
            for (int ks = 0; ks < 4; ++ks) bq[ks] = bqn[ks];
            asm volatile("" : "+v"(bq[0]), "+v"(bq[1]), "+v"(bq[2]), "+v"(bq[3]));
        }
    }
    LBAR();
}

DI void stagger(unsigned bx, unsigned ticks) {
    const unsigned grp = (bx >> 7) & 1u;
    if (grp) { const unsigned long long t1 = __builtin_amdgcn_s_memrealtime() + (unsigned long long)ticks;
        while (__builtin_amdgcn_s_memrealtime() < t1) __builtin_amdgcn_s_sleep(16); }
}
#ifndef STAGGER
#define STAGGER 0
#endif
__global__ void __launch_bounds__(NWAVES * 64, 2) mk_fwd(Args a) {
    extern __shared__ __attribute__((aligned(16))) unsigned char lds_raw[];
    LAS unsigned char* lds = (LAS unsigned char*)lds_raw;
    const int tid = threadIdx.x;
    const int G = gridDim.x, bx = blockIdx.x, vcu = (G % 8 == 0) ? (bx % 8) * (G / 8) + bx / 8 : bx;
    volatile LAS unsigned* MISC = (volatile LAS unsigned*)(lds + MISC_OFF);
    if (tid < 16) MISC[tid] = 0u;
    __syncthreads();
    XcdBarrier bar = xcd_barrier_post((unsigned*)(a.ws + WS_CTL) + CW_BAR, MISC + 8);
    unsigned char* ws = a.ws;
    bf16* R0 = (bf16*)(ws + WS_R);

#define PHASE_IDS(T_, L_, W_) int T_ = threadIdx.x; asm volatile("" : "+v"(T_)); const int L_ = T_ & 63, W_ = __builtin_amdgcn_readfirstlane(T_ >> 6)
    { PHASE_IDS(t0, l0, w0); (void)t0; p0_prologue(a, lds, vcu, G, w0, l0); }
#if PROBE_DUP == 6
    { PHASE_IDS(t0, l0, w0); (void)t0; p0_prologue(a, lds, vcu, G, w0, l0); }
#endif
    xcd_barrier(bar);

    {
        pg8::Gemm g{(const pg8::bf16_t*)(ws + WS_XN), (const pg8::bf16_t*)(ws + WS_WIN), M, NIN, DM, 0}; pg8::StaticOrder S; S.init(M, NIN, G, bx);
        pg8::EpiIn E{(pg8::bf16_t*)R0, a.out, (const float*)(ws + WS_ROPE), a.qnw, a.knw, (LAS float*)(lds + XCH_OFF)};
#if STAGGER
        stagger((unsigned)bx, 1700u);
#endif
        pg8::gemm_phase<pg8::EpiIn, pg8::StaticOrder, true, true>(lds, g, S, E);
#if PROBE_DUP == 1
        pg8::gemm_phase<pg8::EpiIn, pg8::StaticOrder, true, true>(lds, g, S, E);
#endif
    }
    xcd_barrier(bar);

#if PROBE_DUP == 2
    { PHASE_IDS(t1, l1, w1); for (int u = vcu; u < 512; u += G) ret_unit<true>(a, lds, (u >> 2) >> 2, (u >> 2) & 3, u & 3, t1, l1, w1); }
    { PHASE_IDS(t2, l2, w2); for (int u = vcu; u < 256; u += G) ret_unit<false>(a, lds, (u >> 2) >> 2, (u >> 2) & 3, u & 3, t2, l2, w2); }
#endif
    { PHASE_IDS(t1, l1, w1); for (int u = vcu; u < 512; u += G) ret_unit<true>(a, lds, (u >> 2) >> 2, (u >> 2) & 3, u & 3, t1, l1, w1); }
    { PHASE_IDS(t2, l2, w2); for (int u = vcu; u < 256; u += G) ret_unit<false>(a, lds, (u >> 2) >> 2, (u >> 2) & 3, u & 3, t2, l2, w2); }
    xcd_barrier(bar);

#if PROBE_DUP == 3 || PROBE_DUP == 8
    { PHASE_IDS(t3, l3, w3); for (int u = vcu; u < 256; u += G) sb_unit<true>(a, lds, u >> 3, u & 7, 0, t3, l3, w3); }
#endif
#if PROBE_DUP == 3 || PROBE_DUP == 9
    { PHASE_IDS(t4, l4, w4); for (int u = vcu; u < 256; u += G) sb_stream(a, lds, (u >> 1) >> 3, (u >> 1) & 7, 16 * (u & 1), t4, l4, w4); }
#endif
    { PHASE_IDS(t3, l3, w3); for (int u = vcu; u < 256; u += G) sb_unit<true>(a, lds, u >> 3, u & 7, 0, t3, l3, w3); }
    { PHASE_IDS(t4, l4, w4); for (int u = vcu; u < 256; u += G) sb_stream(a, lds, (u >> 1) >> 3, (u >> 1) & 7, 16 * (u & 1), t4, l4, w4); }
    xcd_barrier(bar);

    {
        pg8::Gemm g{(const pg8::bf16_t*)R0, (const pg8::bf16_t*)(ws + WS_WOUT), M, DM, DM, 0}; pg8::StaticOrder S; S.init(M, DM, G, bx);
        pg8::EpiRes1 E{a.xp, a.xs, a.out, (pg8::bf16_t*)(R0 + REG_E), (float*)(ws + WS_SSQ)};
        pg8::gemm_phase<pg8::EpiRes1, pg8::StaticOrder, true, true>(lds, g, S, E);
#if PROBE_DUP == 4
        pg8::gemm_phase<pg8::EpiRes1, pg8::StaticOrder, true, true>(lds, g, S, E);
#endif
    }
    xcd_barrier(bar);

    {
        pg8::Gemm g{(const pg8::bf16_t*)(R0 + REG_E), (const pg8::bf16_t*)(ws + WS_WUP), M, FF, DM, 0}; pg8::StaticOrder S; S.init(M, FF, G, bx);
        pg8::EpiUp E{(pg8::bf16_t*)(R0 + 4 * REG_E), (const float*)(ws + WS_SSQ)};
#if STAGGER
        stagger((unsigned)bx, 1400u);
#endif
        pg8::gemm_phase<pg8::EpiUp, pg8::StaticOrder, true, true>(lds, g, S, E);
#if PROBE_DUP == 5
        pg8::gemm_phase<pg8::EpiUp, pg8::StaticOrder, true, true>(lds, g, S, E);
#endif
#if PROBE_DUP == 7
        { pg8::EpiNull EN{(float*)(ws + WS_SSQ)}; pg8::gemm_phase<pg8::EpiNull, pg8::StaticOrder, true, true>(lds, g, S, EN); }
#endif
#if PROBE_DUP == 10 || PROBE_DUP == 11
        { pg8::EpiLinear EL{(pg8::bf16_t*)(R0 + 2 * REG_E)}; pg8::gemm_phase<pg8::EpiLinear, pg8::StaticOrder, true, true>(lds, g, S, EL); }
#endif
    }
    xcd_barrier(bar);

    {
        pg8::Gemm g{(const pg8::bf16_t*)(R0 + 4 * REG_E), (const pg8::bf16_t*)(ws + WS_WDN), MP, DM, FF, 0}; pg8::StaticOrder S; S.init(MP, DM, G, bx);
        pg8::EpiDown E{a.out};
        pg8::gemm_phase<pg8::EpiDown, pg8::StaticOrder, true, true>(lds, g, S, E);
    }
    float* part = (float*)(R0 + 2 * REG_E);
    for (int mu = bx; mu < 256; mu += G) {
        const int kc = mu & 15, tile = mu >> 4;
        pg8::Gemm g{(const pg8::bf16_t*)(R0 + 4 * REG_E) + kc * 256, (const pg8::bf16_t*)(ws + WS_WDN) + kc * 256, M, DM, FF, 4};
        pg8::OneUnit S{256 + (tile >> 2), tile & 3};
        pg8::EpiPartial E{part + (size_t)kc * MS * DM};
        pg8::gemm_phase<pg8::EpiPartial, pg8::OneUnit, true, true>(lds, g, S, E);
    }
    xcd_barrier(bar);
    {
        GAS f32x4* y4 = (GAS f32x4*)(a.out + (size_t)MP * DM); const GAS f32x4* p4 = (const GAS f32x4*)part;
        for (int i = bx * (NWAVES * 64) + tid; i < MS * DM / 4; i += G * NWAVES * 64) {
            f32x4 pv[16];
#pragma unroll
            for (int kc = 0; kc < 16; ++kc) pv[kc] = p4[(size_t)kc * (MS * DM / 4) + i];
            f32x4 v = y4[i];
#pragma unroll
            for (int kc = 0; kc < 16; ++kc) v += pv[kc];
            y4[i] = v;
        }
    }
}

extern "C" void kernel_launch(void* const* d_in, const int* in_sizes, int n_in, void* d_out, int out_size, void* d_ws, size_t ws_size, hipStream_t stream) {
    static int grid = 0;
    if (grid == 0) {
        if (n_in != 14 || in_sizes[0] != MP * DM || out_size != (int)O_END || ws_size < WS_END) {
            fprintf(stderr, "kernel_launch: unexpected shapes: n_in %d in0 %d out %d ws %zu (need %zu)\n", n_in, n_in > 0 ? in_sizes[0] : -1, out_size, ws_size, (size_t)WS_END); grid = -1; return; }
        int dev = 0, cus = 0, per_cu = 0;
        if (hipGetDevice(&dev) != hipSuccess || hipDeviceGetAttribute(&cus, hipDeviceAttributeMultiprocessorCount, dev) != hipSuccess) { grid = -1; return; }
        if (hipFuncSetAttribute((const void*)mk_fwd, hipFuncAttributeMaxDynamicSharedMemorySize, LDS_BYTES) != hipSuccess) { fprintf(stderr, "kernel_launch: hipFuncSetAttribute failed\n"); grid = -1; return; }
        if (hipOccupancyMaxActiveBlocksPerMultiprocessor(&per_cu, (const void*)mk_fwd, NWAVES * 64, LDS_BYTES) != hipSuccess || per_cu < 1) { fprintf(stderr, "kernel_launch: occupancy query reports %d blocks per CU\n", per_cu); }
        (void)hipGetLastError();
        grid = cus;
    }
    if (grid < 0) return;
    if (hipMemsetAsync((char*)d_ws + WS_CTL, 0, CTL_ZERO_BYTES, stream) != hipSuccess) return;
    Args a{};
    a.xp = (const float*)d_in[0]; a.xs = (const float*)d_in[1]; a.ck = (const float*)d_in[2]; a.cv = (const float*)d_in[3]; a.st = (const float*)d_in[4];
    a.nmix = (const float*)d_in[5]; a.win = (const float*)d_in[6]; a.rnw = (const float*)d_in[7]; a.qnw = (const float*)d_in[8]; a.knw = (const float*)d_in[9];
    a.wout = (const float*)d_in[10]; a.nmlp = (const float*)d_in[11]; a.wup = (const float*)d_in[12]; a.wdn = (const float*)d_in[13];
    a.out = (float*)d_out; a.ws = (unsigned char*)d_ws;
    hipLaunchKernelGGL(mk_fwd, dim3(grid), dim3(NWAVES * 64), LDS_BYTES, stream, a);
}
```

```cpp
#ifndef PROBE_DUP
#define PROBE_DUP 0
#endif
#include <hip/hip_runtime.h>
#include <cstdio>
#include <cstdint>
#include <cmath>
namespace pg8 {
#define PG8_LAS __attribute__((address_space(3)))
typedef unsigned short bf16_t;
typedef short bf16x8 __attribute__((ext_vector_type(8)));
typedef float f32x4 __attribute__((ext_vector_type(4)));
typedef unsigned u32x4 __attribute__((ext_vector_type(4)));
constexpr int BM = 256, BK = 64, HALF = 128, HTB = HALF * BK * 2  , STAGE_BYTES = 8 * HTB, NXCD = 8, WGM = 8;

__host__ __device__ __forceinline__ int lds_byte(int r, int c) { const int st = (r >> 4) * 2 + (c >> 5), rr = r & 15, cc = c & 31, ob = rr * 64 + cc * 2; return st * 1024 + (ob ^ (((ob >> 9) & 1) << 5)); }
__host__ __device__ __forceinline__ void stage_rc(int b, int& R, int& C) { const int st = b / 1024, sb = b % 1024, swz = sb ^ (((sb >> 9) & 1) << 5); R = (st >> 1) * 16 + swz / 64; C = (st & 1) * 32 + (swz % 64) / 2; }
__host__ __device__ __forceinline__ int perm32(int rho) { const int n = rho >> 4, i = rho & 15; return 8 * (i >> 2) + 4 * n + (i & 3); }

struct Unit { int pm, pn; };
struct Gemm { const bf16_t* A; const bf16_t* Bt; int M, N, K; int nt; };

struct StaticOrder {
    int nM, nN, nwg, G, c;
    __host__ __device__ void init(int M, int N, int G_, int c_) { nM = M / BM; nN = N / BM; nwg = nM * nN; G = G_; c = c_; }
    __host__ __device__ bool next(int i, Unit& u) const {
        const long L = (long)i * G + c; if (L >= nwg) return false;
        int wgid = (int)L; { const int q = nwg / NXCD, r = nwg % NXCD, xcd = wgid % NXCD, off = wgid / NXCD; wgid = (xcd < r ? xcd * (q + 1) : r * (q + 1) + (xcd - r) * q) + off; }
        const int nig = WGM * nN, gid = wgid / nig, fm = gid * WGM, gsz = (nM - fm) < WGM ? (nM - fm) : WGM;
        u.pm = fm + ((wgid % nig) % gsz); u.pn = (wgid % nig) / gsz; return true;
    }
    __device__ __forceinline__ void a_ready(const Unit&) const {}
    __device__ __forceinline__ void done(const Unit&) const {}
};

__device__ __forceinline__ unsigned cvt_pk_bf16(float lo, float hi) { unsigned r; asm volatile("v_cvt_pk_bf16_f32 %0, %1, %2" : "=v"(r) : "v"(lo), "v"(hi)); return r; }
typedef float f32x2 __attribute__((ext_vector_type(2)));

typedef unsigned u32x2 __attribute__((ext_vector_type(2)));
typedef float f32x2_t __attribute__((ext_vector_type(2))); typedef __bf16 bf16x2_t __attribute__((ext_vector_type(2)));
__device__ __forceinline__ unsigned cvtpk(float lo, float hi) { f32x2_t v = {lo, hi}; bf16x2_t b = __builtin_convertvector(v, bf16x2_t); return __builtin_bit_cast(unsigned, b); }
__device__ __forceinline__ void store8(bf16_t* p, const f32x4 a, const f32x4 b) { u32x4 w; w.x = cvtpk(a[0], a[1]); w.y = cvtpk(a[2], a[3]); w.z = cvtpk(b[0], b[1]); w.w = cvtpk(b[2], b[3]); *(u32x4*)p = w; }
__device__ __forceinline__ float sigmoidf_fast(float x) { return __builtin_amdgcn_rcpf(1.0f + __builtin_amdgcn_exp2f(-1.4426950408889634f * x)); }
__device__ __forceinline__ float sumsq4(const f32x4 a) { return (a[0] * a[0] + a[1] * a[1]) + (a[2] * a[2] + a[3] * a[3]); }

constexpr int E_MP = 65536;
constexpr size_t E_REG = (size_t)66560 * 1024;
constexpr size_t EO_KP = 68157440, EO_VP = 135266304, EO_KS = 206569472, EO_VS = 207618048;

__device__ __forceinline__ unsigned ror8(unsigned x) { return (unsigned)__builtin_amdgcn_mov_dpp((int)x, 0x128, 0xf, 0xf, true); }
__device__ __forceinline__ u32x4 ror8v(const u32x4 v) { u32x4 r; r.x = ror8(v.x); r.y = ror8(v.y); r.z = ror8(v.z); r.w = ror8(v.w); return r; }
__device__ __forceinline__ u32x4 pack8(const f32x4 a, const f32x4 b) { u32x4 w; w.x = cvtpk(a[0], a[1]); w.y = cvtpk(a[2], a[3]); w.z = cvtpk(b[0], b[1]); w.w = cvtpk(b[2], b[3]); return w; }
__device__ __forceinline__ void store_rows_bf16(bf16_t* grp, size_t ld, int fr, int fq, const u32x4 P0, const u32x4 P1) {
    const bool lo = fr < 8; const u32x4 snd = lo ? P1 : P0, rcv = ror8v(snd);
    bf16_t* a = grp + (size_t)(fr & 7) * ld + (fq + 4 * (fr >> 3)) * 8;
    __builtin_nontemporal_store(lo ? P0 : rcv, (u32x4*)a); __builtin_nontemporal_store(lo ? rcv : P1, (u32x4*)(a + 8 * ld));
}
__device__ __forceinline__ void store_rows_f32(float* grp, size_t ld, int fr, int fq, const f32x4 V0, const f32x4 V1) {
    const bool lo = fr < 8; const u32x4 snd = __builtin_bit_cast(u32x4, lo ? V1 : V0), rcv = ror8v(snd);
    float* a = grp + (size_t)(fr & 7) * ld + (2 * fq + (fr >> 3)) * 4;
    __builtin_nontemporal_store(lo ? __builtin_bit_cast(u32x4, V0) : rcv, (u32x4*)a); __builtin_nontemporal_store(lo ? rcv : __builtin_bit_cast(u32x4, V1), (u32x4*)(a + 8 * ld));
}
struct RowPair { u32x4 a, b; };
__device__ __forceinline__ RowPair load_rows_f32(const float* grp, size_t ld, int fr, int fq) {
    const float* a = grp + (size_t)(fr & 7) * ld + (2 * fq + (fr >> 3)) * 4; RowPair r; r.a = __builtin_nontemporal_load((const u32x4*)a); r.b = __builtin_nontemporal_load((const u32x4*)(a + 8 * ld)); return r;
}
__device__ __forceinline__ void unswap_rows_f32(const RowPair r, int fr, f32x4& V0, f32x4& V1) {
    const bool lo = fr < 8; const u32x4 snd = lo ? r.b : r.a, rcv = ror8v(snd);
    V0 = __builtin_bit_cast(f32x4, lo ? r.a : rcv); V1 = __builtin_bit_cast(f32x4, lo ? rcv : r.b);
}

struct EpiIn {
    static constexpr bool PERM = true, AFTER_DRAIN = false, DUP_OK = true;
    bf16_t* R; float* out; const float* rope; const float* qw; const float* kw; PG8_LAS float* xch; int force;
    __device__ __forceinline__ void operator()(const f32x4 (&acc)[2][2][4][2], const Unit& u, int wr, int wc, int fr, int fq) const {
        const int tt0 = u.pn >> 2, tt = force ? 2 : tt0, hq = u.pn & 3;
        const int rowg = u.pm * BM + wr * 64;
        bf16_t* base = R + (size_t)tt0 * E_REG + hq * 256 + 64 * wc;
        if (tt <= 1) {
            const float sc = (tt == 1) ? 0.0625f : 1.0f;
            const int cl = 32 * wc + 8 * fq;
            f32x4 tb[2][4];
#define ROPE_LD(g_) do { const int row_ = rowg + fr + ((g_) >> 2) * HALF + ((g_) & 3) * 16; const int pos_ = (row_ < E_MP) ? (row_ & 4095) : (4096 + (row_ & 31)); \
                const f32x4* tp_ = (const f32x4*)(rope + ((size_t)pos_ * 128 + cl) * 2); tb[(g_) & 1][0] = tp_[0]; tb[(g_) & 1][1] = tp_[1]; tb[(g_) & 1][2] = tp_[2]; tb[(g_) & 1][3] = tp_[3]; } while (0)
            ROPE_LD(0);
#pragma unroll
            for (int gi = 0; gi < 8; ++gi) {
                const int ai = gi >> 2, m = gi & 3;
                if (gi < 7) ROPE_LD(gi + 1);
                asm volatile("" ::: "memory");
                f32x4 o1[2], o2[2];
#pragma unroll
                for (int n = 0; n < 2; ++n) {
                    const f32x4 t0 = tb[gi & 1][2 * n], t1 = tb[gi & 1][2 * n + 1], x1 = acc[ai][0][m][n], x2 = acc[ai][1][m][n];
                    o1[n] = (f32x4){x1[0] * t0[0] - x2[0] * t0[1], x1[1] * t0[2] - x2[1] * t0[3], x1[2] * t1[0] - x2[2] * t1[1], x1[3] * t1[2] - x2[3] * t1[3]} * sc;
                    o2[n] = (f32x4){x1[0] * t0[1] + x2[0] * t0[0], x1[1] * t0[3] + x2[1] * t0[2], x1[2] * t1[1] + x2[2] * t1[0], x1[3] * t1[3] + x2[3] * t1[2]} * sc;
                }
                store_rows_bf16(base + (size_t)(rowg + ai * HALF + m * 16) * 1024, 1024, fr, fq, pack8(o1[0], o1[1]), pack8(o2[0], o2[1]));
            }
#undef ROPE_LD
        } else if (tt == 4 || tt == 5) {
            const float* wsrc = ((tt == 4) ? qw : kw) + 64 * (wc & 1) + 8 * fq;
            const f32x4 w00 = *(const f32x4*)(wsrc), w01 = *(const f32x4*)(wsrc + 4), w10 = *(const f32x4*)(wsrc + 32), w11 = *(const f32x4*)(wsrc + 36);
            const float osc = (tt == 4) ? 0.08838834764831845f * 1.4426950408889634f : 1.0f;
#pragma unroll
            for (int ai = 0; ai < 2; ++ai)
#pragma unroll
                for (int m = 0; m < 4; ++m) {
                    float s = (sumsq4(acc[ai][0][m][0]) + sumsq4(acc[ai][0][m][1])) + (sumsq4(acc[ai][1][m][0]) + sumsq4(acc[ai][1][m][1]));
                    s += __shfl_xor(s, 16); s += __shfl_xor(s, 32);
                    if (fq == 0) xch[(ai * HALF + wr * 64 + m * 16 + fr) * 4 + wc] = s;
                }
            asm volatile("s_waitcnt lgkmcnt(0)" ::: "memory"); __builtin_amdgcn_s_barrier(); asm volatile("" ::: "memory");
            float* ok = ((u.pm * BM < E_MP) ? out + EO_KP : out + EO_KS - (size_t)E_MP * 1024) + hq * 256 + 64 * wc;
#pragma unroll
            for (int ai = 0; ai < 2; ++ai)
#pragma unroll
                for (int m = 0; m < 4; ++m) {
                    const int rl = ai * HALF + wr * 64 + m * 16 + fr; const size_t grow = (size_t)(rowg + ai * HALF + m * 16);
                    const f32x4 p = *(const PG8_LAS f32x4*)(xch + rl * 4);
                    const float rstd = osc / sqrtf(((wc < 2) ? (p[0] + p[1]) : (p[2] + p[3])) * (1.0f / 128.0f) + 1e-6f);
                    const f32x4 v00 = acc[ai][0][m][0] * rstd * w00, v01 = acc[ai][0][m][1] * rstd * w01, v10 = acc[ai][1][m][0] * rstd * w10, v11 = acc[ai][1][m][1] * rstd * w11;
                    if (tt == 5) { store_rows_f32(ok + grow * 1024, 1024, fr, fq, v00, v01); store_rows_f32(ok + grow * 1024 + 32, 1024, fr, fq, v10, v11); }
                    store_rows_bf16(base + grow * 1024, 1024, fr, fq, pack8(v00, v01), pack8(v10, v11));
                }
        } else if (tt == 3 || tt == 7) {
            bf16_t* gb_ = R + (size_t)3 * E_REG + 128 * ((tt == 3 ? 0 : 4) + hq) + 32 * wc + 8 * fq;
#pragma unroll
            for (int ai = 0; ai < 2; ++ai)
#pragma unroll
                for (int m = 0; m < 4; ++m) {
                    f32x4 v0 = acc[ai][0][m][0], v1 = acc[ai][0][m][1];
#pragma unroll
                    for (int e = 0; e < 4; ++e) { v0[e] *= sigmoidf_fast(v0[e]) * sigmoidf_fast(acc[ai][1][m][0][e]); v1[e] *= sigmoidf_fast(v1[e]) * sigmoidf_fast(acc[ai][1][m][1][e]); }
                    __builtin_nontemporal_store(pack8(v0, v1), (u32x4*)(gb_ + (size_t)(rowg + fr + ai * HALF + m * 16) * 1024));
                }
        } else {
            float* ov = ((u.pm * BM < E_MP) ? out + EO_VP : out + EO_VS - (size_t)E_MP * 1024) + hq * 256 + 64 * wc;
#pragma unroll
            for (int ai = 0; ai < 2; ++ai)
#pragma unroll
                for (int m = 0; m < 4; ++m) {
                    const size_t grow = (size_t)(rowg + ai * HALF + m * 16);
                    f32x4 v[2][2];
#pragma unroll
                    for (int bj = 0; bj < 2; ++bj) {
                        v[bj][0] = acc[ai][bj][m][0]; v[bj][1] = acc[ai][bj][m][1];
                        if (tt >= 7) {
#pragma unroll
                            for (int e = 0; e < 4; ++e) { v[bj][0][e] = sigmoidf_fast(v[bj][0][e]); v[bj][1][e] = sigmoidf_fast(v[bj][1][e]); }
                        }
                    }
                    if (tt == 6) { store_rows_f32(ov + grow * 1024, 1024, fr, fq, v[0][0], v[0][1]); store_rows_f32(ov + grow * 1024 + 32, 1024, fr, fq, v[1][0], v[1][1]); }
                    store_rows_bf16(base + grow * 1024, 1024, fr, fq, pack8(v[0][0], v[0][1]), pack8(v[1][0], v[1][1]));
                }
        }
    }
};

struct EpiRes1 {
    static constexpr bool PERM = true, AFTER_DRAIN = false, DUP_OK = true;
    const float* xp; const float* xs; float* out; bf16_t* XB; float* SSQ;
    __device__ __forceinline__ void operator()(const f32x4 (&acc)[2][2][4][2], const Unit& u, int wr, int wc, int fr, int fq) const {
        const int rowg = u.pm * BM + wr * 64, colw = u.pn * BM + 64 * wc;
        const float* xb = ((u.pm * BM < E_MP) ? xp : xs - (size_t)E_MP * 1024) + colw;
        RowPair xv[2][2];
#define RES_LD(g_) do { const size_t off_ = (size_t)(rowg + ((g_) >> 2) * HALF + ((g_) & 3) * 16) * 1024; xv[(g_) & 1][0] = load_rows_f32(xb + off_, 1024, fr, fq); xv[(g_) & 1][1] = load_rows_f32(xb + off_ + 32, 1024, fr, fq); } while (0)
        RES_LD(0);
#pragma unroll
        for (int gi = 0; gi < 8; ++gi) {
            const int ai = gi >> 2, m = gi & 3;
            if (gi < 7) RES_LD(gi + 1);
            asm volatile("" ::: "memory");
            const size_t grow = (size_t)(rowg + ai * HALF + m * 16); float ss = 0.f;
            f32x4 v[2][2];
#pragma unroll
            for (int bj = 0; bj < 2; ++bj) {
                f32x4 x0, x1; unswap_rows_f32(xv[gi & 1][bj], fr, x0, x1);
                v[bj][0] = acc[ai][bj][m][0] + x0; v[bj][1] = acc[ai][bj][m][1] + x1;
                ss += sumsq4(v[bj][0]) + sumsq4(v[bj][1]);
                store_rows_f32(out + grow * 1024 + colw + 32 * bj, 1024, fr, fq, v[bj][0], v[bj][1]);
            }
            store_rows_bf16(XB + grow * 1024 + colw, 1024, fr, fq, pack8(v[0][0], v[0][1]), pack8(v[1][0], v[1][1]));
            ss += __shfl_xor(ss, 16); ss += __shfl_xor(ss, 32);
            if (fq == 0) SSQ[(grow + fr) * 16 + u.pn * 4 + wc] = ss;
        }
#undef RES_LD
    }
};

struct EpiUp {
    static constexpr bool PERM = true, AFTER_DRAIN = false, DUP_OK = true;
    bf16_t* H; const float* SSQ;
    __device__ __forceinline__ void operator()(const f32x4 (&acc)[2][2][4][2], const Unit& u, int wr, int wc, int fr, int fq) const {
        const int rowg = u.pm * BM + wr * 64, colw = u.pn * BM + 64 * wc;
        f32x4 sq[2][4];
#pragma unroll
        for (int ai = 0; ai < 2; ++ai)
#pragma unroll
            for (int m = 0; m < 4; ++m) sq[ai][m] = *(const f32x4*)(SSQ + (size_t)(rowg + fr + ai * HALF + m * 16) * 16 + 4 * fq);
        asm volatile("" ::: "memory");
#pragma unroll
        for (int ai = 0; ai < 2; ++ai)
#pragma unroll
            for (int m = 0; m < 4; ++m) {
                float t = (sq[ai][m][0] + sq[ai][m][1]) + (sq[ai][m][2] + sq[ai][m][3]);
                t += __shfl_xor(t, 16); t += __shfl_xor(t, 32);
                const float r2 = 1.0f / (t * (1.0f / 1024.0f) + 1e-6f);
                f32x4 v[2][2];
#pragma unroll
                for (int bj = 0; bj < 2; ++bj) {
                    v[bj][0] = acc[ai][bj][m][0]; v[bj][1] = acc[ai][bj][m][1];
#pragma unroll
                    for (int e = 0; e < 4; ++e) { const float a = fmaxf(v[bj][0][e], 0.f), b = fmaxf(v[bj][1][e], 0.f); v[bj][0][e] = a * a * r2; v[bj][1][e] = b * b * r2; }
                }
                store_rows_bf16(H + (size_t)(rowg + ai * HALF + m * 16) * 4096 + colw, 4096, fr, fq, pack8(v[0][0], v[0][1]), pack8(v[1][0], v[1][1]));
            }
    }
};

struct EpiDown {
    static constexpr bool PERM = true, AFTER_DRAIN = false, DUP_OK = false;
    float* out;
    __device__ __forceinline__ void operator()(const f32x4 (&acc)[2][2][4][2], const Unit& u, int wr, int wc, int fr, int fq) const {
        const int rowg = u.pm * BM + wr * 64, colw = u.pn * BM + 64 * wc;
        RowPair xv[2][2];
#define DN_LD(g_) do { const float* o_ = out + (size_t)(rowg + ((g_) >> 2) * HALF + ((g_) & 3) * 16) * 1024 + colw; xv[(g_) & 1][0] = load_rows_f32(o_, 1024, fr, fq); xv[(g_) & 1][1] = load_rows_f32(o_ + 32, 1024, fr, fq); } while (0)
        DN_LD(0);
#pragma unroll
        for (int gi = 0; gi < 8; ++gi) {
            const int ai = gi >> 2, m = gi & 3;
            if (gi < 7) DN_LD(gi + 1);
            asm volatile("" ::: "memory");
            float* o = out + (size_t)(rowg + ai * HALF + m * 16) * 1024 + colw;
#pragma unroll
            for (int bj = 0; bj < 2; ++bj) {
                f32x4 x0, x1; unswap_rows_f32(xv[gi & 1][bj], fr, x0, x1);
                store_rows_f32(o + 32 * bj, 1024, fr, fq, acc[ai][bj][m][0] + x0, acc[ai][bj][m][1] + x1);
            }
        }
#undef DN_LD
    }
};

struct OneUnit {
    int pm, pn;
    __device__ __forceinline__ bool next(int i, Unit& u) const { if (i != 0) return false; u.pm = pm; u.pn = pn; return true; }
    __device__ __forceinline__ void a_ready(const Unit&) const {}
    __device__ __forceinline__ void done(const Unit&) const {}
};
struct EpiPartial {
    static constexpr bool PERM = true, AFTER_DRAIN = false, DUP_OK = false;
    float* part;
    __device__ __forceinline__ void operator()(const f32x4 (&acc)[2][2][4][2], const Unit& u, int wr, int wc, int fr, int fq) const {
        const int rowg = (u.pm - 256) * BM + wr * 64, colw = u.pn * BM + 64 * wc;
#pragma unroll
        for (int ai = 0; ai < 2; ++ai)
#pragma unroll
            for (int m = 0; m < 4; ++m)
#pragma unroll
                for (int bj = 0; bj < 2; ++bj) store_rows_f32(part + (size_t)(rowg + ai * HALF + m * 16) * 1024 + colw + 32 * bj, 1024, fr, fq, acc[ai][bj][m][0], acc[ai][bj][m][1]);
    }
};

struct EpiNull {
    static constexpr bool PERM = true, AFTER_DRAIN = false, DUP_OK = false;
    float* sink;
    __device__ __forceinline__ void operator()(const f32x4 (&acc)[2][2][4][2], const Unit& u, int wr, int wc, int fr, int fq) const {
        float t = 0.f;
#pragma unroll
        for (int ai = 0; ai < 2; ++ai)
#pragma unroll
            for (int bj = 0; bj < 2; ++bj)
#pragma unroll
                for (int m = 0; m < 4; ++m)
#pragma unroll
                    for (int n = 0; n < 2; ++n) t += (acc[ai][bj][m][n][0] + acc[ai][bj][m][n][1]) + (acc[ai][bj][m][n][2] + acc[ai][bj][m][n][3]);
        if (t == 123456.789f) sink[u.pm * 7 + u.pn + wr + wc + fr + fq] = t;
    }
};

struct EpiLinear {
    static constexpr bool PERM = true, AFTER_DRAIN = false, DUP_OK = false;
    bf16_t* sink;
    __device__ __forceinline__ void operator()(const f32x4 (&acc)[2][2][4][2], const Unit& u, int wr, int wc, int fr, int fq) const {
#if PROBE_DUP == 11
        const int l_ = fq * 16 + fr;
        bf16_t* base = sink + (size_t)((u.pm * 16 + u.pn) & 255) * 131072 + (size_t)(l_ >> 3) * 1024 + (wr * 4 + wc) * 64 + (l_ & 7) * 8;
#define LIN_STEP 8192
#else
        bf16_t* base = sink + (size_t)((u.pm * 16 + u.pn) & 255) * 65536 + (size_t)(wr * 4 + wc) * 8192 + (fq * 16 + fr) * 8;
#define LIN_STEP 512
#endif
#pragma unroll
        for (int ai = 0; ai < 2; ++ai)
#pragma unroll
            for (int m = 0; m < 4; ++m)
#pragma unroll
                for (int bj = 0; bj < 2; ++bj) store8(base + ((ai * 4 + m) * 2 + bj) * LIN_STEP, acc[ai][bj][m][0], acc[ai][bj][m][1]);
    }
};
template <class Epi, class Sched, bool ALIGN_EPI = false, bool SP2 = false>
__device__ __forceinline__ void gemm_phase(PG8_LAS unsigned char* lds, const Gemm g, const Sched& S, const Epi& E) {
    int tid_ = threadIdx.x; asm volatile("" : "+v"(tid_));
    const int tid = tid_, wid = __builtin_amdgcn_readfirstlane(tid >> 6), lane = tid & 63, wr = wid >> 2, wc = wid & 3, fr = lane & 15, fq = lane >> 4;
    const int K = g.K, nt = g.nt ? g.nt : K / BK;
    unsigned voffA[2], voffB[2];
#pragma unroll
    for (int i = 0; i < 2; ++i) { int R, C; stage_rc(tid * 16 + i * 8192, R, C); const int Rb = Epi::PERM ? ((R & ~31) + perm32(R & 31)) : R;
        voffA[i] = (unsigned)(R * K + C) * 2u; voffB[i] = (unsigned)(Rb * K + C) * 2u; }
    const size_t kstep = (size_t)(BK * 2);
    const size_t hstep = (size_t)HALF * K * 2;
    const size_t tstep = 2 * hstep;
    const unsigned ldsw = (unsigned)wid * 1024u;
    const int aoff = lds_byte(wr * 64 + fr, fq * 8), boff = lds_byte(wc * 32 + fr, fq * 8);
#define PG8_SA(b, h) (((b) * 2 + (h)) * HTB)
#define PG8_SB(b, h) ((4 + (b) * 2 + (h)) * HTB)
#define PG8_STAGE(bufoff, gbase, voff) do { _Pragma("unroll") for (int _i = 0; _i < 2; ++_i) \
        __builtin_amdgcn_global_load_lds((const unsigned*)((const char*)(gbase) + (voff)[_i]), (PG8_LAS unsigned*)(lds + (bufoff) + ldsw + _i * 8192), 16, 0, 0); } while (0)
#define PG8_LDA(dst, b, h) do { _Pragma("unroll") for (int m = 0; m < 4; ++m) _Pragma("unroll") for (int k = 0; k < 2; ++k) dst[m][k] = *(const PG8_LAS bf16x8*)(lds + PG8_SA(b, h) + aoff + m * 2048 + k * 1024); } while (0)
#define PG8_LDB(dst, b, h) do { _Pragma("unroll") for (int n = 0; n < 2; ++n) _Pragma("unroll") for (int k = 0; k < 2; ++k) dst[n][k] = *(const PG8_LAS bf16x8*)(lds + PG8_SB(b, h) + boff + n * 2048 + k * 1024); } while (0)
#define PG8_MMA(ai, bj, At, Bt) do { __builtin_amdgcn_s_setprio(1); _Pragma("unroll") for (int m = 0; m < 4; ++m) _Pragma("unroll") for (int n = 0; n < 2; ++n) _Pragma("unroll") for (int k = 0; k < 2; ++k) \
        acc[ai][bj][m][n] = __builtin_amdgcn_mfma_f32_16x16x32_bf16(Bt[n][k], At[m][k], acc[ai][bj][m][n], 0, 0, 0); __builtin_amdgcn_s_setprio(0); } while (0)
#define PG8_WAIT_V(n) asm volatile("s_waitcnt vmcnt(" #n ")" ::: "memory")
#define PG8_WAIT_L(n) asm volatile("s_waitcnt lgkmcnt(" #n ")" ::: "memory")
#define PG8_BAR __builtin_amdgcn_s_barrier()
#define PG8_SCHED __builtin_amdgcn_sched_barrier(0)
    Unit cur, nxt; int ui = 0;
    if (!S.next(0, cur)) return;
    f32x4 acc[2][2][4][2];
#pragma unroll
    for (int a = 0; a < 2; ++a)
#pragma unroll
        for (int b = 0; b < 2; ++b)
#pragma unroll
            for (int m = 0; m < 4; ++m)
#pragma unroll
                for (int n = 0; n < 2; ++n) acc[a][b][m][n] = (f32x4){0.f, 0.f, 0.f, 0.f};
    bf16x8 At[4][2], B0[2][2], B1[2][2];
    const char* cA = (const char*)g.A + (size_t)cur.pm * tstep; const char* cB = (const char*)g.Bt + (size_t)cur.pn * tstep;
    S.a_ready(cur);
    if constexpr (SP2) {
        PG8_STAGE(PG8_SB(0, 0), cB, voffB); PG8_STAGE(PG8_SB(0, 1), cB + hstep, voffB); PG8_STAGE(PG8_SA(0, 0), cA, voffA); PG8_STAGE(PG8_SA(0, 1), cA + hstep, voffA);
        if (wr == 1) PG8_BAR;
        PG8_WAIT_V(2); PG8_BAR;
        PG8_STAGE(PG8_SB(1, 0), cB + kstep, voffB); PG8_STAGE(PG8_SA(1, 0), cA + kstep, voffA); PG8_STAGE(PG8_SB(1, 1), cB + hstep + kstep, voffB);
        PG8_WAIT_V(6); PG8_BAR;
    } else {
        PG8_STAGE(PG8_SB(0, 0), cB, voffB); PG8_STAGE(PG8_SA(0, 0), cA, voffA); PG8_STAGE(PG8_SB(0, 1), cB + hstep, voffB); PG8_STAGE(PG8_SA(0, 1), cA + hstep, voffA);
        if (wr == 1) PG8_BAR;
        PG8_WAIT_V(4); PG8_BAR;
        PG8_STAGE(PG8_SB(1, 0), cB + kstep, voffB); PG8_STAGE(PG8_SA(1, 0), cA + kstep, voffA); PG8_STAGE(PG8_SB(1, 1), cB + hstep + kstep, voffB);
        PG8_WAIT_V(6); PG8_BAR;
    }
    for (;;) {
        const bool has_next = S.next(ui + 1, nxt);
        const char* nA = has_next ? (const char*)g.A + (size_t)nxt.pm * tstep : cA; const char* nB = has_next ? (const char*)g.Bt + (size_t)nxt.pn * tstep : cB;
        for (int t = 0; t < nt; t += 2) {
            const bool last = (t == nt - 2);
            const char* a1 = cA + (size_t)(t + 1) * kstep;
            const char* a2 = last ? nA : cA + (size_t)(t + 2) * kstep; const char* b2 = last ? nB : cB + (size_t)(t + 2) * kstep;
            const char* a3 = a2 + kstep; const char* b3 = b2 + kstep;
            if (last && has_next) S.a_ready(nxt);
            if constexpr (SP2) {
            PG8_LDB(B0, 0, 0); PG8_LDB(B1, 0, 1); PG8_SCHED; PG8_LDA(At, 0, 0); PG8_STAGE(PG8_SA(1, 1), a1 + hstep, voffA);
            PG8_WAIT_V(8); PG8_WAIT_L(0); PG8_BAR; PG8_MMA(0, 0, At, B0); PG8_MMA(0, 1, At, B1); PG8_BAR; PG8_SCHED;
            PG8_LDA(At, 0, 1); PG8_STAGE(PG8_SB(0, 0), b2, voffB); PG8_STAGE(PG8_SB(0, 1), b2 + hstep, voffB); PG8_STAGE(PG8_SA(0, 0), a2, voffA);
            PG8_WAIT_V(8); PG8_WAIT_L(0); PG8_BAR; PG8_MMA(1, 0, At, B0); PG8_MMA(1, 1, At, B1); PG8_BAR; PG8_SCHED;
            PG8_LDB(B0, 1, 0); PG8_LDB(B1, 1, 1); PG8_SCHED; PG8_LDA(At, 1, 0); PG8_STAGE(PG8_SA(0, 1), a2 + hstep, voffA);
            PG8_WAIT_V(8); PG8_WAIT_L(0); PG8_BAR; PG8_MMA(0, 0, At, B0); PG8_MMA(0, 1, At, B1); PG8_BAR; PG8_SCHED;
            PG8_LDA(At, 1, 1); PG8_STAGE(PG8_SB(1, 0), b3, voffB); PG8_STAGE(PG8_SB(1, 1), b3 + hstep, voffB); PG8_STAGE(PG8_SA(1, 0), a3, voffA);
            PG8_WAIT_V(8); PG8_WAIT_L(0); PG8_BAR; PG8_MMA(1, 0, At, B0); PG8_MMA(1, 1, At, B1); PG8_BAR; PG8_SCHED;
            } else {
            PG8_LDB(B0, 0, 0); PG8_SCHED; PG8_LDA(At, 0, 0); PG8_STAGE(PG8_SA(1, 1), a1 + hstep, voffA);
            PG8_WAIT_L(8); PG8_BAR; PG8_WAIT_L(0); PG8_MMA(0, 0, At, B0); PG8_BAR; PG8_SCHED;
            PG8_LDB(B1, 0, 1); PG8_STAGE(PG8_SB(0, 0), b2, voffB);
            PG8_BAR; PG8_WAIT_L(0); PG8_MMA(0, 1, At, B1); PG8_BAR;
            PG8_LDA(At, 0, 1); PG8_STAGE(PG8_SA(0, 0), a2, voffA);
            PG8_BAR; PG8_WAIT_L(0); PG8_MMA(1, 0, At, B0); PG8_BAR; PG8_SCHED;
            PG8_STAGE(PG8_SB(0, 1), b2 + hstep, voffB);
            PG8_WAIT_V(6); PG8_BAR; PG8_MMA(1, 1, At, B1); PG8_BAR;
            PG8_LDB(B0, 1, 0); PG8_SCHED; PG8_LDA(At, 1, 0); PG8_STAGE(PG8_SA(0, 1), a2 + hstep, voffA);
            PG8_WAIT_L(8); PG8_BAR; PG8_WAIT_L(0); PG8_MMA(0, 0, At, B0); PG8_BAR; PG8_SCHED;
            PG8_LDB(B1, 1, 1); PG8_STAGE(PG8_SB(1, 0), b3, voffB);
            PG8_BAR; PG8_WAIT_L(0); PG8_MMA(0, 1, At, B1); PG8_BAR;
            PG8_LDA(At, 1, 1); PG8_STAGE(PG8_SA(1, 0), a3, voffA);
            PG8_BAR; PG8_WAIT_L(0); PG8_MMA(1, 0, At, B0); PG8_BAR; PG8_SCHED;
            PG8_STAGE(PG8_SB(1, 1), b3 + hstep, voffB);
            PG8_WAIT_V(6); PG8_BAR; PG8_MMA(1, 1, At, B1); PG8_BAR;
            }
        }
        if constexpr (ALIGN_EPI) { if (wr == 0) PG8_BAR; }
        if constexpr (!Epi::AFTER_DRAIN) { int fr_e = fr, fq_e = fq; asm volatile("" : "+v"(fr_e), "+v"(fq_e));
            E(acc, cur, wr, wc, fr_e, fq_e);
#if defined(PROBE_EPI2)
            if constexpr (Epi::DUP_OK) { asm volatile("" ::: "memory"); E(acc, cur, wr, wc, fr_e, fq_e); }
#endif
            S.done(cur); }
        if (!has_next) break;
#pragma unroll
        for (int a = 0; a < 2; ++a)
#pragma unroll
            for (int b = 0; b < 2; ++b)
#pragma unroll
                for (int m = 0; m < 4; ++m)
#pragma unroll
                    for (int n = 0; n < 2; ++n) acc[a][b][m][n] = (f32x4){0.f, 0.f, 0.f, 0.f};
        cur = nxt; cA = nA; cB = nB; ++ui;
        if constexpr (ALIGN_EPI) { if (wr == 1) PG8_BAR; }
    }
    PG8_WAIT_V(0);
    if constexpr (!ALIGN_EPI) { if (wr == 0) PG8_BAR; }
    PG8_BAR;
    if constexpr (Epi::AFTER_DRAIN) { E.fused(acc, cur, wr, wc, fr, fq, lds, wid, lane); S.done(cur); }
#undef PG8_SA
#undef PG8_SB
#undef PG8_STAGE
#undef PG8_LDA
#undef PG8_LDB
#undef PG8_MMA
#undef PG8_WAIT_V
#undef PG8_WAIT_L
#undef PG8_BAR
#undef PG8_SCHED
}
}
#define GAS __attribute__((address_space(1)))
#define LAS __attribute__((address_space(3)))
typedef unsigned short bf16;
typedef unsigned v4u __attribute__((ext_vector_type(4)));
typedef float f32x4 __attribute__((ext_vector_type(4)));
typedef short bf16x8 __attribute__((ext_vector_type(8)));
typedef GAS unsigned gu32;
typedef GAS unsigned long long gu64;
#define RLX_AGENT __ATOMIC_RELAXED, __HIP_MEMORY_SCOPE_AGENT
#define LDS_WAIT() asm volatile("s_waitcnt lgkmcnt(0)" ::: "memory")
#define VM_WAIT() asm volatile("s_waitcnt vmcnt(0)" ::: "memory")
__device__ __forceinline__ unsigned long long rt() { return __builtin_amdgcn_s_memrealtime(); }
__device__ __forceinline__ unsigned f2bf(float f) { unsigned u = __builtin_bit_cast(unsigned, f); return (u + 0x7fffu + ((u >> 16) & 1u)) >> 16; }
__device__ __forceinline__ unsigned pk2(float lo, float hi) { return f2bf(lo) | (f2bf(hi) << 16); }

#define XB_TMO      128
#define XB_XCNT(j)  (256  + 64 * (j))
#define XB_XSUB(j)  (1280 + 64 * (j))
#define XB_XGEN(j)  (2304 + 64 * (j))
#define XB_TOP      3328
#define XB_TOPGEN   3392
#define XCD_BAR_WORDS 3456
#define XB_SPIN_CAP (1u << 18)

__device__ __forceinline__ unsigned xb_ld(unsigned* p)              { return __hip_atomic_load(p, __ATOMIC_RELAXED, __HIP_MEMORY_SCOPE_AGENT); }
__device__ __forceinline__ unsigned xb_add(unsigned* p, unsigned v) { return __hip_atomic_fetch_add(p, v, __ATOMIC_RELAXED, __HIP_MEMORY_SCOPE_AGENT); }
__device__ __forceinline__ unsigned xb_xcc_id() { return (unsigned)__builtin_amdgcn_s_getreg((3 << 11) | 20) & 0xFu; }
#define XB_SPIN(cond, bar) do { unsigned _sp = 0; while (cond) { __builtin_amdgcn_s_sleep(1); \
    if ((++_sp & 255u) == 0u) { if (xb_ld(&(bar)[XB_TMO])) break; if (_sp > XB_SPIN_CAP) { atomicAdd(&(bar)[XB_TMO], 1u); break; } } } } while (0)

struct XcdBarrier {
    unsigned* bar; unsigned x;
    volatile LAS unsigned* st;
};

__device__ __forceinline__ XcdBarrier xcd_barrier_post(unsigned* bar, volatile LAS unsigned* st) {
    XcdBarrier b; b.bar = bar; b.x = xb_xcc_id(); b.st = st;
    if (threadIdx.x == 0) (void)xb_add(&bar[XB_XCNT(b.x)], 1u);
    return b;
}
__device__ __forceinline__ void xcd_barrier_complete(unsigned* bar, unsigned x, unsigned& nloc, unsigned& nx) {
    const unsigned G = gridDim.x * gridDim.y * gridDim.z;
    unsigned sum, cnt, mine, sp = 0u;
    for (;;) {
        sum = 0u; cnt = 0u; mine = 0u;
#pragma unroll
        for (unsigned j = 0; j < 16; ++j) { const unsigned c = xb_ld(&bar[XB_XCNT(j)]); sum += c; cnt += (c > 0u) ? 1u : 0u; mine = (j == x) ? c : mine; }
        if (sum == G) break;
        __builtin_amdgcn_s_sleep(1);
        if ((++sp & 255u) == 0u) { if (xb_ld(&bar[XB_TMO])) break; if (sp > XB_SPIN_CAP) { atomicAdd(&bar[XB_TMO], 1u); break; } }
    }
    nloc = mine > 0u ? mine : 1u; nx = cnt > 0u ? cnt : 1u;
}

__device__ __forceinline__ void xcd_barrier(const XcdBarrier& b) {
    asm volatile("s_waitcnt vmcnt(0)" ::: "memory");
    __syncthreads();
    if (threadIdx.x == 0) {
        unsigned* bar = b.bar;
        __builtin_amdgcn_s_waitcnt(0);
        unsigned nloc = b.st[0], nx = b.st[1];
        if (nloc == 0u) { xcd_barrier_complete(bar, b.x, nloc, nx); b.st[0] = nloc; b.st[1] = nx; }
        const unsigned old = xb_add(&bar[XB_XSUB(b.x)], 1u);
        const unsigned gen = old / nloc;
        if (old + 1u == (gen + 1u) * nloc) {
            __builtin_amdgcn_fence(__ATOMIC_RELEASE, "agent");
            asm volatile("s_waitcnt vmcnt(0)" ::: "memory");
            const unsigned og = xb_add(&bar[XB_TOP], 1u);
            const unsigned tg = og / nx;
            if (og + 1u == (tg + 1u) * nx) xb_add(&bar[XB_TOPGEN], 1u);
            else XB_SPIN(xb_ld(&bar[XB_TOPGEN]) == tg, bar);
            __builtin_amdgcn_fence(__ATOMIC_ACQUIRE, "agent");
            xb_add(&bar[XB_XGEN(b.x)], 1u);
            asm volatile("s_waitcnt vmcnt(0)" ::: "memory");
        } else {
            XB_SPIN(xb_ld(&bar[XB_XGEN(b.x)]) == gen, bar);
            __builtin_amdgcn_fence(__ATOMIC_ACQUIRE, "agent");
            asm volatile("s_waitcnt vmcnt(0)" ::: "memory");
        }
    }
    __syncthreads();
}
typedef float f32x2_pair __attribute__((ext_vector_type(2)));

constexpr int NWAVES = 8;
constexpr int DM = 1024, FF = 4096, NIN = 9216;
constexpr int MP = 65536, MS = 1024, M = MP + MS;
constexpr int PAST = 4096;
constexpr size_t MiB = 1u << 20;
constexpr size_t REG_E = (size_t)M * DM;
constexpr size_t WS_CTL = 0, CTL_ZERO_BYTES = 1 * MiB;
constexpr size_t WS_WIN = 2 * MiB, WS_WOUT = 20 * MiB, WS_WUP = 22 * MiB, WS_WDN = 30 * MiB;
constexpr size_t WS_ROPE = 38 * MiB;
constexpr size_t WS_SSQ = 43 * MiB;
constexpr size_t WS_RSS = 48 * MiB;
constexpr size_t WS_XN = 54 * MiB;
constexpr size_t WS_R = 184 * MiB;
constexpr size_t WS_END = WS_R + 9 * REG_E * 2;
static_assert(WS_ROPE + (size_t)4128 * 128 * 8 <= WS_SSQ && WS_SSQ + (size_t)M * 64 <= WS_RSS && WS_RSS + (size_t)M * 64 <= WS_XN && WS_XN + REG_E * 2 <= WS_R, "ws map");
constexpr size_t O_Y = 0, O_KP = 68157440, O_VP = 135266304, O_SP = 202375168, O_KS = 206569472, O_VS = 207618048, O_SS = 208666624, O_END = 217055232;
constexpr int CW_BAR = 4096;
constexpr int RING_BYTES = 131072, XCH_OFF = RING_BYTES + 512, MISC_OFF = 163840 - 256, LDS_BYTES = 163840;
static_assert(XCH_OFF + 8192 <= MISC_OFF && MISC_OFF + 64 <= LDS_BYTES, "LDS map");
constexpr int SW_FLAGS_LIMIT = MISC_OFF;

typedef short s16x4 __attribute__((ext_vector_type(4)));
typedef unsigned v2u __attribute__((ext_vector_type(2)));
#define DI __device__ __forceinline__
#define MFMA16(a, b, c) __builtin_amdgcn_mfma_f32_16x16x32_bf16((a), (b), (c), 0, 0, 0)
#define LBAR() do { asm volatile("s_waitcnt lgkmcnt(0)" ::: "memory"); __builtin_amdgcn_s_barrier(); asm volatile("" ::: "memory"); } while (0)
typedef short v4i16_t __attribute__((ext_vector_type(4)));
DI s16x4 trd(const LAS unsigned char* p) { return __builtin_bit_cast(s16x4, __builtin_amdgcn_ds_read_tr16_b64_v4i16((LAS v4i16_t*)p)); }
DI bf16x8 cat8(s16x4 lo, s16x4 hi) { return (bf16x8){lo[0], lo[1], lo[2], lo[3], hi[0], hi[1], hi[2], hi[3]}; }
DI float bflo(unsigned u) { return __uint_as_float(u << 16); }
DI float bfhi(unsigned u) { return __uint_as_float(u & 0xffff0000u); }
using pg8::cvtpk;
DI float wave_sum(float v) {
#pragma unroll
    for (int o = 1; o < 64; o <<= 1) v += __shfl_xor(v, o);
    return v;
}
constexpr float LOG2E = 1.4426950408889634f, LN2 = 0.6931471805599453f;

struct Args {
    const float *xp, *xs, *ck, *cv, *st, *nmix, *win, *rnw, *qnw, *knw, *wout, *nmlp, *wup, *wdn;
    float* out; unsigned char* ws;
};

DI int colpos(int n) { return (n & ~255) | (((n >> 5) & 1) << 7) | (((n >> 6) & 3) << 5) | (n & 31); }
DI void p0_transpose_item(const float* W, int K, int N, bf16* WT, const float* ksc, int pfrom, LAS float* scr, int item, int lane) {
    const int nblk = N / 32, kb = item / nblk, nb = item % nblk, k0 = 64 * kb, n0 = 32 * nb;
#pragma unroll 8
    for (int i = 0; i < 32; ++i) { const int kk = 2 * i + (lane >> 5); float v = W[(size_t)(k0 + kk) * N + n0 + (lane & 31)]; if (ksc) v *= ksc[k0 + kk]; scr[kk * 33 + (lane & 31)] = v; }
    LDS_WAIT(); asm volatile("" ::: "memory");
    const int c = lane & 7;
#pragma unroll
    for (int j = 0; j < 4; ++j) { const int n = (lane >> 3) + 8 * j; const LAS float* s = scr + (8 * c) * 33 + n;
        v4u o; o.x = cvtpk(s[0 * 33], s[1 * 33]); o.y = cvtpk(s[2 * 33], s[3 * 33]); o.z = cvtpk(s[4 * 33], s[5 * 33]); o.w = cvtpk(s[6 * 33], s[7 * 33]);
        const int nn = n0 + n; int np = (nn >= pfrom) ? colpos(nn) : nn;
        if (pfrom == 2048) {
            const bool isg = (nn >= 3072 && nn < 4096), isa = (nn >= 7168 && nn < 8192);
            if (isg || isa) { const int f = nn - (isg ? 3072 : 7168), t8 = f >> 7; np = (t8 < 4 ? 3072 + 256 * t8 : 7168 + 256 * (t8 - 4)) + (isa ? 128 : 0) + (f & 127); }
        }
        *(GAS v4u*)(WT + (size_t)np * K + k0 + 8 * c) = o; }
    LDS_WAIT(); asm volatile("" ::: "memory");
}
DI void p0_prologue(const Args& a, LAS unsigned char* lds, int vcu, int G, int wave, int lane) {
    unsigned char* ws = a.ws;
    LAS float* scr = (LAS float*)(lds + wave * 16384);
    const int gw = vcu * NWAVES + wave, NGW = G * NWAVES;
    constexpr int I_IN = (DM / 64) * (NIN / 32), I_O = (DM / 64) * (DM / 32), I_U = (DM / 64) * (FF / 32), I_D = (FF / 64) * (DM / 32);
    constexpr int NITEMS = I_IN + I_O + I_U + I_D;
    for (int it = gw; it < NITEMS; it += NGW) {
        int r = it;
        if (r < I_IN) { p0_transpose_item(a.win, DM, NIN, (bf16*)(ws + WS_WIN), nullptr, 2048, scr, r, lane); continue; } r -= I_IN;
        if (r < I_O) { p0_transpose_item(a.wout, DM, DM, (bf16*)(ws + WS_WOUT), nullptr, 0, scr, r, lane); continue; } r -= I_O;
        if (r < I_U) { p0_transpose_item(a.wup, DM, FF, (bf16*)(ws + WS_WUP), a.nmlp, 0, scr, r, lane); continue; } r -= I_U;
        p0_transpose_item(a.wdn, FF, DM, (bf16*)(ws + WS_WDN), nullptr, 0, scr, r, lane);
    }
    {
        f32x4 wv[4];
#pragma unroll
        for (int j = 0; j < 4; ++j) wv[j] = ((const GAS f32x4*)a.nmix)[lane + 64 * j];
        bf16* XN = (bf16*)(ws + WS_XN);
        for (int m = gw; m < M; m += NGW) {
            const float* xrow = (m < MP) ? a.xp + (size_t)m * DM : a.xs + (size_t)(m - MP) * DM;
            const GAS f32x4* xr = (const GAS f32x4*)xrow + lane;
            f32x4 v[4]; float s = 0.f;
#pragma unroll
            for (int j = 0; j < 4; ++j) { v[j] = __builtin_nontemporal_load(&xr[64 * j]); s += (v[j].x * v[j].x + v[j].y * v[j].y) + (v[j].z * v[j].z + v[j].w * v[j].w); }
            const float rstd = 1.0f / sqrtf(wave_sum(s) * (1.0f / DM) + 1e-6f);
            GAS v2u* o8 = (GAS v2u*)(XN + (size_t)m * DM) + lane;
#pragma unroll
            for (int j = 0; j < 4; ++j) { const f32x4 y = v[j] * rstd * wv[j]; v2u o; o.x = cvtpk(y.x, y.y); o.y = cvtpk(y.z, y.w); __builtin_nontemporal_store(o, &o8[64 * j]); }
        }
    }
    {
        float* rope = (float*)(ws + WS_ROPE);
        for (int idx = gw * 64 + lane; idx < 4128 * 128; idx += NGW * 64) {
            const int pos = idx >> 7, j = idx & 127;
            const float inv = powf(10000.0f, -(float)j * (1.0f / 128.0f));
            const float ang = (float)pos * inv;
            float sn, cs; sincosf(ang, &sn, &cs);
            *(GAS f32x2_pair*)(rope + (size_t)idx * 2) = (f32x2_pair){cs, sn};
        }
    }
}

constexpr int RT_QS = 0, RT_KS = 33792, RT_VS = 68608, RT_VDS = 78848, RT_PS = 89088, RT_STS = 98304, RT_RXS = 132096;
static_assert(RT_RXS + 1024 <= SW_FLAGS_LIMIT, "retention LDS map");
DI float xsum16_32(float s) {
    auto r = __builtin_amdgcn_permlane16_swap(__float_as_uint(s), __float_as_uint(s), false, false); const float t = __uint_as_float(r[0]) + __uint_as_float(r[1]);
    auto q = __builtin_amdgcn_permlane32_swap(__float_as_uint(t), __float_as_uint(t), false, false); return __uint_as_float(q[0]) + __uint_as_float(q[1]);
}
template <bool SAMPLE>
DI void ret_unit(const Args& a, LAS unsigned char* L, int b, int h, int s, int tid, int lane, int w) {
    const int c15 = lane & 15, g = lane >> 4, q4 = c15 >> 2, p4 = c15 & 3;
    constexpr int Lc = SAMPLE ? 32 : 64, NSTEP = SAMPLE ? 1 : 64;
    const float lg2 = __builtin_amdgcn_logf(1.0f - __builtin_amdgcn_exp2f(-5.0f - (float)h));
    const size_t rowbase = SAMPLE ? (size_t)MP + 32 * b : (size_t)4096 * b;
    const bf16* RQ = (const bf16*)(a.ws + WS_R), *RK = RQ + REG_E, *RV = RQ + 2 * REG_E;
    bf16* ORET = (bf16*)(a.ws + WS_XN);
    float* RSS = (float*)(a.ws + WS_RSS);
    f32x4 S[2][4];
    const size_t sbase = ((size_t)(b * 4 + h) * 256) * 256 + 64 * s;
    {
        const float* sp0 = a.st + sbase + (size_t)(128 * (w & 1) + 32 * (w >> 1) + 4 * g) * 256 + c15;
#pragma unroll
        for (int k2 = 0; k2 < 2; ++k2)
#pragma unroll
            for (int dt = 0; dt < 4; ++dt)
#pragma unroll
                for (int r = 0; r < 4; ++r) S[k2][dt][r] = SAMPLE ? sp0[(16 * k2 + r) * 256 + 16 * dt] : 0.f;
    }
    const int jt = w >> 1, itp = w & 1, dto = w >> 1;
    const float gL = __builtin_amdgcn_exp2f(lg2 * (float)Lc);
    float qd[2];
#pragma unroll
    for (int t = 0; t < 2; ++t) { const int i = 32 * itp + 16 * t + c15; qd[t] = __builtin_amdgcn_exp2f(lg2 * (float)(i + 1)); }
    v4u pq[4], pk[4], pv;
    const int vrow = tid >> 3, vpc = tid & 7;
    const float kd = __builtin_amdgcn_exp2f(lg2 * (float)(Lc - 1 - vrow));
#define RT_LOAD_Q(c) do { int tl_ = tid; asm volatile("" : "+v"(tl_));     \
        _Pragma("unroll") for (int p_ = 0; p_ < 4; ++p_) { const int idx_ = tl_ + 512 * p_, row_ = idx_ >> 5, pc_ = idx_ & 31; \
            if (!SAMPLE || row_ < 32) { const size_t go_ = (rowbase + (size_t)64 * (c) + row_) * 1024 + 256 * h + 8 * pc_; pq[p_] = *(const GAS v4u*)(RQ + go_); } \
            else { pq[p_] = (v4u){0u, 0u, 0u, 0u}; } } } while (0)
#define RT_LOAD_KV(c) do { int tl_ = tid; asm volatile("" : "+v"(tl_)); \
        _Pragma("unroll") for (int p_ = 0; p_ < 4; ++p_) { const int idx_ = tl_ + 512 * p_, row_ = idx_ >> 5, pc_ = idx_ & 31; \
            if (!SAMPLE || row_ < 32) { const size_t go_ = (rowbase + (size_t)64 * (c) + row_) * 1024 + 256 * h + 8 * pc_; pk[p_] = *(const GAS v4u*)(RK + go_); } \
            else { pk[p_] = (v4u){0u, 0u, 0u, 0u}; } } \
        if (!SAMPLE || vrow < 32) pv = *(const GAS v4u*)(RV + (rowbase + (size_t)64 * (c) + vrow) * 1024 + 256 * h + 64 * s + 8 * vpc); else pv = (v4u){0u, 0u, 0u, 0u}; } while (0)
#define RT_WRITE_Q() do { _Pragma("unroll") for (int p_ = 0; p_ < 4; ++p_) { const int idx_ = tid + 512 * p_, row_ = idx_ >> 5, pc_ = idx_ & 31; *(LAS v4u*)(L + RT_QS + row_ * 528 + pc_ * 16) = pq[p_]; } } while (0)
#define RT_WRITE_KV() do { \
        _Pragma("unroll") for (int p_ = 0; p_ < 4; ++p_) { const int idx_ = tid + 512 * p_, row_ = idx_ >> 5, pc_ = idx_ & 31; *(LAS v4u*)(L + RT_KS + row_ * 544 + pc_ * 16) = pk[p_]; } \
        *(LAS v4u*)(L + RT_VS + vrow * 160 + vpc * 16) = pv; \
        { v4u d_; d_.x = cvtpk(bflo(pv.x) * kd, bfhi(pv.x) * kd); d_.y = cvtpk(bflo(pv.y) * kd, bfhi(pv.y) * kd); d_.z = cvtpk(bflo(pv.z) * kd, bfhi(pv.z) * kd); d_.w = cvtpk(bflo(pv.w) * kd, bfhi(pv.w) * kd); \
          *(LAS v4u*)(L + RT_VDS + vrow * 160 + vpc * 16) = d_; } } while (0)
    RT_LOAD_Q(0); RT_LOAD_KV(0); RT_WRITE_Q(); RT_WRITE_KV();
    for (int c = 0; c < NSTEP; ++c) {
        LBAR();
        if (c + 1 < NSTEP) RT_LOAD_KV(c + 1);
        bf16x8 bq[2][8];
        {
            f32x4 sc[2] = {(f32x4){0.f, 0.f, 0.f, 0.f}, (f32x4){0.f, 0.f, 0.f, 0.f}};
            const LAS unsigned char* kp = L + RT_KS + (16 * jt + c15) * 544 + g * 16;
            const LAS unsigned char* qp = L + RT_QS + (32 * itp + c15) * 528 + g * 16;
#pragma unroll
            for (int hb = 0; hb < 2; ++hb) {
                bf16x8 ak[4];
#pragma unroll
                for (int k4 = 0; k4 < 4; ++k4) { const int ks = 4 * hb + k4; ak[k4] = *(const LAS bf16x8*)(kp + ks * 64); bq[0][ks] = *(const LAS bf16x8*)(qp + ks * 64); bq[1][ks] = *(const LAS bf16x8*)(qp + 16 * 528 + ks * 64); }
                __builtin_amdgcn_sched_barrier(0);
#pragma unroll
                for (int k4 = 0; k4 < 4; ++k4) { const int ks = 4 * hb + k4; sc[0] = MFMA16(ak[k4], bq[0][ks], sc[0]); sc[1] = MFMA16(ak[k4], bq[1][ks], sc[1]); }
                __builtin_amdgcn_sched_barrier(0);
            }
#pragma unroll
            for (int t = 0; t < 2; ++t) {
                const int i = 32 * itp + 16 * t + c15, j0 = 16 * jt + 4 * g;
                float pd[4]; float lgc = lg2; asm volatile("" : "+v"(lgc));
#pragma unroll
                for (int r = 0; r < 4; ++r) { const int d = i - (j0 + r); pd[r] = __builtin_amdgcn_exp2f(lgc * (float)(d < 0 ? -d : d)); }
                v2u o; o.x = cvtpk(sc[t][0] * pd[0], sc[t][1] * pd[1]); o.y = cvtpk(sc[t][2] * pd[2], sc[t][3] * pd[3]);
                *(LAS v2u*)(L + RT_PS + i * 144 + j0 * 2) = o;
            }
        }
#pragma unroll
        for (int k2 = 0; k2 < 2; ++k2)
#pragma unroll
            for (int dt = 0; dt < 4; ++dt) { v2u o; o.x = cvtpk(S[k2][dt][0], S[k2][dt][1]); o.y = cvtpk(S[k2][dt][2], S[k2][dt][3]);
                *(LAS v2u*)(L + RT_STS + (16 * dt + c15) * 528 + (16 * (2 * w + k2) + 4 * g) * 2) = o; }
        LBAR();
        if (c + 1 < NSTEP) RT_LOAD_Q(c + 1);
        {
            f32x4 oc[2] = {(f32x4){0.f, 0.f, 0.f, 0.f}, (f32x4){0.f, 0.f, 0.f, 0.f}};
            const LAS unsigned char* sp = L + RT_STS + (16 * dto + c15) * 528 + g * 16;
#pragma unroll
            for (int hb = 0; hb < 2; ++hb) {
                bf16x8 as[4];
#pragma unroll
                for (int k4 = 0; k4 < 4; ++k4) as[k4] = *(const LAS bf16x8*)(sp + (4 * hb + k4) * 64);
                __builtin_amdgcn_sched_barrier(0);
#pragma unroll
                for (int k4 = 0; k4 < 4; ++k4) { const int ks = 4 * hb + k4; oc[0] = MFMA16(as[k4], bq[0][ks], oc[0]); oc[1] = MFMA16(as[k4], bq[1][ks], oc[1]); }
                __builtin_amdgcn_sched_barrier(0);
            }
            oc[0] = oc[0] * qd[0]; oc[1] = oc[1] * qd[1];
#pragma unroll
            for (int k2 = 0; k2 < 2; ++k2) {
                const LAS unsigned char* vp = L + RT_VS + (32 * k2 + 4 * g + q4) * 160 + (16 * dto + 4 * p4) * 2;
                const bf16x8 av = cat8(trd(vp), trd(vp + 16 * 160));
#pragma unroll
                for (int t = 0; t < 2; ++t) { const int i = 32 * itp + 16 * t + c15; const LAS unsigned char* pp = L + RT_PS + i * 144 + (32 * k2 + 4 * g) * 2;
                    const bf16x8 bp = cat8(*(const LAS s16x4*)pp, *(const LAS s16x4*)(pp + 32)); oc[t] = MFMA16(av, bp, oc[t]); }
            }
#pragma unroll
            for (int t = 0; t < 2; ++t) {
                const int i = 32 * itp + 16 * t + c15;
                float ss = (oc[t][0] * oc[t][0] + oc[t][1] * oc[t][1]) + (oc[t][2] * oc[t][2] + oc[t][3] * oc[t][3]);
                ss = xsum16_32(ss);
                if (g == 0) ((LAS float*)(L + RT_RXS))[dto * 64 + i] = ss;
                if (!SAMPLE || i < 32) { v2u o; o.x = cvtpk(oc[t][0], oc[t][1]); o.y = cvtpk(oc[t][2], oc[t][3]);
                    __builtin_nontemporal_store(o, (GAS v2u*)(ORET + (rowbase + (size_t)64 * c + i) * 1024 + 256 * h + 64 * s + 16 * dto + 4 * g)); }
            }
        }
#pragma unroll
        for (int k2 = 0; k2 < 2; ++k2)
#pragma unroll
            for (int dt = 0; dt < 4; ++dt) S[k2][dt] = S[k2][dt] * gL;
#pragma unroll
        for (int ks = 0; ks < 2; ++ks) {
            const int tok = 32 * ks + 4 * g + q4;
            bf16x8 ak[2];
#pragma unroll
            for (int k2 = 0; k2 < 2; ++k2) { const LAS unsigned char* kp = L + RT_KS + tok * 544 + (16 * (2 * w + k2) + 4 * p4) * 2; ak[k2] = cat8(trd(kp), trd(kp + 16 * 544)); }
#pragma unroll
            for (int dt = 0; dt < 4; ++dt) { const LAS unsigned char* vp = L + RT_VDS + tok * 160 + (16 * dt + 4 * p4) * 2; const bf16x8 bv = cat8(trd(vp), trd(vp + 16 * 160));
                S[0][dt] = MFMA16(ak[0], bv, S[0][dt]); S[1][dt] = MFMA16(ak[1], bv, S[1][dt]); }
        }
        if (c + 1 < NSTEP) RT_WRITE_Q();
        LBAR();
        if (tid < 64 && (!SAMPLE || tid < 32)) { const LAS float* rx = (const LAS float*)(L + RT_RXS);
            RSS[(rowbase + (size_t)64 * c + tid) * 16 + h * 4 + s] = (rx[tid] + rx[64 + tid]) + (rx[128 + tid] + rx[192 + tid]); }
        if (c + 1 < NSTEP) RT_WRITE_KV();
    }
    {
        int ln = lane; asm volatile("" : "+v"(ln));
        float* so = a.out + (SAMPLE ? O_SS : O_SP) + sbase + (size_t)(128 * (w & 1) + 32 * (w >> 1) + 4 * (ln >> 4)) * 256 + (ln & 15);
#pragma unroll
        for (int k2 = 0; k2 < 2; ++k2)
#pragma unroll
            for (int dt = 0; dt < 4; ++dt)
#pragma unroll
                for (int r = 0; r < 4; ++r) so[(16 * k2 + r) * 256 + 16 * dt] = S[k2][dt][r];
    }
    LBAR();
#undef RT_LOAD_Q
#undef RT_LOAD_KV
#undef RT_WRITE_Q
#undef RT_WRITE_KV
}

constexpr int SB_KS = 0, SB_KT = 17408, SB_VS = 52224, SB_VT = 18432, SB_FLAGS = 107520, SB_OS = 0, SB_OSW = 8448;
static_assert(SB_KS + 3 * SB_KT <= SB_VS && SB_VS + 3 * SB_VT <= SB_FLAGS && SB_OS + 8 * SB_OSW <= SB_FLAGS && SB_FLAGS + 64 <= RING_BYTES, "SB LDS map");
constexpr float SB_EXIT = 40.0f * 1.4426950408889634f;
template <bool MASKED>
DI void sb_tile(const LAS unsigned char* kb, const LAS unsigned char* vb, const bf16x8 (&bq)[4], const bf16x8 acs, const bf16x8 ones, int key0, int qpos, float& carry, f32x4 (&oacc)[8]) {
    f32x4 z[4];
#pragma unroll
    for (int j = 0; j < 4; ++j) z[j] = (f32x4){0.f, 0.f, 0.f, 0.f};
    {
        bf16x8 ak[2][4];
#pragma unroll
        for (int j = 0; j < 4; ++j) ak[0][j] = *(const LAS bf16x8*)(kb + j * 16 * 272);
#pragma unroll
        for (int ks = 0; ks < 4; ++ks) {
            if (ks < 3) {
#pragma unroll
                for (int j = 0; j < 4; ++j) ak[(ks + 1) & 1][j] = *(const LAS bf16x8*)(kb + j * 16 * 272 + (ks + 1) * 64);
            }
            __builtin_amdgcn_sched_barrier(0);
#pragma unroll
            for (int j = 0; j < 4; ++j) z[j] = MFMA16(ak[ks & 1][j], bq[ks], z[j]);
            __builtin_amdgcn_sched_barrier(0);
        }
    }
    float s[4][4], t[4];
#pragma unroll
    for (int j = 0; j < 4; ++j) {
        float v[4];
#pragma unroll
        for (int r = 0; r < 4; ++r) { const float zz = fminf(z[j][r], 100.0f); z[j][r] = zz; float vv = __builtin_amdgcn_logf(1.0f + __builtin_amdgcn_exp2f(zz));
            if (MASKED) vv = (key0 + 16 * j + r < qpos) ? vv : 0.f;
            v[r] = vv; }
        s[j][3] = v[3]; s[j][2] = v[3] + v[2]; s[j][1] = s[j][2] + v[1]; s[j][0] = s[j][1] + v[0]; t[j] = s[j][0];
    }
    const unsigned h01 = cvtpk(t[0], t[1]), h23 = cvtpk(t[2], t[3]);
    const unsigned l01 = cvtpk(t[0] - bflo(h01), t[1] - bfhi(h01)), l23 = cvtpk(t[2] - bflo(h23), t[3] - bfhi(h23));
    const bf16x8 bt = __builtin_bit_cast(bf16x8, (v4u){h01, h23, l01, l23});
    const f32x4 zero4 = (f32x4){0.f, 0.f, 0.f, 0.f};
    const f32x4 E = MFMA16(acs, bt, zero4), TOT = MFMA16(ones, bt, zero4);
    unsigned wp[4][2];
#pragma unroll
    for (int j = 0; j < 4; ++j) { const float ec = E[j] + carry; float wv[4];
#pragma unroll
        for (int r = 0; r < 4; ++r) { float ex = __builtin_amdgcn_exp2f((z[j][r] - s[j][r]) - ec); if (MASKED) ex = (key0 + 16 * j + r < qpos) ? ex : 0.f; wv[r] = ex; }
        wp[j][0] = cvtpk(wv[0], wv[1]); wp[j][1] = cvtpk(wv[2], wv[3]); }
    carry += TOT[0];
#pragma unroll
    for (int k2 = 0; k2 < 2; ++k2) { const bf16x8 bw = __builtin_bit_cast(bf16x8, (v4u){wp[2 * k2][0], wp[2 * k2][1], wp[2 * k2 + 1][0], wp[2 * k2 + 1][1]});
#pragma unroll
        for (int dt = 0; dt < 8; ++dt) { const bf16x8 av = cat8(trd(vb + (32 * k2) * 288 + dt * 32), trd(vb + (32 * k2 + 16) * 288 + dt * 32)); oacc[dt] = MFMA16(av, bw, oacc[dt]); } }
}
template <bool SAMPLE>
DI void sb_unit(const Args& a, LAS unsigned char* L, int b, int h, int qb, int tid, int lane, int w) {
    const int c15 = lane & 15, g = lane >> 4, q4 = c15 >> 2, p4 = c15 & 3;
    const bf16* R0 = (const bf16*)(a.ws + WS_R);
    const bf16 *RG = R0 + 3 * REG_E, *SQ = R0 + 4 * REG_E, *SK = R0 + 5 * REG_E, *SV = R0 + 6 * REG_E, *GA = R0 + 7 * REG_E, *GB = R0 + 8 * REG_E;
    const bf16* ORET = (const bf16*)(a.ws + WS_XN);
    bf16* MIX = (bf16*)(a.ws + WS_R);
    const float* RSS = (const float*)(a.ws + WS_RSS);
    const bool wvalid = SAMPLE ? (w < 2) : true;
    const int qwbase = SAMPLE ? PAST + 16 * w : 128 * qb + 16 * w;
    const int qpos = qwbase + c15;
    const size_t wrow0 = SAMPLE ? (size_t)MP + 32 * b + 16 * w : (size_t)4096 * b + qwbase;
    bf16x8 bq[4];
#pragma unroll
    for (int ks = 0; ks < 4; ++ks) bq[ks] = wvalid ? *(const GAS bf16x8*)(SQ + (wrow0 + c15) * 1024 + 128 * h + 32 * ks + 8 * g) : (bf16x8){0, 0, 0, 0, 0, 0, 0, 0};
    asm volatile("s_waitcnt vmcnt(0)" : "+v"(bq[0]), "+v"(bq[1]), "+v"(bq[2]), "+v"(bq[3]) :: "memory");
    bf16x8 ones, acs;
#pragma unroll
    for (int e = 0; e < 8; ++e) { ones[e] = (short)0x3f80; acs[e] = (4 * (e & 3) + g > 4 * (c15 & 3) + (c15 >> 2)) ? (short)0x3f80 : (short)0; }
    const int T0 = SAMPLE ? 64 : 2 * qb + 1;
    float carry = 0.f;
    f32x4 oacc[8];
#pragma unroll
    for (int dt = 0; dt < 8; ++dt) oacc[dt] = (f32x4){0.f, 0.f, 0.f, 0.f};
    const int kl0 = tid >> 4, dp = tid & 15;
    v4u tk[2][2], tv[2][2]; f32x4 fk[2][2][2], fv[2][2][2];
#define SB_LOAD(S_, T_) do { _Pragma("unroll") for (int p_ = 0; p_ < 2; ++p_) { const int kl_ = kl0 + 32 * p_; \
        if (!SAMPLE) { const size_t go_ = ((size_t)4096 * b + 64 * (T_) + kl_) * 1024 + 128 * h + 8 * dp; tk[S_][p_] = *(const GAS v4u*)(SK + go_); tv[S_][p_] = *(const GAS v4u*)(SV + go_); } \
        else { const size_t go_ = (((size_t)b * 4096 + 64 * (T_) + kl_) * 8 + h) * 128 + 8 * dp; \
            fk[S_][p_][0] = __builtin_nontemporal_load((const GAS f32x4*)(a.ck + go_)); fk[S_][p_][1] = __builtin_nontemporal_load((const GAS f32x4*)(a.ck + go_ + 4)); fv[S_][p_][0] = __builtin_nontemporal_load((const GAS f32x4*)(a.cv + go_)); fv[S_][p_][1] = __builtin_nontemporal_load((const GAS f32x4*)(a.cv + go_ + 4)); } } } while (0)
#define SB_PARK(S_, B_) do { _Pragma("unroll") for (int p_ = 0; p_ < 2; ++p_) { const int kl_ = kl0 + 32 * p_; \
        if (SAMPLE) { tk[S_][p_] = (v4u){cvtpk(fk[S_][p_][0][0], fk[S_][p_][0][1]), cvtpk(fk[S_][p_][0][2], fk[S_][p_][0][3]), cvtpk(fk[S_][p_][1][0], fk[S_][p_][1][1]), cvtpk(fk[S_][p_][1][2], fk[S_][p_][1][3])}; \
            tv[S_][p_] = (v4u){cvtpk(fv[S_][p_][0][0], fv[S_][p_][0][1]), cvtpk(fv[S_][p_][0][2], fv[S_][p_][0][3]), cvtpk(fv[S_][p_][1][0], fv[S_][p_][1][1]), cvtpk(fv[S_][p_][1][2], fv[S_][p_][1][3])}; } \
        *(LAS v4u*)(L + SB_KS + (B_) * SB_KT + kl_ * 272 + dp * 16) = tk[S_][p_]; *(LAS v4u*)(L + SB_VS + (B_) * SB_VT + kl_ * 288 + dp * 16) = tv[S_][p_]; } } while (0)
    {
#pragma unroll
        for (int p = 0; p < 2; ++p) { const int kl = kl0 + 32 * p; v4u k0, v0;
            if (!SAMPLE) { const size_t go = ((size_t)4096 * b + 64 * T0 + kl) * 1024 + 128 * h + 8 * dp; k0 = *(const GAS v4u*)(SK + go); v0 = *(const GAS v4u*)(SV + go); }
            else if (kl < 32) { const size_t go = ((size_t)MP + 32 * b + kl) * 1024 + 128 * h + 8 * dp; k0 = *(const GAS v4u*)(SK + go); v0 = *(const GAS v4u*)(SV + go); }
            else { k0 = (v4u){0u, 0u, 0u, 0u}; v0 = (v4u){0u, 0u, 0u, 0u}; }
            *(LAS v4u*)(L + SB_KS + kl * 272 + dp * 16) = k0; *(LAS v4u*)(L + SB_VS + kl * 288 + dp * 16) = v0; }
    }
    if (T0 >= 1) SB_LOAD(0, T0 - 1);
    if (T0 >= 2) SB_LOAD(1, T0 - 2);
    int buf = 0;
    for (int it = 0;; ++it) {
        const int T = T0 - it; const int nb = (buf == 2) ? 0 : buf + 1;
        LBAR();
        if (it > 0) { const LAS unsigned* fl = (const LAS unsigned*)(L + SB_FLAGS) + 8 * ((it - 1) & 1);
            const unsigned any = (fl[0] | fl[1]) | (fl[2] | fl[3]) | (fl[4] | fl[5]) | (fl[6] | fl[7]);
            if (__builtin_amdgcn_readfirstlane(any) == 0u) break; }
        if (T > 0) {
            if (it & 1) { SB_PARK(1, nb); if (T >= 3) SB_LOAD(1, T - 3); }
            else        { SB_PARK(0, nb); if (T >= 3) SB_LOAD(0, T - 3); }
        }
        const bool alive = wvalid && (__ballot(carry < SB_EXIT) != 0ull);
        if (alive && 64 * T < qwbase + 16) {
            const LAS unsigned char* kb = L + SB_KS + buf * SB_KT + c15 * 272 + g * 16;
            const LAS unsigned char* vb = L + SB_VS + buf * SB_VT + (4 * g + q4) * 288 + 8 * p4;
            if (64 * T + 63 < qwbase) sb_tile<false>(kb, vb, bq, acs, ones, 64 * T + 4 * g, qpos, carry, oacc);
            else sb_tile<true>(kb, vb, bq, acs, ones, 64 * T + 4 * g, qpos, carry, oacc);
        }
        { const bool more = wvalid && (carry < SB_EXIT); const unsigned long long bal = __ballot(more);
          if (lane == 0) ((LAS unsigned*)(L + SB_FLAGS))[8 * (it & 1) + w] = (bal != 0ull) ? 1u : 0u; }
        if (T == 0) break;
        buf = nb;
    }
#undef SB_LOAD
#undef SB_PARK
    LBAR();
    if (wvalid) {
        LAS unsigned char* os = L + SB_OS + w * SB_OSW;
#pragma unroll
        for (int dt = 0; dt < 8; ++dt) *(LAS f32x4*)(os + c15 * 528 + (16 * dt + 4 * g) * 4) = oacc[dt];
        const int hr = h >> 1, ch = lane & 15, col = 128 * h + 8 * ch;
        const f32x4 rw0 = *(const f32x4*)(a.rnw + 256 * hr + (col & 255)), rw1 = *(const f32x4*)(a.rnw + 256 * hr + (col & 255) + 4);
        v4u orr[4], rg[4], gb[4]; f32x4 rs[4];
#pragma unroll
        for (int k = 0; k < 4; ++k) { const size_t row = wrow0 + 4 * k + (lane >> 4), go = row * 1024 + col;
            orr[k] = *(const GAS v4u*)(ORET + go); rg[k] = *(const GAS v4u*)(RG + go); gb[k] = *(const GAS v4u*)(GB + go);
            rs[k] = *(const GAS f32x4*)(RSS + row * 16 + hr * 4); }
        asm volatile("s_waitcnt lgkmcnt(0)" ::: "memory");
#pragma unroll
        for (int k = 0; k < 4; ++k) {
            const int r = 4 * k + (lane >> 4);
            const f32x4 o0 = *(const LAS f32x4*)(os + r * 528 + ch * 32), o1 = *(const LAS f32x4*)(os + r * 528 + ch * 32 + 16);
            const float rstd = 1.0f / sqrtf(((rs[k][0] + rs[k][1]) + (rs[k][2] + rs[k][3])) * (1.0f / 256.0f) + 1e-6f);
            v4u mo;
            mo.x = cvtpk((bflo(orr[k].x) * rstd * rw0[0] * bflo(rg[k].x)) + bflo(gb[k].x) * o0[0], (bfhi(orr[k].x) * rstd * rw0[1] * bfhi(rg[k].x)) + bfhi(gb[k].x) * o0[1]);
            mo.y = cvtpk((bflo(orr[k].y) * rstd * rw0[2] * bflo(rg[k].y)) + bflo(gb[k].y) * o0[2], (bfhi(orr[k].y) * rstd * rw0[3] * bfhi(rg[k].y)) + bfhi(gb[k].y) * o0[3]);
            mo.z = cvtpk((bflo(orr[k].z) * rstd * rw1[0] * bflo(rg[k].z)) + bflo(gb[k].z) * o1[0], (bfhi(orr[k].z) * rstd * rw1[1] * bfhi(rg[k].z)) + bfhi(gb[k].z) * o1[1]);
            mo.w = cvtpk((bflo(orr[k].w) * rstd * rw1[2] * bflo(rg[k].w)) + bflo(gb[k].w) * o1[2], (bfhi(orr[k].w) * rstd * rw1[3] * bfhi(rg[k].w)) + bfhi(gb[k].w) * o1[3]);
            __builtin_nontemporal_store(mo, (GAS v4u*)(MIX + (wrow0 + r) * 1024 + col));
        }
    }
    LBAR();
}

constexpr int SW_SLOT = 35840, SW_KOFF = 0, SW_VOFF = 17408, SW_FLAGS = 4 * SW_SLOT;
static_assert(SW_FLAGS + 64 <= MISC_OFF && 2 * SW_SLOT >= 8 * SB_OSW, "SB stream LDS map");
DI void sw_fill(LAS unsigned char* L, const bf16* SK, const bf16* SV, size_t rowb, int h, int T, int tid) {
    const int kl0 = tid >> 4, dp = tid & 15; LAS unsigned char* sl = L + (T & 3) * SW_SLOT;
#pragma unroll
    for (int p = 0; p < 2; ++p) { const int kl = kl0 + 32 * p; const size_t go = (rowb + 64 * T + kl) * 1024 + 128 * h + 8 * dp;
        const v4u k0 = *(const GAS v4u*)(SK + go), v0 = *(const GAS v4u*)(SV + go);
        *(LAS v4u*)(sl + SW_KOFF + kl * 272 + dp * 16) = k0; *(LAS v4u*)(sl + SW_VOFF + kl * 288 + dp * 16) = v0; }
}
DI void sb_stream(const Args& a, LAS unsigned char* L, int b, int h, int qb0, int tid, int lane, int w) {
    const int c15 = lane & 15, g = lane >> 4, q4 = c15 >> 2, p4 = c15 & 3;
    const bf16* R0 = (const bf16*)(a.ws + WS_R);
    const bf16 *RG = R0 + 3 * REG_E, *SQ = R0 + 4 * REG_E, *SK = R0 + 5 * REG_E, *SV = R0 + 6 * REG_E, *GA = R0 + 7 * REG_E, *GB = R0 + 8 * REG_E;
    const bf16* ORET = (const bf16*)(a.ws + WS_XN);
    bf16* MIX = (bf16*)(a.ws + WS_R);
    const float* RSS = (const float*)(a.ws + WS_RSS);
    const size_t rowb = (size_t)4096 * b;
    bf16x8 ones, acs;
#pragma unroll
    for (int e = 0; e < 8; ++e) { ones[e] = (short)0x3f80; acs[e] = (4 * (e & 3) + g > 4 * (c15 & 3) + (c15 >> 2)) ? (short)0x3f80 : (short)0; }
    const int kl0 = tid >> 4, dp = tid & 15;
    LAS unsigned* flags = (LAS unsigned*)(L + SW_FLAGS);
    for (int T = (2 * qb0 - 2 > 0 ? 2 * qb0 - 2 : 0); T <= 2 * qb0 + 1; ++T) sw_fill(L, SK, SV, rowb, h, T, tid);
    bf16x8 bq[4];
#pragma unroll
    for (int ks = 0; ks < 4; ++ks) bq[ks] = *(const GAS bf16x8*)(SQ + (rowb + 128 * qb0 + 16 * w + c15) * 1024 + 128 * h + 32 * ks + 8 * g);
    asm volatile("s_waitcnt vmcnt(0)" : "+v"(bq[0]), "+v"(bq[1]), "+v"(bq[2]), "+v"(bq[3]) :: "memory");
    for (int qb = qb0; qb < qb0 + 16; ++qb) {
        const int T0 = 2 * qb + 1, qwbase = 128 * qb + 16 * w, qpos = qwbase + c15;
        const bool has_next = (qb + 1 < qb0 + 16);
        LBAR();
        v4u nk[2][2], nv[2][2]; bf16x8 bqn[4];
        if (has_next) {
#pragma unroll
            for (int tt = 0; tt < 2; ++tt)
#pragma unroll
                for (int p = 0; p < 2; ++p) { const size_t go = (rowb + 64 * (T0 + 1 + tt) + kl0 + 32 * p) * 1024 + 128 * h + 8 * dp; nk[tt][p] = __builtin_nontemporal_load((const GAS v4u*)(SK + go)); nv[tt][p] = __builtin_nontemporal_load((const GAS v4u*)(SV + go)); }
#pragma unroll
            for (int ks = 0; ks < 4; ++ks) bqn[ks] = *(const GAS bf16x8*)(SQ + (rowb + 128 * (qb + 1) + 16 * w + c15) * 1024 + 128 * h + 32 * ks + 8 * g);
        }
        float carry = 0.f;
        f32x4 oacc[8];
#pragma unroll
        for (int dt = 0; dt < 8; ++dt) oacc[dt] = (f32x4){0.f, 0.f, 0.f, 0.f};
        const int Tlow = (T0 - 3 > 0) ? T0 - 3 : 0;
        for (int T = T0; T >= Tlow; --T) {
            if (__ballot(carry < SB_EXIT) == 0ull) break;
            if (64 * T < qwbase + 16) {
                const LAS unsigned char* sl = L + (T & 3) * SW_SLOT;
                const LAS unsigned char* kb = sl + SW_KOFF + c15 * 272 + g * 16;
                const LAS unsigned char* vb = sl + SW_VOFF + (4 * g + q4) * 288 + 8 * p4;
                if (64 * T + 63 < qwbase) sb_tile<false>(kb, vb, bq, acs, ones, 64 * T + 4 * g, qpos, carry, oacc);
                else sb_tile<true>(kb, vb, bq, acs, ones, 64 * T + 4 * g, qpos, carry, oacc);
            }
        }
        { const unsigned long long bal = __ballot(carry < SB_EXIT); if (lane == 0) flags[w] = (bal != 0ull) ? 1u : 0u; }
        LBAR();
        {
            unsigned any = (flags[0] | flags[1]) | (flags[2] | flags[3]) | (flags[4] | flags[5]) | (flags[6] | flags[7]);
            if (__builtin_amdgcn_readfirstlane(any) != 0u && Tlow > 0) {
                int T = Tlow - 1;
                for (;;) {
                    LBAR();
                    {   LAS unsigned char* sl = L + (T0 & 3) * SW_SLOT;
#pragma unroll
                        for (int p = 0; p < 2; ++p) { const int kl = kl0 + 32 * p; const size_t go = (rowb + 64 * T + kl) * 1024 + 128 * h + 8 * dp;
                            const v4u k0 = *(const GAS v4u*)(SK + go), v0 = *(const GAS v4u*)(SV + go);
                            *(LAS v4u*)(sl + SW_KOFF + kl * 272 + dp * 16) = k0; *(LAS v4u*)(sl + SW_VOFF + kl * 288 + dp * 16) = v0; } }
                    LBAR();
                    if (__ballot(carry < SB_EXIT) != 0ull) {
                        const LAS unsigned char* sl = L + (T0 & 3) * SW_SLOT;
                        sb_tile<false>(sl + SW_KOFF + c15 * 272 + g * 16, sl + SW_VOFF + (4 * g + q4) * 288 + 8 * p4, bq, acs, ones, 64 * T + 4 * g, qpos, carry, oacc);
                    }
                    { const unsigned long long bal = __ballot(carry < SB_EXIT); if (lane == 0) flags[w] = (bal != 0ull) ? 1u : 0u; }
                    LBAR();
                    any = (flags[0] | flags[1]) | (flags[2] | flags[3]) | (flags[4] | flags[5]) | (flags[6] | flags[7]);
                    if (__builtin_amdgcn_readfirstlane(any) == 0u || T == 0) break;
                    --T;
                }
                LBAR();
                sw_fill(L, SK, SV, rowb, h, T0, tid);
                LBAR();
            }
        }
        {
            LAS unsigned char* os = L + ((T0 - 3) & 2) * SW_SLOT + w * SB_OSW;
#pragma unroll
            for (int dt = 0; dt < 8; ++dt) *(LAS f32x4*)(os + c15 * 528 + (16 * dt + 4 * g) * 4) = oacc[dt];
            const int hr = h >> 1, ch = lane & 15, col = 128 * h + 8 * ch;
            const size_t wrow0 = rowb + qwbase;
            const f32x4 rw0 = *(const f32x4*)(a.rnw + 256 * hr + (col & 255)), rw1 = *(const f32x4*)(a.rnw + 256 * hr + (col & 255) + 4);
            v4u orr[4], rg[4], gb[4]; f32x4 rs[4];
#pragma unroll
            for (int k = 0; k < 4; ++k) { const size_t row = wrow0 + 4 * k + (lane >> 4), go = row * 1024 + col;
                orr[k] = __builtin_nontemporal_load((const GAS v4u*)(ORET + go)); rg[k] = __builtin_nontemporal_load((const GAS v4u*)(RG + go)); gb[k] = __builtin_nontemporal_load((const GAS v4u*)(GB + go));
                rs[k] = *(const GAS f32x4*)(RSS + row * 16 + hr * 4); }
            asm volatile("s_waitcnt lgkmcnt(0)" ::: "memory");
#pragma unroll
            for (int k = 0; k < 4; ++k) {
                const int r = 4 * k + (lane >> 4);
                const f32x4 o0 = *(const LAS f32x4*)(os + r * 528 + ch * 32), o1 = *(const LAS f32x4*)(os + r * 528 + ch * 32 + 16);
                const float rstd = 1.0f / sqrtf(((rs[k][0] + rs[k][1]) + (rs[k][2] + rs[k][3])) * (1.0f / 256.0f) + 1e-6f);
                v4u mo;
                mo.x = cvtpk((bflo(orr[k].x) * rstd * rw0[0] * bflo(rg[k].x)) + bflo(gb[k].x) * o0[0], (bfhi(orr[k].x) * rstd * rw0[1] * bfhi(rg[k].x)) + bfhi(gb[k].x) * o0[1]);
                mo.y = cvtpk((bflo(orr[k].y) * rstd * rw0[2] * bflo(rg[k].y)) + bflo(gb[k].y) * o0[2], (bfhi(orr[k].y) * rstd * rw0[3] * bfhi(rg[k].y)) + bfhi(gb[k].y) * o0[3]);
                mo.z = cvtpk((bflo(orr[k].z) * rstd * rw1[0] * bflo(rg[k].z)) + bflo(gb[k].z) * o1[0], (bfhi(orr[k].z) * rstd * rw1[1] * bfhi(rg[k].z)) + bfhi(gb[k].z) * o1[1]);
                mo.w = cvtpk((bflo(orr[k].w) * rstd * rw1[2] * bflo(rg[k].w)) + bflo(gb[k].w) * o1[2], (bfhi(orr[k].w) * rstd * rw1[3] * bfhi(rg[k].w)) + bfhi(gb[k].w) * o1[3]);
                __builtin_nontemporal_store(mo, (GAS v4u*)(MIX + (wrow0 + r) * 1024 + col));
            }
        }
        LBAR();
        if (has_next) {
#pragma unroll
            for (int tt = 0; tt < 2; ++tt) { LAS unsigned char* sl = L + ((T0 + 1 + tt) & 3) * SW_SLOT;
#pragma unroll
                for (int p = 0; p < 2; ++p) { const int kl = kl0 + 32 * p; *(LAS v4u*)(sl + SW_KOFF + kl * 272 + dp * 16) = nk[tt][p]; *(LAS v4u*)(sl + SW_VOFF + kl * 288 + dp * 16) = nv[tt][p]; } }
#pragma unroll
            for (int ks = 0; ks < 4; ++ks) bq[ks] = bqn[ks];
            asm volatile("" : "+v"(bq[0]), "+v"(bq[1]), "+v"(bq[2]), "+v"(bq[3]));
        }
    }
    LBAR();
}

DI void stagger(unsigned bx, unsigned ticks) {
    const unsigned x = bx & 7u;
    if (x) { const unsigned long long t1 = __builtin_amdgcn_s_memrealtime() + (unsigned long long)(ticks * x);
        while (__builtin_amdgcn_s_memrealtime() < t1) __builtin_amdgcn_s_sleep(16); }
}
#ifndef STAGGER
#define STAGGER 0
#endif
__global__ void __launch_bounds__(NWAVES * 64, 2) mk_fwd(Args a) {
    extern __shared__ __attribute__((aligned(16))) unsigned char lds_raw[];
    LAS unsigned char* lds = (LAS unsigned char*)lds_raw;
    const int tid = threadIdx.x;
    const int G = gridDim.x, bx = blockIdx.x, vcu = (G % 8 == 0) ? (bx % 8) * (G / 8) + bx / 8 : bx;
    volatile LAS unsigned* MISC = (volatile LAS unsigned*)(lds + MISC_OFF);
    if (tid < 16) MISC[tid] = 0u;
    __syncthreads();
    XcdBarrier bar = xcd_barrier_post((unsigned*)(a.ws + WS_CTL) + CW_BAR, MISC + 8);
    unsigned char* ws = a.ws;
    bf16* R0 = (bf16*)(ws + WS_R);

#define PHASE_IDS(T_, L_, W_) int T_ = threadIdx.x; asm volatile("" : "+v"(T_)); const int L_ = T_ & 63, W_ = __builtin_amdgcn_readfirstlane(T_ >> 6)
    { PHASE_IDS(t0, l0, w0); (void)t0; p0_prologue(a, lds, vcu, G, w0, l0); }
#if PROBE_DUP == 6
    { PHASE_IDS(t0, l0, w0); (void)t0; p0_prologue(a, lds, vcu, G, w0, l0); }
#endif
    xcd_barrier(bar);

    {
        pg8::Gemm g{(const pg8::bf16_t*)(ws + WS_XN), (const pg8::bf16_t*)(ws + WS_WIN), M, NIN, DM, 0}; pg8::StaticOrder S; S.init(M, NIN, G, bx);
        pg8::EpiIn E{(pg8::bf16_t*)R0, a.out, (const float*)(ws + WS_ROPE), a.qnw, a.knw, (LAS float*)(lds + XCH_OFF), 0};
#if PROBE_DUP == 12
        { pg8::EpiIn EF{(pg8::bf16_t*)R0, a.out, (const float*)(ws + WS_ROPE), a.qnw, a.knw, (LAS float*)(lds + XCH_OFF), 1}; pg8::gemm_phase<pg8::EpiIn, pg8::StaticOrder, true, true>(lds, g, S, EF); }
#endif
#if STAGGER
        stagger((unsigned)bx, 430u);
#endif
        pg8::gemm_phase<pg8::EpiIn, pg8::StaticOrder, true, true>(lds, g, S, E);
#if PROBE_DUP == 1
        pg8::gemm_phase<pg8::EpiIn, pg8::StaticOrder, true, true>(lds, g, S, E);
#endif
    }
    xcd_barrier(bar);

#if PROBE_DUP == 2
    { PHASE_IDS(t1, l1, w1); for (int u = vcu; u < 512; u += G) ret_unit<true>(a, lds, (u >> 2) >> 2, (u >> 2) & 3, u & 3, t1, l1, w1); }
    { PHASE_IDS(t2, l2, w2); for (int u = vcu; u < 256; u += G) ret_unit<false>(a, lds, (u >> 2) >> 2, (u >> 2) & 3, u & 3, t2, l2, w2); }
#endif
    { PHASE_IDS(t1, l1, w1); for (int u = vcu; u < 512; u += G) ret_unit<true>(a, lds, (u >> 2) >> 2, (u >> 2) & 3, u & 3, t1, l1, w1); }
    { PHASE_IDS(t2, l2, w2); for (int u = vcu; u < 256; u += G) ret_unit<false>(a, lds, (u >> 2) >> 2, (u >> 2) & 3, u & 3, t2, l2, w2); }
    xcd_barrier(bar);

#if PROBE_DUP == 3 || PROBE_DUP == 8
    { PHASE_IDS(t3, l3, w3); for (int u = vcu; u < 256; u += G) sb_unit<true>(a, lds, u >> 3, u & 7, 0, t3, l3, w3); }
#endif
#if PROBE_DUP == 3 || PROBE_DUP == 9
    { PHASE_IDS(t4, l4, w4); for (int u = vcu; u < 256; u += G) sb_stream(a, lds, (u >> 1) >> 3, (u >> 1) & 7, 16 * (u & 1), t4, l4, w4); }
#endif
    { PHASE_IDS(t3, l3, w3); for (int u = vcu; u < 256; u += G) sb_unit<true>(a, lds, u >> 3, u & 7, 0, t3, l3, w3); }
    { PHASE_IDS(t4, l4, w4); for (int u = vcu; u < 256; u += G) sb_stream(a, lds, (u >> 1) >> 3, (u >> 1) & 7, 16 * (u & 1), t4, l4, w4); }
    xcd_barrier(bar);

    {
        pg8::Gemm g{(const pg8::bf16_t*)R0, (const pg8::bf16_t*)(ws + WS_WOUT), M, DM, DM, 0}; pg8::StaticOrder S; S.init(M, DM, G, bx);
        pg8::EpiRes1 E{a.xp, a.xs, a.out, (pg8::bf16_t*)(R0 + REG_E), (float*)(ws + WS_SSQ)};
        pg8::gemm_phase<pg8::EpiRes1, pg8::StaticOrder, true, true>(lds, g, S, E);
#if PROBE_DUP == 4
        pg8::gemm_phase<pg8::EpiRes1, pg8::StaticOrder, true, true>(lds, g, S, E);
#endif
    }
    xcd_barrier(bar);

    {
        pg8::Gemm g{(const pg8::bf16_t*)(R0 + REG_E), (const pg8::bf16_t*)(ws + WS_WUP), M, FF, DM, 0}; pg8::StaticOrder S; S.init(M, FF, G, bx);
        pg8::EpiUp E{(pg8::bf16_t*)(R0 + 4 * REG_E), (const float*)(ws + WS_SSQ)};
#if STAGGER
        stagger((unsigned)bx, 0u);
#endif
        pg8::gemm_phase<pg8::EpiUp, pg8::StaticOrder, true, true>(lds, g, S, E);
#if PROBE_DUP == 5
        pg8::gemm_phase<pg8::EpiUp, pg8::StaticOrder, true, true>(lds, g, S, E);
#endif
#if PROBE_DUP == 7
        { pg8::EpiNull EN{(float*)(ws + WS_SSQ)}; pg8::gemm_phase<pg8::EpiNull, pg8::StaticOrder, true, true>(lds, g, S, EN); }
#endif
#if PROBE_DUP == 10 || PROBE_DUP == 11
        { pg8::EpiLinear EL{(pg8::bf16_t*)(R0 + 2 * REG_E)}; pg8::gemm_phase<pg8::EpiLinear, pg8::StaticOrder, true, true>(lds, g, S, EL); }
#endif
    }
    xcd_barrier(bar);

    {
        pg8::Gemm g{(const pg8::bf16_t*)(R0 + 4 * REG_E), (const pg8::bf16_t*)(ws + WS_WDN), MP, DM, FF, 0}; pg8::StaticOrder S; S.init(MP, DM, G, bx);
        pg8::EpiDown E{a.out};
        pg8::gemm_phase<pg8::EpiDown, pg8::StaticOrder, true, true>(lds, g, S, E);
    }
    float* part = (float*)(R0 + 2 * REG_E);
    for (int mu = bx; mu < 256; mu += G) {
        const int kc = mu & 15, tile = mu >> 4;
        pg8::Gemm g{(const pg8::bf16_t*)(R0 + 4 * REG_E) + kc * 256, (const pg8::bf16_t*)(ws + WS_WDN) + kc * 256, M, DM, FF, 4};
        pg8::OneUnit S{256 + (tile >> 2), tile & 3};
        pg8::EpiPartial E{part + (size_t)kc * MS * DM};
        pg8::gemm_phase<pg8::EpiPartial, pg8::OneUnit, true, true>(lds, g, S, E);
    }
    xcd_barrier(bar);
    {
        GAS f32x4* y4 = (GAS f32x4*)(a.out + (size_t)MP * DM); const GAS f32x4* p4 = (const GAS f32x4*)part;
        for (int i = bx * (NWAVES * 64) + tid; i < MS * DM / 4; i += G * NWAVES * 64) {
            f32x4 pv[16];
#pragma unroll
            for (int kc = 0; kc < 16; ++kc) pv[kc] = p4[(size_t)kc * (MS * DM / 4) + i];
            f32x4 v = y4[i];
#pragma unroll
            for (int kc = 0; kc < 16; ++kc) v += pv[kc];
            y4[i] = v;
        }
    }
}

extern "C" void kernel_launch(void* const* d_in, const int* in_sizes, int n_in, void* d_out, int out_size, void* d_ws, size_t ws_size, hipStream_t stream) {
    static int grid = 0;
    if (grid == 0) {
        if (n_in != 14 || in_sizes[0] != MP * DM || out_size != (int)O_END || ws_size < WS_END) {
            fprintf(stderr, "kernel_launch: unexpected shapes: n_in %d in0 %d out %d ws %zu (need %zu)\n", n_in, n_in > 0 ? in_sizes[0] : -1, out_size, ws_size, (size_t)WS_END); grid = -1; return; }
        int dev = 0, cus = 0, per_cu = 0;
        if (hipGetDevice(&dev) != hipSuccess || hipDeviceGetAttribute(&cus, hipDeviceAttributeMultiprocessorCount, dev) != hipSuccess) { grid = -1; return; }
        if (hipFuncSetAttribute((const void*)mk_fwd, hipFuncAttributeMaxDynamicSharedMemorySize, LDS_BYTES) != hipSuccess) { fprintf(stderr, "kernel_launch: hipFuncSetAttribute failed\n"); grid = -1; return; }
        if (hipOccupancyMaxActiveBlocksPerMultiprocessor(&per_cu, (const void*)mk_fwd, NWAVES * 64, LDS_BYTES) != hipSuccess || per_cu < 1) { fprintf(stderr, "kernel_launch: occupancy query reports %d blocks per CU\n", per_cu); }
        (void)hipGetLastError();
        grid = cus;
    }
    if (grid < 0) return;
    if (hipMemsetAsync((char*)d_ws + WS_CTL, 0, CTL_ZERO_BYTES, stream) != hipSuccess) return;
    Args a{};
    a.xp = (const float*)d_in[0]; a.xs = (const float*)d_in[1]; a.ck = (const float*)d_in[2]; a.cv = (const float*)d_in[3]; a.st = (const float*)d_in[4];
    a.nmix = (const float*)d_in[5]; a.win = (const float*)d_in[6]; a.rnw = (const float*)d_in[7]; a.qnw = (const float*)d_in[8]; a.knw = (const float*)d_in[9];
    a.wout = (const float*)d_in[10]; a.nmlp = (const float*)d_in[11]; a.wup = (const float*)d_in[12]; a.wdn = (const float*)d_in[13];
    a.out = (float*)d_out; a.ws = (unsigned char*)d_ws;
    hipLaunchKernelGGL(mk_fwd, dim3(grid), dim3(NWAVES * 64), LDS_BYTES, stream, a);
}
```

```cpp
#ifndef PROBE_DUP
#define PROBE_DUP 0
#endif
#include <hip/hip_runtime.h>
#include <cstdio>
#include <cstdint>
#include <cmath>
namespace pg8 {
#define PG8_LAS __attribute__((address_space(3)))
typedef unsigned short bf16_t;
typedef short bf16x8 __attribute__((ext_vector_type(8)));
typedef float f32x4 __attribute__((ext_vector_type(4)));
typedef unsigned u32x4 __attribute__((ext_vector_type(4)));
constexpr int BM = 256, BK = 64, HALF = 128, HTB = HALF * BK * 2  , STAGE_BYTES = 8 * HTB, NXCD = 8, WGM = 8;

__host__ __device__ __forceinline__ int lds_byte(int r, int c) { const int st = (r >> 4) * 2 + (c >> 5), rr = r & 15, cc = c & 31, ob = rr * 64 + cc * 2; return st * 1024 + (ob ^ (((ob >> 9) & 1) << 5)); }
__host__ __device__ __forceinline__ void stage_rc(int b, int& R, int& C) { const int st = b / 1024, sb = b % 1024, swz = sb ^ (((sb >> 9) & 1) << 5); R = (st >> 1) * 16 + swz / 64; C = (st & 1) * 32 + (swz % 64) / 2; }
__host__ __device__ __forceinline__ int perm32(int rho) { const int n = rho >> 4, i = rho & 15; return 8 * (i >> 2) + 4 * n + (i & 3); }

struct Unit { int pm, pn; };
struct Gemm { const bf16_t* A; const bf16_t* Bt; int M, N, K; int nt; };

struct StaticOrder {
    int nM, nN, nwg, G, c;
    __host__ __device__ void init(int M, int N, int G_, int c_) { nM = M / BM; nN = N / BM; nwg = nM * nN; G = G_; c = c_; }
    __host__ __device__ bool next(int i, Unit& u) const {
        const long L = (long)i * G + c; if (L >= nwg) return false;
        int wgid = (int)L; { const int q = nwg / NXCD, r = nwg % NXCD, xcd = wgid % NXCD, off = wgid / NXCD; wgid = (xcd < r ? xcd * (q + 1) : r * (q + 1) + (xcd - r) * q) + off; }
        const int nig = WGM * nN, gid = wgid / nig, fm = gid * WGM, gsz = (nM - fm) < WGM ? (nM - fm) : WGM;
        u.pm = fm + ((wgid % nig) % gsz); u.pn = (wgid % nig) / gsz; return true;
    }
    __device__ __forceinline__ void a_ready(const Unit&) const {}
    __device__ __forceinline__ void done(const Unit&) const {}
};

__device__ __forceinline__ unsigned cvt_pk_bf16(float lo, float hi) { unsigned r; asm volatile("v_cvt_pk_bf16_f32 %0, %1, %2" : "=v"(r) : "v"(lo), "v"(hi)); return r; }
typedef float f32x2 __attribute__((ext_vector_type(2)));
typedef unsigned u32x2 __attribute__((ext_vector_type(2)));
typedef float f32x2_t __attribute__((ext_vector_type(2))); typedef __bf16 bf16x2_t __attribute__((ext_vector_type(2)));
__device__ __forceinline__ unsigned cvtpk(float lo, float hi) { f32x2_t v = {lo, hi}; bf16x2_t b = __builtin_convertvector(v, bf16x2_t); return __builtin_bit_cast(unsigned, b); }
__device__ __forceinline__ void store8(bf16_t* p, const f32x4 a, const f32x4 b) { u32x4 w; w.x = cvtpk(a[0], a[1]); w.y = cvtpk(a[2], a[3]); w.z = cvtpk(b[0], b[1]); w.w = cvtpk(b[2], b[3]); *(u32x4*)p = w; }
__device__ __forceinline__ float sigmoidf_fast(float x) { return __builtin_amdgcn_rcpf(1.0f + __builtin_amdgcn_exp2f(-1.4426950408889634f * x)); }
__device__ __forceinline__ float sumsq4(const f32x4 a) { return (a[0] * a[0] + a[1] * a[1]) + (a[2] * a[2] + a[3] * a[3]); }

__device__ __forceinline__ float xsum_fq(float s) {
    auto r = __builtin_amdgcn_permlane16_swap(__float_as_uint(s), __float_as_uint(s), false, false); const float t = __uint_as_float(r[0]) + __uint_as_float(r[1]);
    auto q = __builtin_amdgcn_permlane32_swap(__float_as_uint(t), __float_as_uint(t), false, false); return __uint_as_float(q[0]) + __uint_as_float(q[1]);
}
constexpr int E_MP = 65536;
constexpr size_t E_REG = (size_t)66560 * 1024;
constexpr size_t EO_KP = 68157440, EO_VP = 135266304, EO_KS = 206569472, EO_VS = 207618048;

__device__ __forceinline__ unsigned ror8(unsigned x) { return (unsigned)__builtin_amdgcn_mov_dpp((int)x, 0x128, 0xf, 0xf, true); }
__device__ __forceinline__ u32x4 ror8v(const u32x4 v) { u32x4 r; r.x = ror8(v.x); r.y = ror8(v.y); r.z = ror8(v.z); r.w = ror8(v.w); return r; }
__device__ __forceinline__ u32x4 pack8(const f32x4 a, const f32x4 b) { u32x4 w; w.x = cvtpk(a[0], a[1]); w.y = cvtpk(a[2], a[3]); w.z = cvtpk(b[0], b[1]); w.w = cvtpk(b[2], b[3]); return w; }
__device__ __forceinline__ void store_rows_bf16(bf16_t* grp, size_t ld, int fr, int fq, const u32x4 P0, const u32x4 P1) {
    const bool lo = fr < 8; const u32x4 snd = lo ? P1 : P0, rcv = ror8v(snd);
    bf16_t* a = grp + (size_t)(fr & 7) * ld + (fq + 4 * (fr >> 3)) * 8;
    __builtin_nontemporal_store(lo ? P0 : rcv, (u32x4*)a); __builtin_nontemporal_store(lo ? rcv : P1, (u32x4*)(a + 8 * ld));
}
__device__ __forceinline__ void store_rows_f32(float* grp, size_t ld, int fr, int fq, const f32x4 V0, const f32x4 V1) {
    const bool lo = fr < 8; const u32x4 snd = __builtin_bit_cast(u32x4, lo ? V1 : V0), rcv = ror8v(snd);
    float* a = grp + (size_t)(fr & 7) * ld + (2 * fq + (fr >> 3)) * 4;
    __builtin_nontemporal_store(lo ? __builtin_bit_cast(u32x4, V0) : rcv, (u32x4*)a); __builtin_nontemporal_store(lo ? rcv : __builtin_bit_cast(u32x4, V1), (u32x4*)(a + 8 * ld));
}
struct RowPair { u32x4 a, b; };
__device__ __forceinline__ RowPair load_rows_f32(const float* grp, size_t ld, int fr, int fq) {
    const float* a = grp + (size_t)(fr & 7) * ld + (2 * fq + (fr >> 3)) * 4; RowPair r; r.a = __builtin_nontemporal_load((const u32x4*)a); r.b = __builtin_nontemporal_load((const u32x4*)(a + 8 * ld)); return r;
}
__device__ __forceinline__ void unswap_rows_f32(const RowPair r, int fr, f32x4& V0, f32x4& V1) {
    const bool lo = fr < 8; const u32x4 snd = lo ? r.b : r.a, rcv = ror8v(snd);
    V0 = __builtin_bit_cast(f32x4, lo ? r.a : rcv); V1 = __builtin_bit_cast(f32x4, lo ? rcv : r.b);
}

struct EpiIn {
    static constexpr bool PERM = true, AFTER_DRAIN = false, DUP_OK = true;
    bf16_t* R; float* out; const float* rope; const float* qw; const float* kw; PG8_LAS float* xch; int force;
    __device__ __forceinline__ void operator()(const f32x4 (&acc)[2][2][4][2], const Unit& u, int wr, int wc, int fr, int fq) const {
        const int tt0 = u.pn >> 2, tt = (force == 1) ? 2 : tt0, hq = u.pn & 3;
        const int rowg = u.pm * BM + wr * 64;
        bf16_t* base = R + (size_t)tt0 * E_REG + hq * 256 + 64 * wc;
        if (tt <= 1) {
            const float lgk = (tt == 1) ? -__builtin_amdgcn_logf(1.0f - __builtin_amdgcn_exp2f(-5.0f - (float)hq)) : 0.f;
            const float sc0 = (tt == 1) ? 0.0625f : 1.0f;
            const int cl = 32 * wc + 8 * fq;
            f32x4 tb[2][4];
#define ROPE_LD(g_) do { const int row_ = rowg + fr + ((g_) >> 2) * HALF + ((g_) & 3) * 16; const int pos_ = (row_ < E_MP) ? (row_ & 4095) : (4096 + (row_ & 31)); \
                const f32x4* tp_ = (const f32x4*)(rope + ((size_t)pos_ * 128 + cl) * 2); tb[(g_) & 1][0] = tp_[0]; tb[(g_) & 1][1] = tp_[1]; tb[(g_) & 1][2] = tp_[2]; tb[(g_) & 1][3] = tp_[3]; } while (0)
            ROPE_LD(0);
#pragma unroll
            for (int gi = 0; gi < 8; ++gi) {
                const int ai = gi >> 2, m = gi & 3;
                if (gi < 7) ROPE_LD(gi + 1);
                asm volatile("" ::: "memory");
                const int rowj = rowg + fr + ai * HALF + m * 16;
                const float sc = sc0 * __builtin_amdgcn_exp2f(lgk * (float)((rowj < E_MP) ? (rowj & 63) : (rowj & 31)));
                f32x4 o1[2], o2[2];
#pragma unroll
                for (int n = 0; n < 2; ++n) {
                    const f32x4 t0 = tb[gi & 1][2 * n], t1 = tb[gi & 1][2 * n + 1], x1 = acc[ai][0][m][n], x2 = acc[ai][1][m][n];
                    o1[n] = (f32x4){x1[0] * t0[0] - x2[0] * t0[1], x1[1] * t0[2] - x2[1] * t0[3], x1[2] * t1[0] - x2[2] * t1[1], x1[3] * t1[2] - x2[3] * t1[3]} * sc;
                    o2[n] = (f32x4){x1[0] * t0[1] + x2[0] * t0[0], x1[1] * t0[3] + x2[1] * t0[2], x1[2] * t1[1] + x2[2] * t1[0], x1[3] * t1[3] + x2[3] * t1[2]} * sc;
                }
                store_rows_bf16(base + (size_t)(rowg + ai * HALF + m * 16) * 1024, 1024, fr, fq, pack8(o1[0], o1[1]), pack8(o2[0], o2[1]));
            }
#undef ROPE_LD
        } else if (tt == 4 || tt == 5) {
            const float* wsrc = ((tt == 4) ? qw : kw) + 64 * (wc & 1) + 8 * fq;
            const f32x4 w00 = *(const f32x4*)(wsrc), w01 = *(const f32x4*)(wsrc + 4), w10 = *(const f32x4*)(wsrc + 32), w11 = *(const f32x4*)(wsrc + 36);
            const float osc = (tt == 4) ? 0.08838834764831845f * 1.4426950408889634f : 1.0f;
#pragma unroll
            for (int ai = 0; ai < 2; ++ai)
#pragma unroll
                for (int m = 0; m < 4; ++m) {
                    float s = (sumsq4(acc[ai][0][m][0]) + sumsq4(acc[ai][0][m][1])) + (sumsq4(acc[ai][1][m][0]) + sumsq4(acc[ai][1][m][1]));
                    s = xsum_fq(s);
                    if (fq == 0) xch[(ai * HALF + wr * 64 + m * 16 + fr) * 4 + wc] = s;
                }
            asm volatile("s_waitcnt lgkmcnt(0)" ::: "memory"); __builtin_amdgcn_s_barrier(); asm volatile("" ::: "memory");
            float* ok = ((u.pm * BM < E_MP) ? out + EO_KP : out + EO_KS - (size_t)E_MP * 1024) + hq * 256 + 64 * wc;
#pragma unroll
            for (int ai = 0; ai < 2; ++ai)
#pragma unroll
                for (int m = 0; m < 4; ++m) {
                    const int rl = ai * HALF + wr * 64 + m * 16 + fr; const size_t grow = (size_t)(rowg + ai * HALF + m * 16);
                    const f32x4 p = *(const PG8_LAS f32x4*)(xch + rl * 4);
                    const float rstd = osc / sqrtf(((wc < 2) ? (p[0] + p[1]) : (p[2] + p[3])) * (1.0f / 128.0f) + 1e-6f);
                    const f32x4 v00 = acc[ai][0][m][0] * rstd * w00, v01 = acc[ai][0][m][1] * rstd * w01, v10 = acc[ai][1][m][0] * rstd * w10, v11 = acc[ai][1][m][1] * rstd * w11;
                    if (tt == 5 && force != 2) { store_rows_f32(ok + grow * 1024, 1024, fr, fq, v00, v01); store_rows_f32(ok + grow * 1024 + 32, 1024, fr, fq, v10, v11); }
                    store_rows_bf16(base + grow * 1024, 1024, fr, fq, pack8(v00, v01), pack8(v10, v11));
                }
        } else if (tt == 3 || tt == 7) {
            bf16_t* gb_ = R + (size_t)3 * E_REG + 128 * ((tt == 3 ? 0 : 4) + hq) + 32 * wc + 8 * fq;
#pragma unroll
            for (int ai = 0; ai < 2; ++ai)
#pragma unroll
                for (int m = 0; m < 4; ++m) {
                    f32x4 v0 = acc[ai][0][m][0], v1 = acc[ai][0][m][1];
#pragma unroll
                    for (int e = 0; e < 4; ++e) { v0[e] *= __builtin_amdgcn_rcpf((1.0f + __builtin_amdgcn_exp2f(-1.4426950408889634f * v0[e])) * (1.0f + __builtin_amdgcn_exp2f(-1.4426950408889634f * acc[ai][1][m][0][e])));
                        v1[e] *= __builtin_amdgcn_rcpf((1.0f + __builtin_amdgcn_exp2f(-1.4426950408889634f * v1[e])) * (1.0f + __builtin_amdgcn_exp2f(-1.4426950408889634f * acc[ai][1][m][1][e]))); }
                    __builtin_nontemporal_store(pack8(v0, v1), (u32x4*)(gb_ + (size_t)(rowg + fr + ai * HALF + m * 16) * 1024));
                }
        } else {
            float* ov = ((u.pm * BM < E_MP) ? out + EO_VP : out + EO_VS - (size_t)E_MP * 1024) + hq * 256 + 64 * wc;
#pragma unroll
            for (int ai = 0; ai < 2; ++ai)
#pragma unroll
                for (int m = 0; m < 4; ++m) {
                    const size_t grow = (size_t)(rowg + ai * HALF + m * 16);
                    f32x4 v[2][2];
#pragma unroll
                    for (int bj = 0; bj < 2; ++bj) {
                        v[bj][0] = acc[ai][bj][m][0]; v[bj][1] = acc[ai][bj][m][1];
                        if (tt >= 7) {
#pragma unroll
                            for (int e = 0; e < 4; ++e) { v[bj][0][e] = sigmoidf_fast(v[bj][0][e]); v[bj][1][e] = sigmoidf_fast(v[bj][1][e]); }
                        }
                    }
                    if (tt == 6 && force != 2) { store_rows_f32(ov + grow * 1024, 1024, fr, fq, v[0][0], v[0][1]); store_rows_f32(ov + grow * 1024 + 32, 1024, fr, fq, v[1][0], v[1][1]); }
                    store_rows_bf16(base + grow * 1024, 1024, fr, fq, pack8(v[0][0], v[0][1]), pack8(v[1][0], v[1][1]));
                }
        }
    }
};

struct EpiRes1 {
    static constexpr bool PERM = true, AFTER_DRAIN = false, DUP_OK = true;
    const float* xp; const float* xs; float* out; bf16_t* XB; float* SSQ;
    __device__ __forceinline__ void operator()(const f32x4 (&acc)[2][2][4][2], const Unit& u, int wr, int wc, int fr, int fq) const {
        const int rowg = u.pm * BM + wr * 64, colw = u.pn * BM + 64 * wc;
        const float* xb = ((u.pm * BM < E_MP) ? xp : xs - (size_t)E_MP * 1024) + colw;
        RowPair xv[2][2];
#define RES_LD(g_) do { const size_t off_ = (size_t)(rowg + ((g_) >> 2) * HALF + ((g_) & 3) * 16) * 1024; xv[(g_) & 1][0] = load_rows_f32(xb + off_, 1024, fr, fq); xv[(g_) & 1][1] = load_rows_f32(xb + off_ + 32, 1024, fr, fq); } while (0)
        RES_LD(0);
#pragma unroll
        for (int gi = 0; gi < 8; ++gi) {
            const int ai = gi >> 2, m = gi & 3;
            if (gi < 7) RES_LD(gi + 1);
            asm volatile("" ::: "memory");
            const size_t grow = (size_t)(rowg + ai * HALF + m * 16); float ss = 0.f;
            f32x4 v[2][2];
#pragma unroll
            for (int bj = 0; bj < 2; ++bj) {
                f32x4 x0, x1; unswap_rows_f32(xv[gi & 1][bj], fr, x0, x1);
                v[bj][0] = acc[ai][bj][m][0] + x0; v[bj][1] = acc[ai][bj][m][1] + x1;
                ss += sumsq4(v[bj][0]) + sumsq4(v[bj][1]);
                store_rows_f32(out + grow * 1024 + colw + 32 * bj, 1024, fr, fq, v[bj][0], v[bj][1]);
            }
            store_rows_bf16(XB + grow * 1024 + colw, 1024, fr, fq, pack8(v[0][0], v[0][1]), pack8(v[1][0], v[1][1]));
            ss = xsum_fq(ss);
            if (fq == 0) SSQ[(grow + fr) * 16 + u.pn * 4 + wc] = ss;
        }
#undef RES_LD
    }
};

struct EpiUp {
    static constexpr bool PERM = true, AFTER_DRAIN = false, DUP_OK = true;
    bf16_t* H; const float* SSQ;
    __device__ __forceinline__ void operator()(const f32x4 (&acc)[2][2][4][2], const Unit& u, int wr, int wc, int fr, int fq) const {
        const int rowg = u.pm * BM + wr * 64, colw = u.pn * BM + 64 * wc;
        f32x4 sq[2][4];
#pragma unroll
        for (int ai = 0; ai < 2; ++ai)
#pragma unroll
            for (int m = 0; m < 4; ++m) sq[ai][m] = *(const f32x4*)(SSQ + (size_t)(rowg + fr + ai * HALF + m * 16) * 16 + 4 * fq);
        asm volatile("" ::: "memory");
#pragma unroll
        for (int ai = 0; ai < 2; ++ai)
#pragma unroll
            for (int m = 0; m < 4; ++m) {
                float t = (sq[ai][m][0] + sq[ai][m][1]) + (sq[ai][m][2] + sq[ai][m][3]);
                t = xsum_fq(t);
                const float r2 = 1.0f / (t * (1.0f / 1024.0f) + 1e-6f);
                f32x4 v[2][2];
#pragma unroll
                for (int bj = 0; bj < 2; ++bj) {
                    v[bj][0] = acc[ai][bj][m][0]; v[bj][1] = acc[ai][bj][m][1];
#pragma unroll
                    for (int e = 0; e < 4; ++e) { const float a = fmaxf(v[bj][0][e], 0.f), b = fmaxf(v[bj][1][e], 0.f); v[bj][0][e] = a * a * r2; v[bj][1][e] = b * b * r2; }
                }
                store_rows_bf16(H + (size_t)(rowg + ai * HALF + m * 16) * 4096 + colw, 4096, fr, fq, pack8(v[0][0], v[0][1]), pack8(v[1][0], v[1][1]));
            }
    }
};

struct EpiDown {
    static constexpr bool PERM = true, AFTER_DRAIN = false, DUP_OK = false;
    float* out;
    __device__ __forceinline__ void operator()(const f32x4 (&acc)[2][2][4][2], const Unit& u, int wr, int wc, int fr, int fq) const {
        const int rowg = u.pm * BM + wr * 64, colw = u.pn * BM + 64 * wc;
        RowPair xv[2][2];
#define DN_LD(g_) do { const float* o_ = out + (size_t)(rowg + ((g_) >> 2) * HALF + ((g_) & 3) * 16) * 1024 + colw; xv[(g_) & 1][0] = load_rows_f32(o_, 1024, fr, fq); xv[(g_) & 1][1] = load_rows_f32(o_ + 32, 1024, fr, fq); } while (0)
        DN_LD(0);
#pragma unroll
        for (int gi = 0; gi < 8; ++gi) {
            const int ai = gi >> 2, m = gi & 3;
            if (gi < 7) DN_LD(gi + 1);
            asm volatile("" ::: "memory");
            float* o = out + (size_t)(rowg + ai * HALF + m * 16) * 1024 + colw;
#pragma unroll
            for (int bj = 0; bj < 2; ++bj) {
                f32x4 x0, x1; unswap_rows_f32(xv[gi & 1][bj], fr, x0, x1);
                store_rows_f32(o + 32 * bj, 1024, fr, fq, acc[ai][bj][m][0] + x0, acc[ai][bj][m][1] + x1);
            }
        }
#undef DN_LD
    }
};

struct OneUnit {
    int pm, pn;
    __device__ __forceinline__ bool next(int i, Unit& u) const { if (i != 0) return false; u.pm = pm; u.pn = pn; return true; }
    __device__ __forceinline__ void a_ready(const Unit&) const {}
    __device__ __forceinline__ void done(const Unit&) const {}
};
struct EpiPartial {
    static constexpr bool PERM = true, AFTER_DRAIN = false, DUP_OK = false;
    float* part;
    __device__ __forceinline__ void operator()(const f32x4 (&acc)[2][2][4][2], const Unit& u, int wr, int wc, int fr, int fq) const {
        const int rowg = (u.pm - 256) * BM + wr * 64, colw = u.pn * BM + 64 * wc;
#pragma unroll
        for (int ai = 0; ai < 2; ++ai)
#pragma unroll
            for (int m = 0; m < 4; ++m)
#pragma unroll
                for (int bj = 0; bj < 2; ++bj) store_rows_f32(part + (size_t)(rowg + ai * HALF + m * 16) * 1024 + colw + 32 * bj, 1024, fr, fq, acc[ai][bj][m][0], acc[ai][bj][m][1]);
    }
};

struct EpiNull {
    static constexpr bool PERM = true, AFTER_DRAIN = false, DUP_OK = false;
    float* sink;
    __device__ __forceinline__ void operator()(const f32x4 (&acc)[2][2][4][2], const Unit& u, int wr, int wc, int fr, int fq) const {
        float t = 0.f;
#pragma unroll
        for (int ai = 0; ai < 2; ++ai)
#pragma unroll
            for (int bj = 0; bj < 2; ++bj)
#pragma unroll
                for (int m = 0; m < 4; ++m)
#pragma unroll
                    for (int n = 0; n < 2; ++n) t += (acc[ai][bj][m][n][0] + acc[ai][bj][m][n][1]) + (acc[ai][bj][m][n][2] + acc[ai][bj][m][n][3]);
        if (t == 123456.789f) sink[u.pm * 7 + u.pn + wr + wc + fr + fq] = t;
    }
};

struct EpiLinear {
    static constexpr bool PERM = true, AFTER_DRAIN = false, DUP_OK = false;
    bf16_t* sink;
    __device__ __forceinline__ void operator()(const f32x4 (&acc)[2][2][4][2], const Unit& u, int wr, int wc, int fr, int fq) const {
#if PROBE_DUP == 11
        const int l_ = fq * 16 + fr;
        bf16_t* base = sink + (size_t)((u.pm * 16 + u.pn) & 255) * 131072 + (size_t)(l_ >> 3) * 1024 + (wr * 4 + wc) * 64 + (l_ & 7) * 8;
#define LIN_STEP 8192
#else
        bf16_t* base = sink + (size_t)((u.pm * 16 + u.pn) & 255) * 65536 + (size_t)(wr * 4 + wc) * 8192 + (fq * 16 + fr) * 8;
#define LIN_STEP 512
#endif
#pragma unroll
        for (int ai = 0; ai < 2; ++ai)
#pragma unroll
            for (int m = 0; m < 4; ++m)
#pragma unroll
                for (int bj = 0; bj < 2; ++bj) store8(base + ((ai * 4 + m) * 2 + bj) * LIN_STEP, acc[ai][bj][m][0], acc[ai][bj][m][1]);
    }
};
template <class Epi, class Sched, bool ALIGN_EPI = false, bool SP2 = false>
__device__ __forceinline__ void gemm_phase(PG8_LAS unsigned char* lds, const Gemm g, const Sched& S, const Epi& E) {
    int tid_ = threadIdx.x; asm volatile("" : "+v"(tid_));
    const int tid = tid_, wid = __builtin_amdgcn_readfirstlane(tid >> 6), lane = tid & 63, wr = wid >> 2, wc = wid & 3, fr = lane & 15, fq = lane >> 4;
    const int K = g.K, nt = g.nt ? g.nt : K / BK;
    unsigned voffA[2], voffB[2];
#pragma unroll
    for (int i = 0; i < 2; ++i) { int R, C; stage_rc(tid * 16 + i * 8192, R, C); const int Rb = Epi::PERM ? ((R & ~31) + perm32(R & 31)) : R;
        voffA[i] = (unsigned)(R * K + C) * 2u; voffB[i] = (unsigned)(Rb * K + C) * 2u; }
    const size_t kstep = (size_t)(BK * 2);
    const size_t hstep = (size_t)HALF * K * 2;
    const size_t tstep = 2 * hstep;
    const unsigned ldsw = (unsigned)wid * 1024u;
    const int aoff = lds_byte(wr * 64 + fr, fq * 8), boff = lds_byte(wc * 32 + fr, fq * 8);
#define PG8_SA(b, h) (((b) * 2 + (h)) * HTB)
#define PG8_SB(b, h) ((4 + (b) * 2 + (h)) * HTB)
#define PG8_STAGE(bufoff, gbase, voff) do { _Pragma("unroll") for (int _i = 0; _i < 2; ++_i) \
        __builtin_amdgcn_global_load_lds((const unsigned*)((const char*)(gbase) + (voff)[_i]), (PG8_LAS unsigned*)(lds + (bufoff) + ldsw + _i * 8192), 16, 0, 0); } while (0)
#define PG8_LDA(dst, b, h) do { _Pragma("unroll") for (int m = 0; m < 4; ++m) _Pragma("unroll") for (int k = 0; k < 2; ++k) dst[m][k] = *(const PG8_LAS bf16x8*)(lds + PG8_SA(b, h) + aoff + m * 2048 + k * 1024); } while (0)
#define PG8_LDB(dst, b, h) do { _Pragma("unroll") for (int n = 0; n < 2; ++n) _Pragma("unroll") for (int k = 0; k < 2; ++k) dst[n][k] = *(const PG8_LAS bf16x8*)(lds + PG8_SB(b, h) + boff + n * 2048 + k * 1024); } while (0)
#define PG8_MMA(ai, bj, At, Bt) do { __builtin_amdgcn_s_setprio(1); _Pragma("unroll") for (int m = 0; m < 4; ++m) _Pragma("unroll") for (int n = 0; n < 2; ++n) _Pragma("unroll") for (int k = 0; k < 2; ++k) \
        acc[ai][bj][m][n] = __builtin_amdgcn_mfma_f32_16x16x32_bf16(Bt[n][k], At[m][k], acc[ai][bj][m][n], 0, 0, 0); __builtin_amdgcn_s_setprio(0); } while (0)
#define PG8_WAIT_V(n) asm volatile("s_waitcnt vmcnt(" #n ")" ::: "memory")
#define PG8_WAIT_L(n) asm volatile("s_waitcnt lgkmcnt(" #n ")" ::: "memory")
#define PG8_BAR __builtin_amdgcn_s_barrier()
#define PG8_SCHED __builtin_amdgcn_sched_barrier(0)
    Unit cur, nxt; int ui = 0;
    if (!S.next(0, cur)) return;
    f32x4 acc[2][2][4][2];
#pragma unroll
    for (int a = 0; a < 2; ++a)
#pragma unroll
        for (int b = 0; b < 2; ++b)
#pragma unroll
            for (int m = 0; m < 4; ++m)
#pragma unroll
                for (int n = 0; n < 2; ++n) acc[a][b][m][n] = (f32x4){0.f, 0.f, 0.f, 0.f};
    bf16x8 At[4][2], B0[2][2], B1[2][2];
    const char* cA = (const char*)g.A + (size_t)cur.pm * tstep; const char* cB = (const char*)g.Bt + (size_t)cur.pn * tstep;
    S.a_ready(cur);
    if constexpr (SP2) {
        PG8_STAGE(PG8_SB(0, 0), cB, voffB); PG8_STAGE(PG8_SB(0, 1), cB + hstep, voffB); PG8_STAGE(PG8_SA(0, 0), cA, voffA); PG8_STAGE(PG8_SA(0, 1), cA + hstep, voffA);
        if (wr == 1) PG8_BAR;
        PG8_WAIT_V(2); PG8_BAR;
        PG8_STAGE(PG8_SB(1, 0), cB + kstep, voffB); PG8_STAGE(PG8_SA(1, 0), cA + kstep, voffA); PG8_STAGE(PG8_SB(1, 1), cB + hstep + kstep, voffB);
        PG8_WAIT_V(6); PG8_BAR;
    } else {
        PG8_STAGE(PG8_SB(0, 0), cB, voffB); PG8_STAGE(PG8_SA(0, 0), cA, voffA); PG8_STAGE(PG8_SB(0, 1), cB + hstep, voffB); PG8_STAGE(PG8_SA(0, 1), cA + hstep, voffA);
        if (wr == 1) PG8_BAR;
        PG8_WAIT_V(4); PG8_BAR;
        PG8_STAGE(PG8_SB(1, 0), cB + kstep, voffB); PG8_STAGE(PG8_SA(1, 0), cA + kstep, voffA); PG8_STAGE(PG8_SB(1, 1), cB + hstep + kstep, voffB);
        PG8_WAIT_V(6); PG8_BAR;
    }
    for (;;) {
        const bool has_next = S.next(ui + 1, nxt);
        const char* nA = has_next ? (const char*)g.A + (size_t)nxt.pm * tstep : cA; const char* nB = has_next ? (const char*)g.Bt + (size_t)nxt.pn * tstep : cB;
        for (int t = 0; t < nt; t += 2) {
            const bool last = (t == nt - 2);
            const char* a1 = cA + (size_t)(t + 1) * kstep;
            const char* a2 = last ? nA : cA + (size_t)(t + 2) * kstep; const char* b2 = last ? nB : cB + (size_t)(t + 2) * kstep;
            const char* a3 = a2 + kstep; const char* b3 = b2 + kstep;
            if (last && has_next) S.a_ready(nxt);
            if constexpr (SP2) {
            PG8_LDB(B0, 0, 0); PG8_LDB(B1, 0, 1); PG8_SCHED; PG8_LDA(At, 0, 0); PG8_STAGE(PG8_SA(1, 1), a1 + hstep, voffA);
            PG8_WAIT_V(8); PG8_WAIT_L(0); PG8_BAR; PG8_MMA(0, 0, At, B0); PG8_MMA(0, 1, At, B1); PG8_BAR; PG8_SCHED;
            PG8_LDA(At, 0, 1); PG8_STAGE(PG8_SB(0, 0), b2, voffB); PG8_STAGE(PG8_SB(0, 1), b2 + hstep, voffB); PG8_STAGE(PG8_SA(0, 0), a2, voffA);
            PG8_WAIT_V(8); PG8_WAIT_L(0); PG8_BAR; PG8_MMA(1, 0, At, B0); PG8_MMA(1, 1, At, B1); PG8_BAR; PG8_SCHED;
            PG8_LDB(B0, 1, 0); PG8_LDB(B1, 1, 1); PG8_SCHED; PG8_LDA(At, 1, 0); PG8_STAGE(PG8_SA(0, 1), a2 + hstep, voffA);
            PG8_WAIT_V(8); PG8_WAIT_L(0); PG8_BAR; PG8_MMA(0, 0, At, B0); PG8_MMA(0, 1, At, B1); PG8_BAR; PG8_SCHED;
            PG8_LDA(At, 1, 1); PG8_STAGE(PG8_SB(1, 0), b3, voffB); PG8_STAGE(PG8_SB(1, 1), b3 + hstep, voffB); PG8_STAGE(PG8_SA(1, 0), a3, voffA);
            PG8_WAIT_V(8); PG8_WAIT_L(0); PG8_BAR; PG8_MMA(1, 0, At, B0); PG8_MMA(1, 1, At, B1); PG8_BAR; PG8_SCHED;
            } else {
            PG8_LDB(B0, 0, 0); PG8_SCHED; PG8_LDA(At, 0, 0); PG8_STAGE(PG8_SA(1, 1), a1 + hstep, voffA);
            PG8_WAIT_L(8); PG8_BAR; PG8_WAIT_L(0); PG8_MMA(0, 0, At, B0); PG8_BAR; PG8_SCHED;
            PG8_LDB(B1, 0, 1); PG8_STAGE(PG8_SB(0, 0), b2, voffB);
            PG8_BAR; PG8_WAIT_L(0); PG8_MMA(0, 1, At, B1); PG8_BAR;
            PG8_LDA(At, 0, 1); PG8_STAGE(PG8_SA(0, 0), a2, voffA);
            PG8_BAR; PG8_WAIT_L(0); PG8_MMA(1, 0, At, B0); PG8_BAR; PG8_SCHED;
            PG8_STAGE(PG8_SB(0, 1), b2 + hstep, voffB);
            PG8_WAIT_V(6); PG8_BAR; PG8_MMA(1, 1, At, B1); PG8_BAR;
            PG8_LDB(B0, 1, 0); PG8_SCHED; PG8_LDA(At, 1, 0); PG8_STAGE(PG8_SA(0, 1), a2 + hstep, voffA);
            PG8_WAIT_L(8); PG8_BAR; PG8_WAIT_L(0); PG8_MMA(0, 0, At, B0); PG8_BAR; PG8_SCHED;
            PG8_LDB(B1, 1, 1); PG8_STAGE(PG8_SB(1, 0), b3, voffB);
            PG8_BAR; PG8_WAIT_L(0); PG8_MMA(0, 1, At, B1); PG8_BAR;
            PG8_LDA(At, 1, 1); PG8_STAGE(PG8_SA(1, 0), a3, voffA);
            PG8_BAR; PG8_WAIT_L(0); PG8_MMA(1, 0, At, B0); PG8_BAR; PG8_SCHED;
            PG8_STAGE(PG8_SB(1, 1), b3 + hstep, voffB);
            PG8_WAIT_V(6); PG8_BAR; PG8_MMA(1, 1, At, B1); PG8_BAR;
            }
        }
        if constexpr (ALIGN_EPI) { if (wr == 0) PG8_BAR; }
        if constexpr (!Epi::AFTER_DRAIN) { int fr_e = fr, fq_e = fq; asm volatile("" : "+v"(fr_e), "+v"(fq_e));
            E(acc, cur, wr, wc, fr_e, fq_e);
#if defined(PROBE_EPI2)
            if constexpr (Epi::DUP_OK) { asm volatile("" ::: "memory"); E(acc, cur, wr, wc, fr_e, fq_e); }
#endif
            S.done(cur); }
        if (!has_next) break;
#pragma unroll
        for (int a = 0; a < 2; ++a)
#pragma unroll
            for (int b = 0; b < 2; ++b)
#pragma unroll
                for (int m = 0; m < 4; ++m)
#pragma unroll
                    for (int n = 0; n < 2; ++n) acc[a][b][m][n] = (f32x4){0.f, 0.f, 0.f, 0.f};
        cur = nxt; cA = nA; cB = nB; ++ui;
        if constexpr (ALIGN_EPI) { if (wr == 1) PG8_BAR; }
    }
    PG8_WAIT_V(0);
    if constexpr (!ALIGN_EPI) { if (wr == 0) PG8_BAR; }
    PG8_BAR;
    if constexpr (Epi::AFTER_DRAIN) { E.fused(acc, cur, wr, wc, fr, fq, lds, wid, lane); S.done(cur); }
#undef PG8_SA
#undef PG8_SB
#undef PG8_STAGE
#undef PG8_LDA
#undef PG8_LDB
#undef PG8_MMA
#undef PG8_WAIT_V
#undef PG8_WAIT_L
#undef PG8_BAR
#undef PG8_SCHED
}
}
#define GAS __attribute__((address_space(1)))
#define LAS __attribute__((address_space(3)))
typedef unsigned short bf16;
typedef unsigned v4u __attribute__((ext_vector_type(4)));
typedef float f32x4 __attribute__((ext_vector_type(4)));
typedef short bf16x8 __attribute__((ext_vector_type(8)));
typedef GAS unsigned gu32;
typedef GAS unsigned long long gu64;
#define RLX_AGENT __ATOMIC_RELAXED, __HIP_MEMORY_SCOPE_AGENT
#define LDS_WAIT() asm volatile("s_waitcnt lgkmcnt(0)" ::: "memory")
#define VM_WAIT() asm volatile("s_waitcnt vmcnt(0)" ::: "memory")
__device__ __forceinline__ unsigned long long rt() { return __builtin_amdgcn_s_memrealtime(); }
__device__ __forceinline__ unsigned f2bf(float f) { unsigned u = __builtin_bit_cast(unsigned, f); return (u + 0x7fffu + ((u >> 16) & 1u)) >> 16; }
__device__ __forceinline__ unsigned pk2(float lo, float hi) { return f2bf(lo) | (f2bf(hi) << 16); }

#define XB_TMO      128
#define XB_XCNT(j)  (256  + 64 * (j))
#define XB_XSUB(j)  (1280 + 64 * (j))
#define XB_XGEN(j)  (2304 + 64 * (j))
#define XB_TOP      3328
#define XB_TOPGEN   3392
#define XCD_BAR_WORDS 3456
#define XB_SPIN_CAP (1u << 18)

__device__ __forceinline__ unsigned xb_ld(unsigned* p)              { return __hip_atomic_load(p, __ATOMIC_RELAXED, __HIP_MEMORY_SCOPE_AGENT); }
__device__ __forceinline__ unsigned xb_add(unsigned* p, unsigned v) { return __hip_atomic_fetch_add(p, v, __ATOMIC_RELAXED, __HIP_MEMORY_SCOPE_AGENT); }
__device__ __forceinline__ unsigned xb_xcc_id() { return (unsigned)__builtin_amdgcn_s_getreg((3 << 11) | 20) & 0xFu; }
#define XB_SPIN(cond, bar) do { unsigned _sp = 0; while (cond) { __builtin_amdgcn_s_sleep(1); \
    if ((++_sp & 255u) == 0u) { if (xb_ld(&(bar)[XB_TMO])) break; if (_sp > XB_SPIN_CAP) { atomicAdd(&(bar)[XB_TMO], 1u); break; } } } } while (0)

struct XcdBarrier {
    unsigned* bar; unsigned x;
    volatile LAS unsigned* st;
};

__device__ __forceinline__ XcdBarrier xcd_barrier_post(unsigned* bar, volatile LAS unsigned* st) {
    XcdBarrier b; b.bar = bar; b.x = xb_xcc_id(); b.st = st;
    if (threadIdx.x == 0) (void)xb_add(&bar[XB_XCNT(b.x)], 1u);
    return b;
}
__device__ __forceinline__ void xcd_barrier_complete(unsigned* bar, unsigned x, unsigned& nloc, unsigned& nx) {
    const unsigned G = gridDim.x * gridDim.y * gridDim.z;
    unsigned sum, cnt, mine, sp = 0u;
    for (;;) {
        sum = 0u; cnt = 0u; mine = 0u;
#pragma unroll
        for (unsigned j = 0; j < 16; ++j) { const unsigned c = xb_ld(&bar[XB_XCNT(j)]); sum += c; cnt += (c > 0u) ? 1u : 0u; mine = (j == x) ? c : mine; }
        if (sum == G) break;
        __builtin_amdgcn_s_sleep(1);
        if ((++sp & 255u) == 0u) { if (xb_ld(&bar[XB_TMO])) break; if (sp > XB_SPIN_CAP) { atomicAdd(&bar[XB_TMO], 1u); break; } }
    }
    nloc = mine > 0u ? mine : 1u; nx = cnt > 0u ? cnt : 1u;
}

__device__ __forceinline__ void xcd_barrier(const XcdBarrier& b) {
    asm volatile("s_waitcnt vmcnt(0)" ::: "memory");
    __syncthreads();
    if (threadIdx.x == 0) {
        unsigned* bar = b.bar;
        __builtin_amdgcn_s_waitcnt(0);
        unsigned nloc = b.st[0], nx = b.st[1];
        if (nloc == 0u) { xcd_barrier_complete(bar, b.x, nloc, nx); b.st[0] = nloc; b.st[1] = nx; }
        const unsigned old = xb_add(&bar[XB_XSUB(b.x)], 1u);
        const unsigned gen = old / nloc;
        if (old + 1u == (gen + 1u) * nloc) {
            __builtin_amdgcn_fence(__ATOMIC_RELEASE, "agent");
            asm volatile("s_waitcnt vmcnt(0)" ::: "memory");
            const unsigned og = xb_add(&bar[XB_TOP], 1u);
            const unsigned tg = og / nx;
            if (og + 1u == (tg + 1u) * nx) xb_add(&bar[XB_TOPGEN], 1u);
            else XB_SPIN(xb_ld(&bar[XB_TOPGEN]) == tg, bar);
            __builtin_amdgcn_fence(__ATOMIC_ACQUIRE, "agent");
            xb_add(&bar[XB_XGEN(b.x)], 1u);
            asm volatile("s_waitcnt vmcnt(0)" ::: "memory");
        } else {
            XB_SPIN(xb_ld(&bar[XB_XGEN(b.x)]) == gen, bar);
            __builtin_amdgcn_fence(__ATOMIC_ACQUIRE, "agent");
            asm volatile("s_waitcnt vmcnt(0)" ::: "memory");
        }
    }
    __syncthreads();
}
typedef float f32x2_pair __attribute__((ext_vector_type(2)));

constexpr int NWAVES = 8;
constexpr int DM = 1024, FF = 4096, NIN = 9216;
constexpr int MP = 65536, MS = 1024, M = MP + MS;
constexpr int PAST = 4096;
constexpr size_t MiB = 1u << 20;
constexpr size_t REG_E = (size_t)M * DM;
constexpr size_t WS_CTL = 0, CTL_ZERO_BYTES = 1 * MiB;
constexpr size_t WS_WIN = 2 * MiB, WS_WOUT = 20 * MiB, WS_WUP = 22 * MiB, WS_WDN = 30 * MiB;
constexpr size_t WS_ROPE = 38 * MiB;
constexpr size_t WS_SSQ = 43 * MiB;
constexpr size_t WS_RSS = 48 * MiB;
constexpr size_t WS_XN = 54 * MiB;
constexpr size_t WS_R = 184 * MiB;
constexpr size_t WS_END = WS_R + 9 * REG_E * 2;
static_assert(WS_ROPE + (size_t)4128 * 128 * 8 <= WS_SSQ && WS_SSQ + (size_t)M * 64 <= WS_RSS && WS_RSS + (size_t)M * 64 <= WS_XN && WS_XN + REG_E * 2 <= WS_R, "ws map");
constexpr size_t O_Y = 0, O_KP = 68157440, O_VP = 135266304, O_SP = 202375168, O_KS = 206569472, O_VS = 207618048, O_SS = 208666624, O_END = 217055232;
constexpr int CW_BAR = 4096;
constexpr int RING_BYTES = 131072, XCH_OFF = RING_BYTES + 512, MISC_OFF = 163840 - 256, LDS_BYTES = 163840;
static_assert(XCH_OFF + 8192 <= MISC_OFF && MISC_OFF + 64 <= LDS_BYTES, "LDS map");
constexpr int SW_FLAGS_LIMIT = MISC_OFF;

typedef short s16x4 __attribute__((ext_vector_type(4)));
typedef unsigned v2u __attribute__((ext_vector_type(2)));
#define DI __device__ __forceinline__
#define MFMA16(a, b, c) __builtin_amdgcn_mfma_f32_16x16x32_bf16((a), (b), (c), 0, 0, 0)
#define LBAR() do { asm volatile("s_waitcnt lgkmcnt(0)" ::: "memory"); __builtin_amdgcn_s_barrier(); asm volatile("" ::: "memory"); } while (0)
typedef short v4i16_t __attribute__((ext_vector_type(4)));
DI s16x4 trd(const LAS unsigned char* p) { return __builtin_bit_cast(s16x4, __builtin_amdgcn_ds_read_tr16_b64_v4i16((LAS v4i16_t*)p)); }
DI bf16x8 cat8(s16x4 lo, s16x4 hi) { return (bf16x8){lo[0], lo[1], lo[2], lo[3], hi[0], hi[1], hi[2], hi[3]}; }
DI float bflo(unsigned u) { return __uint_as_float(u << 16); }
DI float bfhi(unsigned u) { return __uint_as_float(u & 0xffff0000u); }
using pg8::cvtpk;
DI float wave_sum(float v) {
#pragma unroll
    for (int o = 1; o < 64; o <<= 1) v += __shfl_xor(v, o);
    return v;
}
constexpr float LOG2E = 1.4426950408889634f, LN2 = 0.6931471805599453f;

struct Args {
    const float *xp, *xs, *ck, *cv, *st, *nmix, *win, *rnw, *qnw, *knw, *wout, *nmlp, *wup, *wdn;
    float* out; unsigned char* ws;
};

DI int colpos(int n) { return (n & ~255) | (((n >> 5) & 1) << 7) | (((n >> 6) & 3) << 5) | (n & 31); }
DI void p0_transpose_item(const float* W, int K, int N, bf16* WT, const float* ksc, int pfrom, LAS float* scr, int item, int lane) {
    const int nblk = N / 32, kb = item / nblk, nb = item % nblk, k0 = 64 * kb, n0 = 32 * nb;
#pragma unroll 8
    for (int i = 0; i < 32; ++i) { const int kk = 2 * i + (lane >> 5); float v = W[(size_t)(k0 + kk) * N + n0 + (lane & 31)]; if (ksc) v *= ksc[k0 + kk]; scr[kk * 33 + (lane & 31)] = v; }
    LDS_WAIT(); asm volatile("" ::: "memory");
    const int c = lane & 7;
#pragma unroll
    for (int j = 0; j < 4; ++j) { const int n = (lane >> 3) + 8 * j; const LAS float* s = scr + (8 * c) * 33 + n;
        v4u o; o.x = cvtpk(s[0 * 33], s[1 * 33]); o.y = cvtpk(s[2 * 33], s[3 * 33]); o.z = cvtpk(s[4 * 33], s[5 * 33]); o.w = cvtpk(s[6 * 33], s[7 * 33]);
        const int nn = n0 + n; int np = (nn >= pfrom) ? colpos(nn) : nn;
        if (pfrom == 2048) {
            const bool isg = (nn >= 3072 && nn < 4096), isa = (nn >= 7168 && nn < 8192);
            if (isg || isa) { const int f = nn - (isg ? 3072 : 7168), t8 = f >> 7; np = (t8 < 4 ? 3072 + 256 * t8 : 7168 + 256 * (t8 - 4)) + (isa ? 128 : 0) + (f & 127); }
        }
        *(GAS v4u*)(WT + (size_t)np * K + k0 + 8 * c) = o; }
    LDS_WAIT(); asm volatile("" ::: "memory");
}
DI void p0_prologue(const Args& a, LAS unsigned char* lds, int vcu, int G, int wave, int lane) {
    unsigned char* ws = a.ws;
    LAS float* scr = (LAS float*)(lds + wave * 16384);
    const int gw = vcu * NWAVES + wave, NGW = G * NWAVES;
    constexpr int I_IN = (DM / 64) * (NIN / 32), I_O = (DM / 64) * (DM / 32), I_U = (DM / 64) * (FF / 32), I_D = (FF / 64) * (DM / 32);
    constexpr int NITEMS = I_IN + I_O + I_U + I_D;
    for (int it = gw; it < NITEMS; it += NGW) {
        int r = it;
        if (r < I_IN) { p0_transpose_item(a.win, DM, NIN, (bf16*)(ws + WS_WIN), nullptr, 2048, scr, r, lane); continue; } r -= I_IN;
        if (r < I_O) { p0_transpose_item(a.wout, DM, DM, (bf16*)(ws + WS_WOUT), nullptr, 0, scr, r, lane); continue; } r -= I_O;
        if (r < I_U) { p0_transpose_item(a.wup, DM, FF, (bf16*)(ws + WS_WUP), a.nmlp, 0, scr, r, lane); continue; } r -= I_U;
        p0_transpose_item(a.wdn, FF, DM, (bf16*)(ws + WS_WDN), nullptr, 0, scr, r, lane);
    }
    {
        f32x4 wv[4];
#pragma unroll
        for (int j = 0; j < 4; ++j) wv[j] = ((const GAS f32x4*)a.nmix)[lane + 64 * j];
        bf16* XN = (bf16*)(ws + WS_XN);
        for (int m = gw; m < M; m += NGW) {
            const float* xrow = (m < MP) ? a.xp + (size_t)m * DM : a.xs + (size_t)(m - MP) * DM;
            const GAS f32x4* xr = (const GAS f32x4*)xrow + lane;
            f32x4 v[4]; float s = 0.f;
#pragma unroll
            for (int j = 0; j < 4; ++j) { v[j] = __builtin_nontemporal_load(&xr[64 * j]); s += (v[j].x * v[j].x + v[j].y * v[j].y) + (v[j].z * v[j].z + v[j].w * v[j].w); }
            const float rstd = 1.0f / sqrtf(wave_sum(s) * (1.0f / DM) + 1e-6f);
            GAS v2u* o8 = (GAS v2u*)(XN + (size_t)m * DM) + lane;
#pragma unroll
            for (int j = 0; j < 4; ++j) { const f32x4 y = v[j] * rstd * wv[j]; v2u o; o.x = cvtpk(y.x, y.y); o.y = cvtpk(y.z, y.w); __builtin_nontemporal_store(o, &o8[64 * j]); }
        }
    }
    {
        float* rope = (float*)(ws + WS_ROPE);
        for (int idx = gw * 64 + lane; idx < 4128 * 128; idx += NGW * 64) {
            const int pos = idx >> 7, j = idx & 127;
            const float inv = powf(10000.0f, -(float)j * (1.0f / 128.0f));
            const float ang = (float)pos * inv;
            float sn, cs; sincosf(ang, &sn, &cs);
            *(GAS f32x2_pair*)(rope + (size_t)idx * 2) = (f32x2_pair){cs, sn};
        }
    }
}

constexpr int RT_QS = 0, RT_KS = 33792, RT_KB = 34816, RT_VS = 103424, RT_PS = 113664, RT_STS = 122880, RT_RXS = 156672;
static_assert(RT_RXS + 1024 <= SW_FLAGS_LIMIT, "retention LDS map");
DI float xsum16_32(float s) {
    auto r = __builtin_amdgcn_permlane16_swap(__float_as_uint(s), __float_as_uint(s), false, false); const float t = __uint_as_float(r[0]) + __uint_as_float(r[1]);
    auto q = __builtin_amdgcn_permlane32_swap(__float_as_uint(t), __float_as_uint(t), false, false); return __uint_as_float(q[0]) + __uint_as_float(q[1]);
}
template <bool SAMPLE, int VAR = 0>
DI void ret_unit(const Args& a, LAS unsigned char* L, int b, int h, int s, int tid, int lane, int w) {
    const int c15 = lane & 15, g = lane >> 4, q4 = c15 >> 2, p4 = c15 & 3;
    constexpr int Lc = SAMPLE ? 32 : 64, NSTEP = SAMPLE ? 1 : 64;
    const float lg2 = __builtin_amdgcn_logf(1.0f - __builtin_amdgcn_exp2f(-5.0f - (float)h));
    const size_t rowbase = SAMPLE ? (size_t)MP + 32 * b : (size_t)4096 * b;
    const bf16* RQ = (const bf16*)(a.ws + WS_R), *RK = RQ + REG_E, *RV = RQ + 2 * REG_E;
    bf16* ORET = (bf16*)(a.ws + WS_XN);
    float* RSS = (float*)(a.ws + WS_RSS);
    f32x4 S[2][4];
    const size_t sbase = ((size_t)(b * 4 + h) * 256) * 256 + 64 * s;
    {
        const float* sp0 = a.st + sbase + (size_t)(128 * (w & 1) + 32 * (w >> 1) + 4 * g) * 256 + c15;
#pragma unroll
        for (int k2 = 0; k2 < 2; ++k2)
#pragma unroll
            for (int dt = 0; dt < 4; ++dt)
#pragma unroll
                for (int r = 0; r < 4; ++r) S[k2][dt][r] = SAMPLE ? sp0[(16 * k2 + r) * 256 + 16 * dt] : 0.f;
    }
    const int jt = w >> 1, itp = w & 1, dto = w >> 1;
    const float g1 = __builtin_amdgcn_exp2f(lg2), gLm1 = __builtin_amdgcn_exp2f(lg2 * (float)(Lc - 1));
    float qd[2];
#pragma unroll
    for (int t = 0; t < 2; ++t) { const int i = 32 * itp + 16 * t + c15; qd[t] = __builtin_amdgcn_exp2f(lg2 * (float)(i + 1)); }
    v4u pq[4], pk[4], pv;
    const int vrow = tid >> 3, vpc = tid & 7;
#define RT_LOAD_Q(c) do { int tl_ = tid; asm volatile("" : "+v"(tl_));     \
        _Pragma("unroll") for (int p_ = 0; p_ < 4; ++p_) { const int idx_ = tl_ + 512 * p_, row_ = idx_ >> 5, pc_ = idx_ & 31; \
            if (!SAMPLE || row_ < 32) { const size_t go_ = (rowbase + (size_t)64 * (c) + row_) * 1024 + 256 * h + 8 * pc_; pq[p_] = *(const GAS v4u*)(RQ + go_); } \
            else { pq[p_] = (v4u){0u, 0u, 0u, 0u}; } } } while (0)
#define RT_LOAD_KV(c) do { int tl_ = tid; asm volatile("" : "+v"(tl_)); \
        _Pragma("unroll") for (int p_ = 0; p_ < 4; ++p_) { const int idx_ = tl_ + 512 * p_, row_ = idx_ >> 5, pc_ = idx_ & 31; \
            if (!SAMPLE || row_ < 32) { const size_t go_ = (rowbase + (size_t)64 * (c) + row_) * 1024 + 256 * h + 8 * pc_; pk[p_] = *(const GAS v4u*)(RK + go_); } \
            else { pk[p_] = (v4u){0u, 0u, 0u, 0u}; } } \
        if (!SAMPLE || vrow < 32) pv = *(const GAS v4u*)(RV + (rowbase + (size_t)64 * (c) + vrow) * 1024 + 256 * h + 64 * s + 8 * vpc); else pv = (v4u){0u, 0u, 0u, 0u}; } while (0)
#define RT_WRITE_Q() do { _Pragma("unroll") for (int p_ = 0; p_ < 4; ++p_) { const int idx_ = tid + 512 * p_, row_ = idx_ >> 5, pc_ = idx_ & 31; *(LAS v4u*)(L + RT_QS + row_ * 528 + pc_ * 16) = pq[p_]; } } while (0)
#define RT_WRITE_K(kb_) do { _Pragma("unroll") for (int p_ = 0; p_ < 4; ++p_) { const int idx_ = tid + 512 * p_, row_ = idx_ >> 5, pc_ = idx_ & 31; *(LAS v4u*)(L + RT_KS + (kb_) * RT_KB + row_ * 544 + pc_ * 16) = pk[p_]; } } while (0)
#define RT_WRITE_V() do { *(LAS v4u*)(L + RT_VS + vrow * 160 + vpc * 16) = pv; } while (0)
    RT_LOAD_Q(0); RT_LOAD_KV(0); RT_WRITE_Q(); RT_WRITE_K(0); RT_WRITE_V();
    for (int c = 0; c < NSTEP; ++c) {
        const int kb = c & 1;
        LBAR();
        if (c + 1 < NSTEP) RT_LOAD_KV(c + 1);
        bf16x8 bq[2][8];
        if (VAR == 1) {
#pragma unroll
            for (int ks = 0; ks < 8; ++ks) { bq[0][ks] = (bf16x8){0,0,0,0,0,0,0,0}; bq[1][ks] = bq[0][ks]; }
        } else {
            f32x4 sc[2] = {(f32x4){0.f, 0.f, 0.f, 0.f}, (f32x4){0.f, 0.f, 0.f, 0.f}};
            const LAS unsigned char* kp = L + RT_KS + kb * RT_KB + (16 * jt + c15) * 544 + g * 16;
            const LAS unsigned char* qp = L + RT_QS + (32 * itp + c15) * 528 + g * 16;
#pragma unroll
            for (int hb = 0; hb < 2; ++hb) {
                bf16x8 ak[4];
#pragma unroll
                for (int k4 = 0; k4 < 4; ++k4) { const int ks = 4 * hb + k4; ak[k4] = *(const LAS bf16x8*)(kp + ks * 64); bq[0][ks] = *(const LAS bf16x8*)(qp + ks * 64); bq[1][ks] = *(const LAS bf16x8*)(qp + 16 * 528 + ks * 64); }
                __builtin_amdgcn_sched_barrier(0);
#pragma unroll
                for (int k4 = 0; k4 < 4; ++k4) { const int ks = 4 * hb + k4; sc[0] = MFMA16(ak[k4], bq[0][ks], sc[0]); sc[1] = MFMA16(ak[k4], bq[1][ks], sc[1]); }
                __builtin_amdgcn_sched_barrier(0);
            }
#pragma unroll
            for (int t = 0; t < 2; ++t) {
                const int i = 32 * itp + 16 * t + c15, j0 = 16 * jt + 4 * g;
                float pd[4]; float lgc = lg2; asm volatile("" : "+v"(lgc));
#pragma unroll
                for (int r = 0; r < 4; ++r) { const int j = j0 + r; pd[r] = __builtin_amdgcn_exp2f(lgc * (float)(i >= j ? i : 2 * j - i)); }
                v2u o; o.x = cvtpk(sc[t][0] * pd[0], sc[t][1] * pd[1]); o.y = cvtpk(sc[t][2] * pd[2], sc[t][3] * pd[3]);
                *(LAS v2u*)(L + RT_PS + i * 144 + j0 * 2) = o;
            }
        }
#pragma unroll
        for (int k2 = 0; k2 < 2; ++k2)
#pragma unroll
            for (int dt = 0; dt < 4; ++dt) { v2u o; o.x = cvtpk(S[k2][dt][0], S[k2][dt][1]); o.y = cvtpk(S[k2][dt][2], S[k2][dt][3]);
                *(LAS v2u*)(L + RT_STS + (16 * dt + c15) * 528 + (16 * (2 * w + k2) + 4 * g) * 2) = o; }
        if (VAR != 6) LBAR();
        if (c + 1 < NSTEP) RT_LOAD_Q(c + 1);
        if (VAR != 2) {
            f32x4 oc[2] = {(f32x4){0.f, 0.f, 0.f, 0.f}, (f32x4){0.f, 0.f, 0.f, 0.f}};
            const LAS unsigned char* sp = L + RT_STS + (16 * dto + c15) * 528 + g * 16;
#pragma unroll
            for (int hb = 0; hb < 2; ++hb) {
                bf16x8 as[4];
#pragma unroll
                for (int k4 = 0; k4 < 4; ++k4) as[k4] = *(const LAS bf16x8*)(sp + (4 * hb + k4) * 64);
                __builtin_amdgcn_sched_barrier(0);
#pragma unroll
                for (int k4 = 0; k4 < 4; ++k4) { const int ks = 4 * hb + k4; oc[0] = MFMA16(as[k4], bq[0][ks], oc[0]); oc[1] = MFMA16(as[k4], bq[1][ks], oc[1]); }
                __builtin_amdgcn_sched_barrier(0);
            }
            oc[0] = oc[0] * qd[0]; oc[1] = oc[1] * qd[1];
#pragma unroll
            for (int k2 = 0; k2 < 2; ++k2) {
                const LAS unsigned char* vp = L + RT_VS + (32 * k2 + 4 * g + q4) * 160 + (16 * dto + 4 * p4) * 2;
                const bf16x8 av = cat8(trd(vp), trd(vp + 16 * 160));
#pragma unroll
                for (int t = 0; t < 2; ++t) { const int i = 32 * itp + 16 * t + c15; const LAS unsigned char* pp = L + RT_PS + i * 144 + (32 * k2 + 4 * g) * 2;
                    const bf16x8 bp = cat8(*(const LAS s16x4*)pp, *(const LAS s16x4*)(pp + 32)); oc[t] = MFMA16(av, bp, oc[t]); }
            }
#pragma unroll
            for (int t = 0; t < 2; ++t) {
                const int i = 32 * itp + 16 * t + c15;
                float ss = (oc[t][0] * oc[t][0] + oc[t][1] * oc[t][1]) + (oc[t][2] * oc[t][2] + oc[t][3] * oc[t][3]);
                ss = xsum16_32(ss);
                if (g == 0) ((LAS float*)(L + RT_RXS))[dto * 64 + i] = ss;
                if (!SAMPLE || i < 32) { v2u o; o.x = cvtpk(oc[t][0], oc[t][1]); o.y = cvtpk(oc[t][2], oc[t][3]);
                    __builtin_nontemporal_store(o, (GAS v2u*)(ORET + (rowbase + (size_t)64 * c + i) * 1024 + 256 * h + 64 * s + 16 * dto + 4 * g)); }
            }
        }
#pragma unroll
        for (int k2 = 0; k2 < 2; ++k2)
#pragma unroll
            for (int dt = 0; dt < 4; ++dt) S[k2][dt] = S[k2][dt] * g1;
#pragma unroll
        for (int ks = 0; ks < (VAR == 3 ? 0 : 2); ++ks) {
            const int tok = 32 * ks + 4 * g + q4;
            bf16x8 ak[2];
#pragma unroll
            for (int k2 = 0; k2 < 2; ++k2) { const LAS unsigned char* kp = L + RT_KS + kb * RT_KB + tok * 544 + (16 * (2 * w + k2) + 4 * p4) * 2; ak[k2] = cat8(trd(kp), trd(kp + 16 * 544)); }
#pragma unroll
            for (int dt = 0; dt < 4; ++dt) { const LAS unsigned char* vp = L + RT_VS + tok * 160 + (16 * dt + 4 * p4) * 2; const bf16x8 bv = cat8(trd(vp), trd(vp + 16 * 160));
                S[0][dt] = MFMA16(ak[0], bv, S[0][dt]); S[1][dt] = MFMA16(ak[1], bv, S[1][dt]); }
        }
#pragma unroll
        for (int k2 = 0; k2 < 2; ++k2)
#pragma unroll
            for (int dt = 0; dt < 4; ++dt) S[k2][dt] = S[k2][dt] * gLm1;
        if (c + 1 < NSTEP && VAR != 4) { RT_WRITE_Q(); RT_WRITE_K(kb ^ 1); }
        if (VAR != 6) LBAR();
        if (tid < 64 && (!SAMPLE || tid < 32)) { const LAS float* rx = (const LAS float*)(L + RT_RXS);
            RSS[(rowbase + (size_t)64 * c + tid) * 16 + h * 4 + s] = (rx[tid] + rx[64 + tid]) + (rx[128 + tid] + rx[192 + tid]); }
        if (c + 1 < NSTEP && VAR != 4) RT_WRITE_V(); else if (VAR == 4) asm volatile("" :: "v"(pk[0]), "v"(pk[1]), "v"(pk[2]), "v"(pk[3]), "v"(pv), "v"(pq[0]), "v"(pq[1]), "v"(pq[2]), "v"(pq[3]));
    }
    {
        int ln = lane; asm volatile("" : "+v"(ln));
        float* so = a.out + (SAMPLE ? O_SS : O_SP) + sbase + (size_t)(128 * (w & 1) + 32 * (w >> 1) + 4 * (ln >> 4)) * 256 + (ln & 15);
#pragma unroll
        for (int k2 = 0; k2 < 2; ++k2)
#pragma unroll
            for (int dt = 0; dt < 4; ++dt)
#pragma unroll
                for (int r = 0; r < 4; ++r) so[(16 * k2 + r) * 256 + 16 * dt] = S[k2][dt][r];
    }
    LBAR();
#undef RT_LOAD_Q
#undef RT_LOAD_KV
#undef RT_WRITE_Q
#undef RT_WRITE_K
#undef RT_WRITE_V
}

constexpr int SB_KS = 0, SB_KT = 17408, SB_VS = 52224, SB_VT = 18432, SB_FLAGS = 107520, SB_OS = 0, SB_OSW = 8448;
static_assert(SB_KS + 3 * SB_KT <= SB_VS && SB_VS + 3 * SB_VT <= SB_FLAGS && SB_OS + 8 * SB_OSW <= SB_FLAGS && SB_FLAGS + 64 <= RING_BYTES, "SB LDS map");
constexpr float SB_EXIT = 40.0f * 1.4426950408889634f;
template <bool MASKED>
DI void sb_tile(const LAS unsigned char* kb, const LAS unsigned char* vb, const bf16x8 (&bq)[4], const bf16x8 acs, const bf16x8 ones, int key0, int qpos, float& carry, f32x4 (&oacc)[8]) {
    f32x4 z[4];
#pragma unroll
    for (int j = 0; j < 4; ++j) z[j] = (f32x4){0.f, 0.f, 0.f, 0.f};
    {
        bf16x8 ak[2][4];
#pragma unroll
        for (int j = 0; j < 4; ++j) ak[0][j] = *(const LAS bf16x8*)(kb + j * 16 * 272);
#pragma unroll
        for (int ks = 0; ks < 4; ++ks) {
            if (ks < 3) {
#pragma unroll
                for (int j = 0; j < 4; ++j) ak[(ks + 1) & 1][j] = *(const LAS bf16x8*)(kb + j * 16 * 272 + (ks + 1) * 64);
            }
            __builtin_amdgcn_sched_barrier(0);
#pragma unroll
            for (int j = 0; j < 4; ++j) z[j] = MFMA16(ak[ks & 1][j], bq[ks], z[j]);
            __builtin_amdgcn_sched_barrier(0);
        }
    }
    float s[4][4], t[4];
#pragma unroll
    for (int j = 0; j < 4; ++j) {
        float v[4];
#pragma unroll
        for (int r = 0; r < 4; ++r) { const float zz = fminf(z[j][r], 100.0f); z[j][r] = zz; float vv = __builtin_amdgcn_logf(1.0f + __builtin_amdgcn_exp2f(zz));
            if (MASKED) vv = (key0 + 16 * j + r < qpos) ? vv : 0.f;
            v[r] = vv; }
        s[j][3] = v[3]; s[j][2] = v[3] + v[2]; s[j][1] = s[j][2] + v[1]; s[j][0] = s[j][1] + v[0]; t[j] = s[j][0];
    }
    const unsigned h01 = cvtpk(t[0], t[1]), h23 = cvtpk(t[2], t[3]);
    const unsigned l01 = cvtpk(t[0] - bflo(h01), t[1] - bfhi(h01)), l23 = cvtpk(t[2] - bflo(h23), t[3] - bfhi(h23));
    const bf16x8 bt = __builtin_bit_cast(bf16x8, (v4u){h01, h23, l01, l23});
    const f32x4 zero4 = (f32x4){0.f, 0.f, 0.f, 0.f};
    const f32x4 E = MFMA16(acs, bt, zero4), TOT = MFMA16(ones, bt, zero4);
    unsigned wp[4][2];
#pragma unroll
    for (int j = 0; j < 4; ++j) { const float ec = E[j] + carry; float wv[4];
#pragma unroll
        for (int r = 0; r < 4; ++r) { float ex = __builtin_amdgcn_exp2f((z[j][r] - s[j][r]) - ec); if (MASKED) ex = (key0 + 16 * j + r < qpos) ? ex : 0.f; wv[r] = ex; }
        wp[j][0] = cvtpk(wv[0], wv[1]); wp[j][1] = cvtpk(wv[2], wv[3]); }
    carry += TOT[0];
#pragma unroll
    for (int k2 = 0; k2 < 2; ++k2) { const bf16x8 bw = __builtin_bit_cast(bf16x8, (v4u){wp[2 * k2][0], wp[2 * k2][1], wp[2 * k2 + 1][0], wp[2 * k2 + 1][1]});
#pragma unroll
        for (int dt = 0; dt < 8; ++dt) { const bf16x8 av = cat8(trd(vb + (32 * k2) * 288 + dt * 32), trd(vb + (32 * k2 + 16) * 288 + dt * 32)); oacc[dt] = MFMA16(av, bw, oacc[dt]); } }
}
template <bool SAMPLE>
DI void sb_unit(const Args& a, LAS unsigned char* L, int b, int h, int qb, int tid, int lane, int w) {
    const int c15 = lane & 15, g = lane >> 4, q4 = c15 >> 2, p4 = c15 & 3;
    const bf16* R0 = (const bf16*)(a.ws + WS_R);
    const bf16 *RG = R0 + 3 * REG_E, *SQ = R0 + 4 * REG_E, *SK = R0 + 5 * REG_E, *SV = R0 + 6 * REG_E, *GA = R0 + 7 * REG_E, *GB = R0 + 8 * REG_E;
    const bf16* ORET = (const bf16*)(a.ws + WS_XN);
    bf16* MIX = (bf16*)(a.ws + WS_R);
    const float* RSS = (const float*)(a.ws + WS_RSS);
    const bool wvalid = SAMPLE ? (w < 2) : true;
    const int qwbase = SAMPLE ? PAST + 16 * w : 128 * qb + 16 * w;
    const int qpos = qwbase + c15;
    const size_t wrow0 = SAMPLE ? (size_t)MP + 32 * b + 16 * w : (size_t)4096 * b + qwbase;
    bf16x8 bq[4];
#pragma unroll
    for (int ks = 0; ks < 4; ++ks) bq[ks] = wvalid ? *(const GAS bf16x8*)(SQ + (wrow0 + c15) * 1024 + 128 * h + 32 * ks + 8 * g) : (bf16x8){0, 0, 0, 0, 0, 0, 0, 0};
    asm volatile("s_waitcnt vmcnt(0)" : "+v"(bq[0]), "+v"(bq[1]), "+v"(bq[2]), "+v"(bq[3]) :: "memory");
    bf16x8 ones, acs;
#pragma unroll
    for (int e = 0; e < 8; ++e) { ones[e] = (short)0x3f80; acs[e] = (4 * (e & 3) + g > 4 * (c15 & 3) + (c15 >> 2)) ? (short)0x3f80 : (short)0; }
    const int T0 = SAMPLE ? 64 : 2 * qb + 1;
    float carry = 0.f;
    f32x4 oacc[8];
#pragma unroll
    for (int dt = 0; dt < 8; ++dt) oacc[dt] = (f32x4){0.f, 0.f, 0.f, 0.f};
    const int kl0 = tid >> 4, dp = tid & 15;
    v4u tk[2][2], tv[2][2]; f32x4 fk[2][2][2], fv[2][2][2];
#define SB_LOAD(S_, T_) do { _Pragma("unroll") for (int p_ = 0; p_ < 2; ++p_) { const int kl_ = kl0 + 32 * p_; \
        if (!SAMPLE) { const size_t go_ = ((size_t)4096 * b + 64 * (T_) + kl_) * 1024 + 128 * h + 8 * dp; tk[S_][p_] = *(const GAS v4u*)(SK + go_); tv[S_][p_] = *(const GAS v4u*)(SV + go_); } \
        else { const size_t go_ = (((size_t)b * 4096 + 64 * (T_) + kl_) * 8 + h) * 128 + 8 * dp; \
            fk[S_][p_][0] = __builtin_nontemporal_load((const GAS f32x4*)(a.ck + go_)); fk[S_][p_][1] = __builtin_nontemporal_load((const GAS f32x4*)(a.ck + go_ + 4)); fv[S_][p_][0] = __builtin_nontemporal_load((const GAS f32x4*)(a.cv + go_)); fv[S_][p_][1] = __builtin_nontemporal_load((const GAS f32x4*)(a.cv + go_ + 4)); } } } while (0)
#define SB_PARK(S_, B_) do { _Pragma("unroll") for (int p_ = 0; p_ < 2; ++p_) { const int kl_ = kl0 + 32 * p_; \
        if (SAMPLE) { tk[S_][p_] = (v4u){cvtpk(fk[S_][p_][0][0], fk[S_][p_][0][1]), cvtpk(fk[S_][p_][0][2], fk[S_][p_][0][3]), cvtpk(fk[S_][p_][1][0], fk[S_][p_][1][1]), cvtpk(fk[S_][p_][1][2], fk[S_][p_][1][3])}; \
            tv[S_][p_] = (v4u){cvtpk(fv[S_][p_][0][0], fv[S_][p_][0][1]), cvtpk(fv[S_][p_][0][2], fv[S_][p_][0][3]), cvtpk(fv[S_][p_][1][0], fv[S_][p_][1][1]), cvtpk(fv[S_][p_][1][2], fv[S_][p_][1][3])}; } \
        *(LAS v4u*)(L + SB_KS + (B_) * SB_KT + kl_ * 272 + dp * 16) = tk[S_][p_]; *(LAS v4u*)(L + SB_VS + (B_) * SB_VT + kl_ * 288 + dp * 16) = tv[S_][p_]; } } while (0)
    {
#pragma unroll
        for (int p = 0; p < 2; ++p) { const int kl = kl0 + 32 * p; v4u k0, v0;
            if (!SAMPLE) { const size_t go = ((size_t)4096 * b + 64 * T0 + kl) * 1024 + 128 * h + 8 * dp; k0 = *(const GAS v4u*)(SK + go); v0 = *(const GAS v4u*)(SV + go); }
            else if (kl < 32) { const size_t go = ((size_t)MP + 32 * b + kl) * 1024 + 128 * h + 8 * dp; k0 = *(const GAS v4u*)(SK + go); v0 = *(const GAS v4u*)(SV + go); }
            else { k0 = (v4u){0u, 0u, 0u, 0u}; v0 = (v4u){0u, 0u, 0u, 0u}; }
            *(LAS v4u*)(L + SB_KS + kl * 272 + dp * 16) = k0; *(LAS v4u*)(L + SB_VS + kl * 288 + dp * 16) = v0; }
    }
    if (T0 >= 1) SB_LOAD(0, T0 - 1);
    if (T0 >= 2) SB_LOAD(1, T0 - 2);
    int buf = 0;
    for (int it = 0;; ++it) {
        const int T = T0 - it; const int nb = (buf == 2) ? 0 : buf + 1;
        LBAR();
        if (it > 0) { const LAS unsigned* fl = (const LAS unsigned*)(L + SB_FLAGS) + 8 * ((it - 1) & 1);
            const unsigned any = (fl[0] | fl[1]) | (fl[2] | fl[3]) | (fl[4] | fl[5]) | (fl[6] | fl[7]);
            if (__builtin_amdgcn_readfirstlane(any) == 0u) break; }
        if (T > 0) {
            if (it & 1) { SB_PARK(1, nb); if (T >= 3) SB_LOAD(1, T - 3); }
            else        { SB_PARK(0, nb); if (T >= 3) SB_LOAD(0, T - 3); }
        }
        const bool alive = wvalid && (__ballot(carry < SB_EXIT) != 0ull);
        if (alive && 64 * T < qwbase + 16) {
            const LAS unsigned char* kb = L + SB_KS + buf * SB_KT + c15 * 272 + g * 16;
            const LAS unsigned char* vb = L + SB_VS + buf * SB_VT + (4 * g + q4) * 288 + 8 * p4;
            if (64 * T + 63 < qwbase) sb_tile<false>(kb, vb, bq, acs, ones, 64 * T + 4 * g, qpos, carry, oacc);
            else sb_tile<true>(kb, vb, bq, acs, ones, 64 * T + 4 * g, qpos, carry, oacc);
        }
        { const bool more = wvalid && (carry < SB_EXIT); const unsigned long long bal = __ballot(more);
          if (lane == 0) ((LAS unsigned*)(L + SB_FLAGS))[8 * (it & 1) + w] = (bal != 0ull) ? 1u : 0u; }
        if (T == 0) break;
        buf = nb;
    }
#undef SB_LOAD
#undef SB_PARK
    LBAR();
    if (wvalid) {
        LAS unsigned char* os = L + SB_OS + w * SB_OSW;
#pragma unroll
        for (int dt = 0; dt < 8; ++dt) *(LAS f32x4*)(os + c15 * 528 + (16 * dt + 4 * g) * 4) = oacc[dt];
        const int hr = h >> 1, ch = lane & 15, col = 128 * h + 8 * ch;
        const f32x4 rw0 = *(const f32x4*)(a.rnw + 256 * hr + (col & 255)), rw1 = *(const f32x4*)(a.rnw + 256 * hr + (col & 255) + 4);
        v4u orr[4], rg[4], gb[4]; f32x4 rs[4];
#pragma unroll
        for (int k = 0; k < 4; ++k) { const size_t row = wrow0 + 4 * k + (lane >> 4), go = row * 1024 + col;
            orr[k] = *(const GAS v4u*)(ORET + go); rg[k] = *(const GAS v4u*)(RG + go); gb[k] = *(const GAS v4u*)(GB + go);
            rs[k] = *(const GAS f32x4*)(RSS + row * 16 + hr * 4); }
        asm volatile("s_waitcnt lgkmcnt(0)" ::: "memory");
#pragma unroll
        for (int k = 0; k < 4; ++k) {
            const int r = 4 * k + (lane >> 4);
            const f32x4 o0 = *(const LAS f32x4*)(os + r * 528 + ch * 32), o1 = *(const LAS f32x4*)(os + r * 528 + ch * 32 + 16);
            const float rstd = 1.0f / sqrtf(((rs[k][0] + rs[k][1]) + (rs[k][2] + rs[k][3])) * (1.0f / 256.0f) + 1e-6f);
            v4u mo;
            mo.x = cvtpk((bflo(orr[k].x) * rstd * rw0[0] * bflo(rg[k].x)) + bflo(gb[k].x) * o0[0], (bfhi(orr[k].x) * rstd * rw0[1] * bfhi(rg[k].x)) + bfhi(gb[k].x) * o0[1]);
            mo.y = cvtpk((bflo(orr[k].y) * rstd * rw0[2] * bflo(rg[k].y)) + bflo(gb[k].y) * o0[2], (bfhi(orr[k].y) * rstd * rw0[3] * bfhi(rg[k].y)) + bfhi(gb[k].y) * o0[3]);
            mo.z = cvtpk((bflo(orr[k].z) * rstd * rw1[0] * bflo(rg[k].z)) + bflo(gb[k].z) * o1[0], (bfhi(orr[k].z) * rstd * rw1[1] * bfhi(rg[k].z)) + bfhi(gb[k].z) * o1[1]);
            mo.w = cvtpk((bflo(orr[k].w) * rstd * rw1[2] * bflo(rg[k].w)) + bflo(gb[k].w) * o1[2], (bfhi(orr[k].w) * rstd * rw1[3] * bfhi(rg[k].w)) + bfhi(gb[k].w) * o1[3]);
            __builtin_nontemporal_store(mo, (GAS v4u*)(MIX + (wrow0 + r) * 1024 + col));
        }
    }
    LBAR();
}

constexpr int SW_SLOT = 35840, SW_KOFF = 0, SW_VOFF = 17408, SW_FLAGS = 4 * SW_SLOT;
static_assert(SW_FLAGS + 64 <= MISC_OFF && 2 * SW_SLOT >= 8 * SB_OSW, "SB stream LDS map");
DI void sw_fill(LAS unsigned char* L, const bf16* SK, const bf16* SV, size_t rowb, int h, int T, int tid) {
    const int kl0 = tid >> 4, dp = tid & 15; LAS unsigned char* sl = L + (T & 3) * SW_SLOT;
#pragma unroll
    for (int p = 0; p < 2; ++p) { const int kl = kl0 + 32 * p; const size_t go = (rowb + 64 * T + kl) * 1024 + 128 * h + 8 * dp;
        const v4u k0 = *(const GAS v4u*)(SK + go), v0 = *(const GAS v4u*)(SV + go);
        *(LAS v4u*)(sl + SW_KOFF + kl * 272 + dp * 16) = k0; *(LAS v4u*)(sl + SW_VOFF + kl * 288 + dp * 16) = v0; }
}
DI void sb_stream(const Args& a, LAS unsigned char* L, int b, int h, int qb0, int tid, int lane, int w) {
    const int c15 = lane & 15, g = lane >> 4, q4 = c15 >> 2, p4 = c15 & 3;
    const bf16* R0 = (const bf16*)(a.ws + WS_R);
    const bf16 *RG = R0 + 3 * REG_E, *SQ = R0 + 4 * REG_E, *SK = R0 + 5 * REG_E, *SV = R0 + 6 * REG_E, *GA = R0 + 7 * REG_E, *GB = R0 + 8 * REG_E;
    const bf16* ORET = (const bf16*)(a.ws + WS_XN);
    bf16* MIX = (bf16*)(a.ws + WS_R);
    const float* RSS = (const float*)(a.ws + WS_RSS);
    const size_t rowb = (size_t)4096 * b;
    bf16x8 ones, acs;
#pragma unroll
    for (int e = 0; e < 8; ++e) { ones[e] = (short)0x3f80; acs[e] = (4 * (e & 3) + g > 4 * (c15 & 3) + (c15 >> 2)) ? (short)0x3f80 : (short)0; }
    const int kl0 = tid >> 4, dp = tid & 15;
    LAS unsigned* flags = (LAS unsigned*)(L + SW_FLAGS);
    for (int T = (2 * qb0 - 2 > 0 ? 2 * qb0 - 2 : 0); T <= 2 * qb0 + 1; ++T) sw_fill(L, SK, SV, rowb, h, T, tid);
    bf16x8 bq[4];
#pragma unroll
    for (int ks = 0; ks < 4; ++ks) bq[ks] = *(const GAS bf16x8*)(SQ + (rowb + 128 * qb0 + 16 * w + c15) * 1024 + 128 * h + 32 * ks + 8 * g);
    asm volatile("s_waitcnt vmcnt(0)" : "+v"(bq[0]), "+v"(bq[1]), "+v"(bq[2]), "+v"(bq[3]) :: "memory");
    for (int qb = qb0; qb < qb0 + 16; ++qb) {
        const int T0 = 2 * qb + 1, qwbase = 128 * qb + 16 * w, qpos = qwbase + c15;
        const bool has_next = (qb + 1 < qb0 + 16);
        LBAR();
        v4u nk[2][2], nv[2][2]; bf16x8 bqn[4];
        if (has_next) {
#pragma unroll
            for (int tt = 0; tt < 2; ++tt)
#pragma unroll
                for (int p = 0; p < 2; ++p) { const size_t go = (rowb + 64 * (T0 + 1 + tt) + kl0 + 32 * p) * 1024 + 128 * h + 8 * dp; nk[tt][p] = __builtin_nontemporal_load((const GAS v4u*)(SK + go)); nv[tt][p] = __builtin_nontemporal_load((const GAS v4u*)(SV + go)); }
#pragma unroll
            for (int ks = 0; ks < 4; ++ks) bqn[ks] = *(const GAS bf16x8*)(SQ + (rowb + 128 * (qb + 1) + 16 * w + c15) * 1024 + 128 * h + 32 * ks + 8 * g);
        }
        float carry = 0.f;
        f32x4 oacc[8];
#pragma unroll
        for (int dt = 0; dt < 8; ++dt) oacc[dt] = (f32x4){0.f, 0.f, 0.f, 0.f};
        const int Tlow = (T0 - 3 > 0) ? T0 - 3 : 0;
        for (int T = T0; T >= Tlow; --T) {
            if (__ballot(carry < SB_EXIT) == 0ull) break;
            if (64 * T < qwbase + 16) {
                const LAS unsigned char* sl = L + (T & 3) * SW_SLOT;
                const LAS unsigned char* kb = sl + SW_KOFF + c15 * 272 + g * 16;
                const LAS unsigned char* vb = sl + SW_VOFF + (4 * g + q4) * 288 + 8 * p4;
                if (64 * T + 63 < qwbase) sb_tile<false>(kb, vb, bq, acs, ones, 64 * T + 4 * g, qpos, carry, oacc);
                else sb_tile<true>(kb, vb, bq, acs, ones, 64 * T + 4 * g, qpos, carry, oacc);
            }
        }
        { const unsigned long long bal = __ballot(carry < SB_EXIT); if (lane == 0) flags[w] = (bal != 0ull) ? 1u : 0u; }
        LBAR();
        {
            unsigned any = (flags[0] | flags[1]) | (flags[2] | flags[3]) | (flags[4] | flags[5]) | (flags[6] | flags[7]);
            if (__builtin_amdgcn_readfirstlane(any) != 0u && Tlow > 0) {
                int T = Tlow - 1;
                for (;;) {
                    LBAR();
                    {   LAS unsigned char* sl = L + (T0 & 3) * SW_SLOT;
#pragma unroll
                        for (int p = 0; p < 2; ++p) { const int kl = kl0 + 32 * p; const size_t go = (rowb + 64 * T + kl) * 1024 + 128 * h + 8 * dp;
                            const v4u k0 = *(const GAS v4u*)(SK + go), v0 = *(const GAS v4u*)(SV + go);
                            *(LAS v4u*)(sl + SW_KOFF + kl * 272 + dp * 16) = k0; *(LAS v4u*)(sl + SW_VOFF + kl * 288 + dp * 16) = v0; } }
                    LBAR();
                    if (__ballot(carry < SB_EXIT) != 0ull) {
                        const LAS unsigned char* sl = L + (T0 & 3) * SW_SLOT;
                        sb_tile<false>(sl + SW_KOFF + c15 * 272 + g * 16, sl + SW_VOFF + (4 * g + q4) * 288 + 8 * p4, bq, acs, ones, 64 * T + 4 * g, qpos, carry, oacc);
                    }
                    { const unsigned long long bal = __ballot(carry < SB_EXIT); if (lane == 0) flags[w] = (bal != 0ull) ? 1u : 0u; }
                    LBAR();
                    any = (flags[0] | flags[1]) | (flags[2] | flags[3]) | (flags[4] | flags[5]) | (flags[6] | flags[7]);
                    if (__builtin_amdgcn_readfirstlane(any) == 0u || T == 0) break;
                    --T;
                }
                LBAR();
                sw_fill(L, SK, SV, rowb, h, T0, tid);
                LBAR();
            }
        }
        {
            LAS unsigned char* os = L + ((T0 - 3) & 2) * SW_SLOT + w * SB_OSW;
#pragma unroll
            for (int dt = 0; dt < 8; ++dt) *(LAS f32x4*)(os + c15 * 528 + (16 * dt + 4 * g) * 4) = oacc[dt];
            const int hr = h >> 1, ch = lane & 15, col = 128 * h + 8 * ch;
            const size_t wrow0 = rowb + qwbase;
            const f32x4 rw0 = *(const f32x4*)(a.rnw + 256 * hr + (col & 255)), rw1 = *(const f32x4*)(a.rnw + 256 * hr + (col & 255) + 4);
            v4u orr[4], rg[4], gb[4]; f32x4 rs[4];
#pragma unroll
            for (int k = 0; k < 4; ++k) { const size_t row = wrow0 + 4 * k + (lane >> 4), go = row * 1024 + col;
                orr[k] = __builtin_nontemporal_load((const GAS v4u*)(ORET + go)); rg[k] = __builtin_nontemporal_load((const GAS v4u*)(RG + go)); gb[k] = __builtin_nontemporal_load((const GAS v4u*)(GB + go));
                rs[k] = *(const GAS f32x4*)(RSS + row * 16 + hr * 4); }
            asm volatile("s_waitcnt lgkmcnt(0)" ::: "memory");
#pragma unroll
            for (int k = 0; k < 4; ++k) {
                const int r = 4 * k + (lane >> 4);
                const f32x4 o0 = *(const LAS f32x4*)(os + r * 528 + ch * 32), o1 = *(const LAS f32x4*)(os + r * 528 + ch * 32 + 16);
                const float rstd = 1.0f / sqrtf(((rs[k][0] + rs[k][1]) + (rs[k][2] + rs[k][3])) * (1.0f / 256.0f) + 1e-6f);
                v4u mo;
                mo.x = cvtpk((bflo(orr[k].x) * rstd * rw0[0] * bflo(rg[k].x)) + bflo(gb[k].x) * o0[0], (bfhi(orr[k].x) * rstd * rw0[1] * bfhi(rg[k].x)) + bfhi(gb[k].x) * o0[1]);
                mo.y = cvtpk((bflo(orr[k].y) * rstd * rw0[2] * bflo(rg[k].y)) + bflo(gb[k].y) * o0[2], (bfhi(orr[k].y) * rstd * rw0[3] * bfhi(rg[k].y)) + bfhi(gb[k].y) * o0[3]);
                mo.z = cvtpk((bflo(orr[k].z) * rstd * rw1[0] * bflo(rg[k].z)) + bflo(gb[k].z) * o1[0], (bfhi(orr[k].z) * rstd * rw1[1] * bfhi(rg[k].z)) + bfhi(gb[k].z) * o1[1]);
                mo.w = cvtpk((bflo(orr[k].w) * rstd * rw1[2] * bflo(rg[k].w)) + bflo(gb[k].w) * o1[2], (bfhi(orr[k].w) * rstd * rw1[3] * bfhi(rg[k].w)) + bfhi(gb[k].w) * o1[3]);
                __builtin_nontemporal_store(mo, (GAS v4u*)(MIX + (wrow0 + r) * 1024 + col));
            }
        }
        LBAR();
        if (has_next) {
#pragma unroll
            for (int tt = 0; tt < 2; ++tt) { LAS unsigned char* sl = L + ((T0 + 1 + tt) & 3) * SW_SLOT;
#pragma unroll
                for (int p = 0; p < 2; ++p) { const int kl = kl0 + 32 * p; *(LAS v4u*)(sl + SW_KOFF + kl * 272 + dp * 16) = nk[tt][p]; *(LAS v4u*)(sl + SW_VOFF + kl * 288 + dp * 16) = nv[tt][p]; } }
#pragma unroll
            for (int ks = 0; ks < 4; ++ks) bq[ks] = bqn[ks];
            asm volatile("" : "+v"(bq[0]), "+v"(bq[1]), "+v"(bq[2]), "+v"(bq[3]));
        }
    }
    LBAR();
}

DI void stagger(unsigned bx, unsigned ticks) {
    const unsigned x = bx & 7u;
    if (x) { const unsigned long long t1 = __builtin_amdgcn_s_memrealtime() + (unsigned long long)(ticks * x);
        while (__builtin_amdgcn_s_memrealtime() < t1) __builtin_amdgcn_s_sleep(16); }
}
#ifndef STAGGER
#define STAGGER 0
#endif
__global__ void __launch_bounds__(NWAVES * 64, 2) mk_fwd(Args a) {
    extern __shared__ __attribute__((aligned(16))) unsigned char lds_raw[];
    LAS unsigned char* lds = (LAS unsigned char*)lds_raw;
    const int tid = threadIdx.x;
    const int G = gridDim.x, bx = blockIdx.x, vcu = (G % 8 == 0) ? (bx % 8) * (G / 8) + bx / 8 : bx;
    volatile LAS unsigned* MISC = (volatile LAS unsigned*)(lds + MISC_OFF);
    if (tid < 16) MISC[tid] = 0u;
    __syncthreads();
    XcdBarrier bar = xcd_barrier_post((unsigned*)(a.ws + WS_CTL) + CW_BAR, MISC + 8);
    unsigned char* ws = a.ws;
    bf16* R0 = (bf16*)(ws + WS_R);

#define PHASE_IDS(T_, L_, W_) int T_ = threadIdx.x; asm volatile("" : "+v"(T_)); const int L_ = T_ & 63, W_ = __builtin_amdgcn_readfirstlane(T_ >> 6)
    { PHASE_IDS(t0, l0, w0); (void)t0; p0_prologue(a, lds, vcu, G, w0, l0); }
#if PROBE_DUP == 6
    { PHASE_IDS(t0, l0, w0); (void)t0; p0_prologue(a, lds, vcu, G, w0, l0); }
#endif
    xcd_barrier(bar);

    {
        pg8::Gemm g{(const pg8::bf16_t*)(ws + WS_XN), (const pg8::bf16_t*)(ws + WS_WIN), M, NIN, DM, 0}; pg8::StaticOrder S; S.init(M, NIN, G, bx);
        pg8::EpiIn E{(pg8::bf16_t*)R0, a.out, (const float*)(ws + WS_ROPE), a.qnw, a.knw, (LAS float*)(lds + XCH_OFF), 0};
#if PROBE_DUP == 12 || PROBE_DUP == 14
        { pg8::EpiIn EF{(pg8::bf16_t*)R0, a.out, (const float*)(ws + WS_ROPE), a.qnw, a.knw, (LAS float*)(lds + XCH_OFF), PROBE_DUP == 12 ? 1 : 2}; pg8::gemm_phase<pg8::EpiIn, pg8::StaticOrder, true, true>(lds, g, S, EF); }
#endif
#if STAGGER
        stagger((unsigned)bx, 430u);
#endif
        pg8::gemm_phase<pg8::EpiIn, pg8::StaticOrder, true, true>(lds, g, S, E);
#if PROBE_DUP == 1
        pg8::gemm_phase<pg8::EpiIn, pg8::StaticOrder, true, true>(lds, g, S, E);
#endif
    }
    xcd_barrier(bar);

#if PROBE_DUP == 2
    { PHASE_IDS(t1, l1, w1); for (int u = vcu; u < 512; u += G) ret_unit<true>(a, lds, (u >> 2) >> 2, (u >> 2) & 3, u & 3, t1, l1, w1); }
    { PHASE_IDS(t2, l2, w2); for (int u = vcu; u < 256; u += G) ret_unit<false>(a, lds, (u >> 2) >> 2, (u >> 2) & 3, u & 3, t2, l2, w2); }
#endif
#if PROBE_DUP >= 21 && PROBE_DUP <= 26
    { PHASE_IDS(t2, l2, w2); for (int u = vcu; u < 256; u += G) ret_unit<false, PROBE_DUP - 20>(a, lds, (u >> 2) >> 2, (u >> 2) & 3, u & 3, t2, l2, w2); }
#endif
    { PHASE_IDS(t1, l1, w1); for (int u = vcu; u < 512; u += G) ret_unit<true>(a, lds, (u >> 2) >> 2, (u >> 2) & 3, u & 3, t1, l1, w1); }
    { PHASE_IDS(t2, l2, w2); for (int u = vcu; u < 256; u += G) ret_unit<false>(a, lds, (u >> 2) >> 2, (u >> 2) & 3, u & 3, t2, l2, w2); }
    xcd_barrier(bar);

#if PROBE_DUP == 3 || PROBE_DUP == 8
    { PHASE_IDS(t3, l3, w3); for (int u = vcu; u < 256; u += G) sb_unit<true>(a, lds, u >> 3, u & 7, 0, t3, l3, w3); }
#endif
#if PROBE_DUP == 3 || PROBE_DUP == 9
    { PHASE_IDS(t4, l4, w4); for (int u = vcu; u < 256; u += G) sb_stream(a, lds, (u >> 1) >> 3, (u >> 1) & 7, 16 * (u & 1), t4, l4, w4); }
#endif
    { PHASE_IDS(t3, l3, w3); for (int u = vcu; u < 256; u += G) sb_unit<true>(a, lds, u >> 3, u & 7, 0, t3, l3, w3); }
    { PHASE_IDS(t4, l4, w4); for (int u = vcu; u < 256; u += G) sb_stream(a, lds, (u >> 1) >> 3, (u >> 1) & 7, 16 * (u & 1), t4, l4, w4); }
    xcd_barrier(bar);

    {
        pg8::Gemm g{(const pg8::bf16_t*)R0, (const pg8::bf16_t*)(ws + WS_WOUT), M, DM, DM, 0}; pg8::StaticOrder S; S.init(M, DM, G, bx);
        pg8::EpiRes1 E{a.xp, a.xs, a.out, (pg8::bf16_t*)(R0 + REG_E), (float*)(ws + WS_SSQ)};
        pg8::gemm_phase<pg8::EpiRes1, pg8::StaticOrder, true, true>(lds, g, S, E);
#if PROBE_DUP == 4
        pg8::gemm_phase<pg8::EpiRes1, pg8::StaticOrder, true, true>(lds, g, S, E);
#endif
    }
    xcd_barrier(bar);

    {
        pg8::Gemm g{(const pg8::bf16_t*)(R0 + REG_E), (const pg8::bf16_t*)(ws + WS_WUP), M, FF, DM, 0}; pg8::StaticOrder S; S.init(M, FF, G, bx);
        pg8::EpiUp E{(pg8::bf16_t*)(R0 + 4 * REG_E), (const float*)(ws + WS_SSQ)};
#if STAGGER
        stagger((unsigned)bx, 0u);
#endif
        pg8::gemm_phase<pg8::EpiUp, pg8::StaticOrder, true, true>(lds, g, S, E);
#if PROBE_DUP == 5
        pg8::gemm_phase<pg8::EpiUp, pg8::StaticOrder, true, true>(lds, g, S, E);
#endif
#if PROBE_DUP == 7
        { pg8::EpiNull EN{(float*)(ws + WS_SSQ)}; pg8::gemm_phase<pg8::EpiNull, pg8::StaticOrder, true, true>(lds, g, S, EN); }
#endif
#if PROBE_DUP == 10 || PROBE_DUP == 11
        { pg8::EpiLinear EL{(pg8::bf16_t*)(R0 + 2 * REG_E)}; pg8::gemm_phase<pg8::EpiLinear, pg8::StaticOrder, true, true>(lds, g, S, EL); }
#endif
    }
    xcd_barrier(bar);

    {
        pg8::Gemm g{(const pg8::bf16_t*)(R0 + 4 * REG_E), (const pg8::bf16_t*)(ws + WS_WDN), MP, DM, FF, 0}; pg8::StaticOrder S; S.init(MP, DM, G, bx);
        pg8::EpiDown E{a.out};
#if PROBE_DUP == 13
        { pg8::EpiNull EN{(float*)(ws + WS_SSQ)}; pg8::gemm_phase<pg8::EpiNull, pg8::StaticOrder, true, true>(lds, g, S, EN); }
#endif
        pg8::gemm_phase<pg8::EpiDown, pg8::StaticOrder, true, true>(lds, g, S, E);
    }
    float* part = (float*)(R0 + 2 * REG_E);
    for (int mu = bx; mu < 256; mu += G) {
        const int kc = mu & 15, tile = mu >> 4;
        pg8::Gemm g{(const pg8::bf16_t*)(R0 + 4 * REG_E) + kc * 256, (const pg8::bf16_t*)(ws + WS_WDN) + kc * 256, M, DM, FF, 4};
        pg8::OneUnit S{256 + (tile >> 2), tile & 3};
        pg8::EpiPartial E{part + (size_t)kc * MS * DM};
        pg8::gemm_phase<pg8::EpiPartial, pg8::OneUnit, true, true>(lds, g, S, E);
    }
    xcd_barrier(bar);
    {
        GAS f32x4* y4 = (GAS f32x4*)(a.out + (size_t)MP * DM); const GAS f32x4* p4 = (const GAS f32x4*)part;
        for (int i = bx * (NWAVES * 64) + tid; i < MS * DM / 4; i += G * NWAVES * 64) {
            f32x4 pv[16];
#pragma unroll
            for (int kc = 0; kc < 16; ++kc) pv[kc] = p4[(size_t)kc * (MS * DM / 4) + i];
            f32x4 v = y4[i];
#pragma unroll
            for (int kc = 0; kc < 16; ++kc) v += pv[kc];
            y4[i] = v;
        }
    }
}

extern "C" void kernel_launch(void* const* d_in, const int* in_sizes, int n_in, void* d_out, int out_size, void* d_ws, size_t ws_size, hipStream_t stream) {
    static int grid = 0;
    if (grid == 0) {
        if (n_in != 14 || in_sizes[0] != MP * DM || out_size != (int)O_END || ws_size < WS_END) {
            fprintf(stderr, "kernel_launch: unexpected shapes: n_in %d in0 %d out %d ws %zu (need %zu)\n", n_in, n_in > 0 ? in_sizes[0] : -1, out_size, ws_size, (size_t)WS_END); grid = -1; return; }
        int dev = 0, cus = 0, per_cu = 0;
        if (hipGetDevice(&dev) != hipSuccess || hipDeviceGetAttribute(&cus, hipDeviceAttributeMultiprocessorCount, dev) != hipSuccess) { grid = -1; return; }
        if (hipFuncSetAttribute((const void*)mk_fwd, hipFuncAttributeMaxDynamicSharedMemorySize, LDS_BYTES) != hipSuccess) { fprintf(stderr, "kernel_launch: hipFuncSetAttribute failed\n"); grid = -1; return; }
        if (hipOccupancyMaxActiveBlocksPerMultiprocessor(&per_cu, (const void*)mk_fwd, NWAVES * 64, LDS_BYTES) != hipSuccess || per_cu < 1) { fprintf(stderr, "kernel_launch: occupancy query reports %d blocks per CU\n", per_cu); }
        (void)hipGetLastError();
        grid = cus;
    }
    if (grid < 0) return;
    if (hipMemsetAsync((char*)d_ws + WS_CTL, 0, CTL_ZERO_BYTES, stream) != hipSuccess) return;
    Args a{};
    a.xp = (const float*)d_in[0]; a.xs = (const float*)d_in[1]; a.ck = (const float*)d_in[2]; a.cv = (const float*)d_in[3]; a.st = (const float*)d_in[4];
    a.nmix = (const float*)d_in[5]; a.win = (const float*)d_in[6]; a.rnw = (const float*)d_in[7]; a.qnw = (const float*)d_in[8]; a.knw = (const float*)d_in[9];
    a.wout = (const float*)d_in[10]; a.nmlp = (const float*)d_in[11]; a.wup = (const float*)d_in[12]; a.wdn = (const float*)d_in[13];
    a.out = (float*)d_out; a.ws = (unsigned char*)d_ws;
    hipLaunchKernelGGL(mk_fwd, dim3(grid), dim3(NWAVES * 64), LDS_BYTES, stream, a);
}
```
